# Optimizing an MI355X kernel written in HIP

```python
import math
import jax
import jax.numpy as jnp
from jax import lax
import numpy as np

D_MODEL = 1024
BATCH = 4
SEQ = 4096
DEPTH = 2

S5_WIDTH = D_MODEL // 2
S5_GROUP = 16
S5_GROUPS = S5_WIDTH // S5_GROUP
S5_STATE = 64
ATTN_HEADS = 8
HEAD_DIM = 64
ATTN_WIDTH = ATTN_HEADS * HEAD_DIM
IDX_HEADS = 8
IDX_DIM = 64
TOPK_MAX = 256
Q_BLOCK = 128
ROPE_THETA = 500000.0
ROPE_DIM = HEAD_DIM // 4
MIX_WIDTH = S5_WIDTH + ATTN_WIDTH
IN_SPLITS = (S5_WIDTH, ATTN_WIDTH, HEAD_DIM, HEAD_DIM, IDX_HEADS * IDX_DIM, IDX_DIM, IDX_HEADS)
IN_WIDTH = sum(IN_SPLITS)
POOL_WINDOWS = (2, 4, 8, 16)
POOL_GROUP = D_MODEL // len(POOL_WINDOWS)
N_EXPERTS = 64
TOP_K = 8
N_EXPERT_GROUPS = 8
TOPK_GROUPS = 4
EXPERT_DIM = 256
SHARED_DIM = 256
ROUTED_SCALE = 2.5
ROW_BLOCK = 128
N_EVEN = (DEPTH + 1) // 2
N_ODD = DEPTH // 2
EPS = 1e-6

kernel_name = 'hybrid_s5_dsa_pool_moe_trunk'


def rms_norm(x, g):
    xf = x.astype(jnp.float32)
    y = xf * lax.rsqrt(jnp.mean(xf * xf, axis=-1, keepdims=True) + EPS)
    return (y * g.astype(jnp.float32)).astype(x.dtype)


def ada_mod(cs, w, b):
    return jnp.split(cs @ w + b, 3, axis=-1)


def modulate(n, shift, scale):
    return n * (1.0 + scale[:, None, :]) + shift[:, None, :]


def rope_tables(positions, rot_dim):
    inv = jnp.power(jnp.float32(ROPE_THETA), -jnp.arange(0, rot_dim, 2, dtype=jnp.float32) / rot_dim)
    ang = positions.astype(jnp.float32)[..., None] * inv
    return jnp.cos(ang)[:, :, None, :], jnp.sin(ang)[:, :, None, :]


def partial_rope(x, cos, sin):
    half = cos.shape[-1]
    xr = x[..., :2 * half].astype(jnp.float32)
    x1, x2 = xr[..., :half], xr[..., half:]
    rot = jnp.concatenate([x1 * cos - x2 * sin, x1 * sin + x2 * cos], axis=-1)
    return jnp.concatenate([rot.astype(x.dtype), x[..., 2 * half:]], axis=-1)


def _ssm_combine(e1, e2):
    a1r, a1i, b1r, b1i = e1
    a2r, a2i, b2r, b2i = e2
    return (a2r * a1r - a2i * a1i, a2r * a1i + a2i * a1r,
            a2r * b1r - a2i * b1i + b2r, a2r * b1i + a2i * b1r + b2i)


def s5_mixer(u, lam_re, lam_im, log_dt, b_re, b_im, c_re, c_im, d_skip, glu_w, glu_b):
    bsz, seq, _ = u.shape
    uf = u.astype(jnp.float32).reshape(bsz, seq, S5_GROUPS, S5_GROUP)
    lr = lam_re.astype(jnp.float32)
    li = lam_im.astype(jnp.float32)
    dt = jnp.exp(log_dt.astype(jnp.float32))[:, None]
    mag = jnp.exp(lr * dt)
    ar, ai = mag * jnp.cos(li * dt), mag * jnp.sin(li * dt)
    nr, ni = ar - 1.0, ai
    den = lr * lr + li * li
    cr, ci = (nr * lr + ni * li) / den, (ni * lr - nr * li) / den
    bre, bim = b_re.astype(jnp.float32), b_im.astype(jnp.float32)
    bbar_r = cr[..., None] * bre - ci[..., None] * bim
    bbar_i = cr[..., None] * bim + ci[..., None] * bre
    bu_r = jnp.einsum('gph,bsgh->bsgp', bbar_r, uf)
    bu_i = jnp.einsum('gph,bsgh->bsgp', bbar_i, uf)
    a_r = jnp.broadcast_to(ar, bu_r.shape)
    a_i = jnp.broadcast_to(ai, bu_i.shape)
    _, _, st_r, st_i = lax.associative_scan(_ssm_combine, (a_r, a_i, bu_r, bu_i), axis=1)
    y = (jnp.einsum('ghp,bsgp->bsgh', c_re.astype(jnp.float32), st_r)
         - jnp.einsum('ghp,bsgp->bsgh', c_im.astype(jnp.float32), st_i)
         + d_skip.astype(jnp.float32) * uf)
    y = jax.nn.gelu(y)
    y = y * jax.nn.sigmoid(jnp.einsum('bsgh,ghk->bsgk', y, glu_w.astype(jnp.float32)) + glu_b.astype(jnp.float32))
    return y.reshape(bsz, seq, S5_WIDTH).astype(u.dtype)


def dsa_mixer(q, k, v, qi, ki, wi, q_norm_g, k_norm_g, positions):
    bsz, seq, _ = q.shape
    cos, sin = rope_tables(positions, ROPE_DIM)
    q = partial_rope(rms_norm(q.reshape(bsz, seq, ATTN_HEADS, HEAD_DIM), q_norm_g), cos, sin)
    k = partial_rope(rms_norm(k, k_norm_g)[:, :, None, :], cos, sin)[:, :, 0]
    qi = partial_rope(qi.reshape(bsz, seq, IDX_HEADS, IDX_DIM), cos, sin).astype(jnp.float32)
    ki = partial_rope(ki[:, :, None, :], cos, sin)[:, :, 0].astype(jnp.float32)
    wi = wi.astype(jnp.float32) * IDX_HEADS ** -0.5
    k_sel = min(TOPK_MAX, seq // 4)
    n_blk = seq // Q_BLOCK
    key_pos = jnp.arange(seq, dtype=jnp.int32)

    def to_blocks(a):
        return jnp.moveaxis(a.reshape(bsz, n_blk, Q_BLOCK, *a.shape[2:]), 1, 0)

    def block(args):
        qb, qib, wb, tb = args
        iscore = jnp.einsum('bqhd,bsd->bqhs', qib, ki) * IDX_DIM ** -0.5
        iscore = jnp.einsum('bqh,bqhs->bqs', wb, jax.nn.relu(iscore))
        iscore = jnp.where(key_pos[None, None, :] <= tb[None, :, None], iscore, -jnp.inf)
        _, sel = lax.top_k(iscore, k_sel)
        valid = sel <= tb[None, :, None]
        kg = jax.vmap(lambda kk, ii: kk[ii])(k, sel)
        vg = jax.vmap(lambda vv, ii: vv[ii])(v, sel)
        sc = jnp.einsum('bqhd,bqkd->bqhk', qb, kg).astype(jnp.float32) * HEAD_DIM ** -0.5
        sc = jnp.where(valid[:, :, None, :], sc, -jnp.inf)
        p = jax.nn.softmax(sc, axis=-1).astype(vg.dtype)
        return jnp.einsum('bqhk,bqkd->bqhd', p, vg)

    q_pos = jnp.arange(seq, dtype=jnp.int32).reshape(n_blk, Q_BLOCK)
    out = lax.map(block, (to_blocks(q), to_blocks(qi), to_blocks(wi), q_pos))
    return jnp.moveaxis(out, 0, 1).reshape(bsz, seq, ATTN_WIDTH)


def hybrid_mixer(h, positions, w_in, w_out, lam_re, lam_im, log_dt, b_re, b_im, c_re, c_im,
                 d_skip, glu_w, glu_b, q_norm_g, k_norm_g):
    proj = h @ w_in
    cuts = np.cumsum(IN_SPLITS)[:-1].tolist()
    u, q, k, v, qi, ki, wi = jnp.split(proj, cuts, axis=-1)
    y_ssm = s5_mixer(u, lam_re, lam_im, log_dt, b_re, b_im, c_re, c_im, d_skip, glu_w, glu_b)
    y_att = dsa_mixer(q, k, v, qi, ki, wi, q_norm_g, k_norm_g, positions)
    return jnp.concatenate([y_ssm, y_att], axis=-1) @ w_out


def pool_mixer(h, pool_w, pool_scale):
    bsz, seq, d = h.shape
    hf = h.astype(jnp.float32)
    cs = jnp.concatenate([jnp.zeros((bsz, 1, d), jnp.float32), jnp.cumsum(hf, axis=1)], axis=1)
    hi = np.arange(1, seq + 1)
    outs = []
    for g, win in enumerate(POOL_WINDOWS):
        lo = np.maximum(hi - win, 0)
        cnt = (hi - lo).astype(np.float32)
        sl = slice(g * POOL_GROUP, (g + 1) * POOL_GROUP)
        csg = cs[:, :, sl]
        pooled = (csg[:, hi] - csg[:, lo]) / cnt[None, :, None] - hf[:, :, sl]
        outs.append(jnp.einsum('bsc,cd->bsd', pooled.astype(h.dtype), pool_w[g]))
    return jnp.concatenate(outs, axis=-1) * pool_scale


def moe_ffn(h, router_w, router_bias, w_gate, w_up, w_down, sh_gate, sh_up, sh_down):
    bsz, seq, d = h.shape
    n_tok = bsz * seq
    xt = h.reshape(n_tok, d)
    scores = jax.nn.sigmoid((xt @ router_w).astype(jnp.float32))
    sel = (scores + router_bias.astype(jnp.float32)).reshape(n_tok, N_EXPERT_GROUPS, -1)
    group_score = lax.top_k(sel, 2)[0].sum(-1)
    _, top_groups = lax.top_k(group_score, TOPK_GROUPS)
    group_mask = jax.nn.one_hot(top_groups, N_EXPERT_GROUPS, dtype=jnp.float32).sum(1) > 0
    sel = jnp.where(group_mask[:, :, None], sel, -jnp.inf).reshape(n_tok, N_EXPERTS)
    _, expert_idx = lax.top_k(sel, TOP_K)
    gate_w = jnp.take_along_axis(scores, expert_idx, axis=-1)
    gate_w = gate_w / jnp.sum(gate_w, axis=-1, keepdims=True) * ROUTED_SCALE
    n_assign = n_tok * TOP_K
    flat_e = expert_idx.reshape(n_assign)
    flat_tok = jnp.repeat(jnp.arange(n_tok, dtype=jnp.int32), TOP_K)
    flat_w = gate_w.reshape(n_assign)
    order = jnp.argsort(flat_e)
    se, stok, sw = flat_e[order], flat_tok[order], flat_w[order]
    counts = jnp.bincount(flat_e, length=N_EXPERTS)
    padded = (counts + ROW_BLOCK - 1) // ROW_BLOCK * ROW_BLOCK
    pad_end = jnp.cumsum(padded)
    pad_start = pad_end - padded
    start = jnp.cumsum(counts) - counts
    dest = pad_start[se] + jnp.arange(n_assign, dtype=jnp.int32) - start[se]
    n_blocks = -(-n_assign // ROW_BLOCK) + N_EXPERTS
    n_rows = n_blocks * ROW_BLOCK
    row_tok = jnp.full((n_rows,), n_tok, jnp.int32).at[dest].set(stok)
    row_w = jnp.zeros((n_rows,), jnp.float32).at[dest].set(sw)
    block_e = jnp.minimum(jnp.searchsorted(pad_end, jnp.arange(n_blocks, dtype=jnp.int32) * ROW_BLOCK, side='right'), N_EXPERTS - 1)
    x_pad = jnp.concatenate([xt, jnp.zeros((1, d), xt.dtype)], axis=0)

    def expert_block(args):
        rows, wr, e = args
        xb = x_pad[rows]
        hb = jax.nn.silu(xb @ w_gate[e]) * (xb @ w_up[e])
        return (hb @ w_down[e]) * wr[:, None].astype(xb.dtype)

    y = lax.map(expert_block, (row_tok.reshape(n_blocks, ROW_BLOCK), row_w.reshape(n_blocks, ROW_BLOCK), block_e))
    routed = jax.ops.segment_sum(y.reshape(n_rows, d), row_tok, num_segments=n_tok + 1)[:n_tok]
    shared = (jax.nn.silu(xt @ sh_gate) * (xt @ sh_up)) @ sh_down
    return (routed + shared).reshape(bsz, seq, d)


def setup_inputs(seed: int = 0) -> dict:
    key = jax.random.key(seed)
    ks = iter(jax.random.split(key, 48))
    f32 = jnp.float32

    def nrm(shape, std):
        return jax.random.normal(next(ks), shape, f32) * std

    D, G, P, H, E = D_MODEL, S5_GROUPS, S5_STATE, S5_GROUP, N_EXPERTS
    x = nrm((BATCH, SEQ, D), 1.0)
    c = nrm((BATCH, D), 1.0)
    positions = jnp.broadcast_to(jnp.arange(SEQ, dtype=jnp.int32)[None, :], (BATCH, SEQ))
    mix_norm_g = 1.0 + nrm((DEPTH, D), 0.02)
    mix_mod_w = nrm((DEPTH, D, 3 * D), 0.5 * D ** -0.5)
    mix_mod_b = nrm((DEPTH, 3 * D), 0.02)
    ffn_norm_g = 1.0 + nrm((DEPTH, D), 0.02)
    ffn_mod_w = nrm((DEPTH, D, 3 * D), 0.5 * D ** -0.5)
    ffn_mod_b = nrm((DEPTH, 3 * D), 0.02)
    hyb_w_in = nrm((N_EVEN, D, IN_WIDTH), D ** -0.5)
    hyb_w_out = nrm((N_EVEN, MIX_WIDTH, D), MIX_WIDTH ** -0.5)
    s5_lambda_re = -0.5 + nrm((N_EVEN, G, P), 0.01)
    s5_lambda_im = math.pi * jnp.arange(P, dtype=f32) + nrm((N_EVEN, G, P), 0.01)
    s5_log_dt = jax.random.uniform(next(ks), (N_EVEN, G), f32, math.log(1e-3), math.log(1e-1))
    s5_b_re = nrm((N_EVEN, G, P, H), (2 * H) ** -0.5)
    s5_b_im = nrm((N_EVEN, G, P, H), (2 * H) ** -0.5)
    s5_c_re = nrm((N_EVEN, G, H, P), 4.0 * P ** -0.5)
    s5_c_im = nrm((N_EVEN, G, H, P), 4.0 * P ** -0.5)
    s5_d = nrm((N_EVEN, G, H), 1.0)
    s5_glu_w = nrm((N_EVEN, G, H, H), H ** -0.5)
    s5_glu_b = nrm((N_EVEN, G, H), 0.02)
    attn_q_norm_g = 1.0 + nrm((N_EVEN, HEAD_DIM), 0.02)
    attn_k_norm_g = 1.0 + nrm((N_EVEN, HEAD_DIM), 0.02)
    pool_w = nrm((N_ODD, len(POOL_WINDOWS), POOL_GROUP, POOL_GROUP), POOL_GROUP ** -0.5)
    pool_scale = 1.0 + nrm((N_ODD, D), 0.1)
    router_w = nrm((DEPTH, D, E), D ** -0.5)
    router_bias = nrm((DEPTH, E), 0.01)
    exp_w_gate = nrm((DEPTH, E, D, EXPERT_DIM), D ** -0.5)
    exp_w_up = nrm((DEPTH, E, D, EXPERT_DIM), D ** -0.5)
    exp_w_down = nrm((DEPTH, E, EXPERT_DIM, D), EXPERT_DIM ** -0.5)
    sh_w_gate = nrm((DEPTH, D, SHARED_DIM), D ** -0.5)
    sh_w_up = nrm((DEPTH, D, SHARED_DIM), D ** -0.5)
    sh_w_down = nrm((DEPTH, SHARED_DIM, D), SHARED_DIM ** -0.5)
    return {'x': x, 'c': c, 'positions': positions,
            'mix_norm_g': mix_norm_g, 'mix_mod_w': mix_mod_w, 'mix_mod_b': mix_mod_b,
            'ffn_norm_g': ffn_norm_g, 'ffn_mod_w': ffn_mod_w, 'ffn_mod_b': ffn_mod_b,
            'hyb_w_in': hyb_w_in, 'hyb_w_out': hyb_w_out,
            's5_lambda_re': s5_lambda_re, 's5_lambda_im': s5_lambda_im, 's5_log_dt': s5_log_dt,
            's5_b_re': s5_b_re, 's5_b_im': s5_b_im, 's5_c_re': s5_c_re, 's5_c_im': s5_c_im,
            's5_d': s5_d, 's5_glu_w': s5_glu_w, 's5_glu_b': s5_glu_b,
            'attn_q_norm_g': attn_q_norm_g, 'attn_k_norm_g': attn_k_norm_g,
            'pool_w': pool_w, 'pool_scale': pool_scale,
            'router_w': router_w, 'router_bias': router_bias,
            'exp_w_gate': exp_w_gate, 'exp_w_up': exp_w_up, 'exp_w_down': exp_w_down,
            'sh_w_gate': sh_w_gate, 'sh_w_up': sh_w_up, 'sh_w_down': sh_w_down}


def reference(x, c, positions, mix_norm_g, mix_mod_w, mix_mod_b, ffn_norm_g, ffn_mod_w, ffn_mod_b,
              hyb_w_in, hyb_w_out, s5_lambda_re, s5_lambda_im, s5_log_dt, s5_b_re, s5_b_im,
              s5_c_re, s5_c_im, s5_d, s5_glu_w, s5_glu_b, attn_q_norm_g, attn_k_norm_g,
              pool_w, pool_scale, router_w, router_bias, exp_w_gate, exp_w_up, exp_w_down,
              sh_w_gate, sh_w_up, sh_w_down):
    cs = jax.nn.silu(c)
    for i in range(DEPTH):
        j = i // 2
        shift, scale, gate = ada_mod(cs, mix_mod_w[i], mix_mod_b[i])
        h = modulate(rms_norm(x, mix_norm_g[i]), shift, scale)
        if i % 2 == 0:
            y = hybrid_mixer(h, positions, hyb_w_in[j], hyb_w_out[j], s5_lambda_re[j], s5_lambda_im[j],
                             s5_log_dt[j], s5_b_re[j], s5_b_im[j], s5_c_re[j], s5_c_im[j], s5_d[j],
                             s5_glu_w[j], s5_glu_b[j], attn_q_norm_g[j], attn_k_norm_g[j])
        else:
            y = pool_mixer(h, pool_w[j], pool_scale[j])
        x = x + gate[:, None, :] * y
        shift, scale, gate = ada_mod(cs, ffn_mod_w[i], ffn_mod_b[i])
        h = modulate(rms_norm(x, ffn_norm_g[i]), shift, scale)
        y = moe_ffn(h, router_w[i], router_bias[i], exp_w_gate[i], exp_w_up[i], exp_w_down[i],
                    sh_w_gate[i], sh_w_up[i], sh_w_down[i])
        x = x + gate[:, None, :] * y
    return x
```

```cpp
#include <hip/hip_runtime.h>
#include <cstdio>
#include <cstdint>

#ifndef MK_LAUNCH_PER_PHASE
#define MK_LAUNCH_PER_PHASE 1
#endif

#define GAS __attribute__((address_space(1)))
#define LAS __attribute__((address_space(3)))
typedef unsigned short bf16;
typedef unsigned v4u __attribute__((ext_vector_type(4)));
typedef unsigned v2u __attribute__((ext_vector_type(2)));
typedef float f32x4 __attribute__((ext_vector_type(4)));
typedef short bf16x8 __attribute__((ext_vector_type(8)));
#define LDS_WAIT() asm volatile("s_waitcnt lgkmcnt(0)" ::: "memory")
#define VM_WAIT() asm volatile("s_waitcnt vmcnt(0)" ::: "memory")

constexpr int NB = 4, SEQ = 4096, T = NB * SEQ, D = 1024;
constexpr int INW = 1736, INP = 1792;
constexpr int NEXP = 64, EDIM = 256;
constexpr int NASSIGN = T * 8;
constexpr int ECAP = T;

constexpr size_t MiB = 1u << 20;
constexpr size_t WS_CTL = 0;
constexpr size_t CTL_ZERO_BYTES = 1 * MiB;
constexpr size_t WS_MOD = 1 * MiB;
constexpr size_t WS_ROPE = WS_MOD + 256 * 1024;
constexpr size_t WS_S5T = WS_ROPE + 1 * MiB;
constexpr size_t WS_WIN = 4 * MiB;
constexpr size_t WS_WOUT = WS_WIN + (size_t)INP * D * 2;
constexpr size_t WS_WPOOL = WS_WOUT + (size_t)D * D * 2;
constexpr size_t WS_WGU = 10 * MiB;
constexpr size_t WS_WD = WS_WGU + (size_t)65 * 512 * 1024 * 2;
constexpr size_t WS_H = WS_WD + (size_t)65 * 1024 * 256 * 2;
constexpr size_t WS_EIDX = WS_H + (size_t)T * D * 2;
constexpr size_t WS_SLOT = WS_EIDX + (size_t)T * 8 * 4;
constexpr size_t WS_ELT = WS_SLOT + (size_t)T * 8 * 4;
constexpr size_t WS_ELW = WS_ELT + (size_t)NEXP * ECAP * 4;
constexpr size_t WS_BIG = WS_ELW + (size_t)NEXP * ECAP * 4;
constexpr size_t BG_PROJ = WS_BIG;
constexpr size_t BG_U = BG_PROJ + (size_t)T * INP * 4;
constexpr size_t BG_Q = BG_U + (size_t)T * 512 * 4;
constexpr size_t BG_QI = BG_Q + (size_t)T * 512 * 2;
constexpr size_t BG_K = BG_QI + (size_t)T * 512 * 2;
constexpr size_t BG_V = BG_K + (size_t)T * 64 * 2;
constexpr size_t BG_KI = BG_V + (size_t)T * 64 * 2;
constexpr size_t BG_WI = BG_KI + (size_t)T * 64 * 2;
constexpr size_t BG_SLOC = BG_WI + (size_t)T * 8 * 4;
constexpr size_t BG_SIN = BG_SLOC + (size_t)4 * 32 * 64 * 64 * 2 * 4;
constexpr size_t BG_MIX = BG_SIN + (size_t)4 * 32 * 64 * 64 * 2 * 4;
constexpr size_t BG_MIXER_END = BG_MIX + (size_t)T * D * 2;
constexpr size_t BG_HB = WS_BIG;
constexpr size_t BG_HBSH = BG_HB + (size_t)(NASSIGN + 256) * 256 * 2;
constexpr size_t BG_Y = BG_HBSH + (size_t)T * 256 * 2;
constexpr size_t BG_MOE_END = BG_Y + (size_t)NASSIGN * D * 2;
constexpr size_t BG_H2F = WS_BIG;
constexpr size_t WS_END = (BG_MOE_END > BG_MIXER_END ? BG_MOE_END : BG_MIXER_END);
static_assert(WS_END <= 539993216ull, "workspace map exceeds the guaranteed d_ws size");

constexpr int S5_ABAR = 0;
constexpr int S5_A64 = S5_ABAR + 32 * 64 * 2;
constexpr int S5_BBR = S5_A64 + 32 * 64 * 2;
constexpr int S5_BBI = S5_BBR + 32 * 64 * 16;

constexpr int CW_BAR = 4096;
constexpr int CW_CNT = 16384;
constexpr int CW_EST = 16384 + 256;
constexpr int CW_NT = 16384 + 512;
constexpr int CW_TE = 16384 + 1024;
constexpr int CW_TJ = 16384 + 4096;
constexpr int LDS_BYTES = 163840;

__device__ __forceinline__ unsigned f2bf(float f) { unsigned u = __builtin_bit_cast(unsigned, f); return (u + 0x7fffu + ((u >> 16) & 1u)) >> 16; }
__device__ __forceinline__ unsigned pk2(float lo, float hi) { return f2bf(lo) | (f2bf(hi) << 16); }
__device__ __forceinline__ float bf2f(unsigned b) { return __builtin_bit_cast(float, b << 16); }
__device__ __forceinline__ float bflo(unsigned w) { return __builtin_bit_cast(float, w << 16); }
__device__ __forceinline__ float bfhi(unsigned w) { return __builtin_bit_cast(float, w & 0xffff0000u); }
__device__ __forceinline__ float wave_sum(float v) {
#pragma unroll
    for (int o = 1; o < 64; o <<= 1) v += __shfl_xor(v, o);
    return v;
}
__device__ __forceinline__ float wave_max(float v) {
#pragma unroll
    for (int o = 1; o < 64; o <<= 1) v = fmaxf(v, __shfl_xor(v, o));
    return v;
}
__device__ __forceinline__ int wave_sum_i(int v) {
#pragma unroll
    for (int o = 1; o < 64; o <<= 1) v += __shfl_xor(v, o);
    return v;
}
__device__ __forceinline__ float sigmoidf_(float x) { return 1.0f / (1.0f + __expf(-x)); }

namespace pg8 {
typedef float f32x4 __attribute__((ext_vector_type(4)));
constexpr int BM = 256, BK = 64, HALF = 128, HTB = HALF * BK * 2, STAGE_BYTES = 8 * HTB;
__host__ __device__ __forceinline__ int lds_byte(int r, int c) { const int st = (r >> 4) * 2 + (c >> 5), rr = r & 15, cc = c & 31, ob = rr * 64 + cc * 2; return st * 1024 + (ob ^ (((ob >> 9) & 1) << 5)); }
__host__ __device__ __forceinline__ void stage_rc(int b, int& R, int& C) { const int st = b / 1024, sb = b % 1024, swz = sb ^ (((sb >> 9) & 1) << 5); R = (st >> 1) * 16 + swz / 64; C = (st & 1) * 32 + (swz % 64) / 2; }
struct Unit { int pm, pn, e, rows; };
template <class Epi, class Sched, bool GATHER>
__device__ __forceinline__ void gemm_phase(LAS unsigned char* lds, const int tid, const int K, const unsigned lda_b, const unsigned ldb_b, const Sched& S, const Epi& E) {
    const int wid = __builtin_amdgcn_readfirstlane(tid >> 6), lane = tid & 63, wr = wid >> 2, wc = wid & 3, fr = lane & 15, fq = lane >> 4;
    const int nt = K / BK;
    unsigned voffA[2], voffB[2]; int RA[2], CA[2];
#pragma unroll
    for (int i = 0; i < 2; ++i) { int R, C; stage_rc(tid * 16 + i * 8192, R, C); RA[i] = R; CA[i] = C; voffA[i] = (unsigned)R * lda_b + (unsigned)C * 2u; voffB[i] = (unsigned)R * ldb_b + (unsigned)C * 2u; }
    const size_t kstep = (size_t)(BK * 2);
    const size_t hstepA = (size_t)HALF * lda_b, hstepB = (size_t)HALF * ldb_b;
    const unsigned ldsw = (unsigned)wid * 1024u;
    const int aoff = lds_byte(wr * 64 + fr, fq * 8), boff = lds_byte(wc * 32 + fr, fq * 8);
#define PG8_SA(b, h) (((b) * 2 + (h)) * HTB)
#define PG8_SB(b, h) ((4 + (b) * 2 + (h)) * HTB)
#define PG8_STAGE(bufoff, gbase, voff) do { _Pragma("unroll") for (int _i = 0; _i < 2; ++_i) \
        __builtin_amdgcn_global_load_lds((const unsigned*)((const char*)(gbase) + (voff)[_i]), (LAS unsigned*)(lds + (bufoff) + ldsw + _i * 8192), 16, 0, 0); } while (0)
#define PG8_STAGE_A(bufoff, gbase, h, OS) do { if constexpr (GATHER) { PG8_STAGE(bufoff, gbase, g##OS##h); } else { PG8_STAGE(bufoff, (gbase) + (h) * hstepA, voffA); } } while (0)
#define PG8_LDA(dst, b, h) do { _Pragma("unroll") for (int m = 0; m < 4; ++m) _Pragma("unroll") for (int k = 0; k < 2; ++k) dst[m][k] = *(const LAS bf16x8*)(lds + PG8_SA(b, h) + aoff + m * 2048 + k * 1024); } while (0)
#define PG8_LDB(dst, b, h) do { _Pragma("unroll") for (int n = 0; n < 2; ++n) _Pragma("unroll") for (int k = 0; k < 2; ++k) dst[n][k] = *(const LAS bf16x8*)(lds + PG8_SB(b, h) + boff + n * 2048 + k * 1024); } while (0)
#define PG8_MMA(ai, bj, At, Bt) do { __builtin_amdgcn_s_setprio(1); _Pragma("unroll") for (int m = 0; m < 4; ++m) _Pragma("unroll") for (int n = 0; n < 2; ++n) _Pragma("unroll") for (int k = 0; k < 2; ++k) \
        acc[ai][bj][m][n] = __builtin_amdgcn_mfma_f32_16x16x32_bf16(Bt[n][k], At[m][k], acc[ai][bj][m][n], 0, 0, 0); __builtin_amdgcn_s_setprio(0); } while (0)
#define PG8_WAIT_V(n) asm volatile("s_waitcnt vmcnt(" #n ")" ::: "memory")
#define PG8_WAIT_L(n) asm volatile("s_waitcnt lgkmcnt(" #n ")" ::: "memory")
#define PG8_BAR __builtin_amdgcn_s_barrier()
#define PG8_SCHED __builtin_amdgcn_sched_barrier(0)
    Unit cur, nxt; int ui = 0;
    if (!S.next(0, cur)) return;
    f32x4 acc[2][2][4][2];
#pragma unroll
    for (int a = 0; a < 2; ++a)
#pragma unroll
        for (int b = 0; b < 2; ++b)
#pragma unroll
            for (int m = 0; m < 4; ++m)
#pragma unroll
                for (int n = 0; n < 2; ++n) acc[a][b][m][n] = (f32x4){0.f, 0.f, 0.f, 0.f};
    bf16x8 At[4][2], B0[2][2], B1[2][2];
    unsigned gc0[2] = {0u, 0u}, gc1[2] = {0u, 0u}, gn0[2] = {0u, 0u}, gn1[2] = {0u, 0u};
    const char* cA = S.a_base(cur); const char* cB = S.b_base(cur);
    if constexpr (GATHER) {
#pragma unroll
        for (int i = 0; i < 2; ++i) { gc0[i] = S.a_off(cur, RA[i]) + (unsigned)CA[i] * 2u; gc1[i] = S.a_off(cur, HALF + RA[i]) + (unsigned)CA[i] * 2u; }
    }
    PG8_STAGE(PG8_SB(0, 0), cB, voffB); PG8_STAGE(PG8_SB(0, 1), cB + hstepB, voffB); PG8_STAGE_A(PG8_SA(0, 0), cA, 0, c); PG8_STAGE_A(PG8_SA(0, 1), cA, 1, c);
    if (wr == 1) PG8_BAR;
    PG8_WAIT_V(2); PG8_BAR;
    PG8_STAGE(PG8_SB(1, 0), cB + kstep, voffB); PG8_STAGE_A(PG8_SA(1, 0), cA + kstep, 0, c); PG8_STAGE(PG8_SB(1, 1), cB + hstepB + kstep, voffB);
    PG8_WAIT_V(6); PG8_BAR;
#pragma unroll 1
    for (;;) {
        const bool has_next = S.next(ui + 1, nxt);
        const char* nA = has_next ? S.a_base(nxt) : cA; const char* nB = has_next ? S.b_base(nxt) : cB;
        if constexpr (GATHER) {
            if (has_next) {
#pragma unroll
                for (int i = 0; i < 2; ++i) { gn0[i] = S.a_off(nxt, RA[i]) + (unsigned)CA[i] * 2u; gn1[i] = S.a_off(nxt, HALF + RA[i]) + (unsigned)CA[i] * 2u; }
            } else {
#pragma unroll
                for (int i = 0; i < 2; ++i) { gn0[i] = gc0[i]; gn1[i] = gc1[i]; }
            }
        }
#pragma unroll 1
        for (int t = 0; t < nt; t += 2) {
            const bool last = (t == nt - 2);
            const char* a1 = cA + (size_t)(t + 1) * kstep;
            const char* a2 = last ? nA : cA + (size_t)(t + 2) * kstep; const char* b2 = last ? nB : cB + (size_t)(t + 2) * kstep;
            const char* a3 = a2 + kstep; const char* b3 = b2 + kstep;
            unsigned gx0[2], gx1[2];
#pragma unroll
            for (int i = 0; i < 2; ++i) { gx0[i] = last ? gn0[i] : gc0[i]; gx1[i] = last ? gn1[i] : gc1[i]; }
            (void)gx0; (void)gx1;
            PG8_LDB(B0, 0, 0); PG8_LDB(B1, 0, 1); PG8_SCHED; PG8_LDA(At, 0, 0); PG8_STAGE_A(PG8_SA(1, 1), a1, 1, c);
            PG8_WAIT_V(8); PG8_WAIT_L(0); PG8_BAR; PG8_MMA(0, 0, At, B0); PG8_MMA(0, 1, At, B1); PG8_BAR; PG8_SCHED;
            PG8_LDA(At, 0, 1); PG8_STAGE(PG8_SB(0, 0), b2, voffB); PG8_STAGE(PG8_SB(0, 1), b2 + hstepB, voffB); PG8_STAGE_A(PG8_SA(0, 0), a2, 0, x);
            PG8_WAIT_V(8); PG8_WAIT_L(0); PG8_BAR; PG8_MMA(1, 0, At, B0); PG8_MMA(1, 1, At, B1); PG8_BAR; PG8_SCHED;
            PG8_LDB(B0, 1, 0); PG8_LDB(B1, 1, 1); PG8_SCHED; PG8_LDA(At, 1, 0); PG8_STAGE_A(PG8_SA(0, 1), a2, 1, x);
            PG8_WAIT_V(8); PG8_WAIT_L(0); PG8_BAR; PG8_MMA(0, 0, At, B0); PG8_MMA(0, 1, At, B1); PG8_BAR; PG8_SCHED;
            PG8_LDA(At, 1, 1); PG8_STAGE(PG8_SB(1, 0), b3, voffB); PG8_STAGE(PG8_SB(1, 1), b3 + hstepB, voffB); PG8_STAGE_A(PG8_SA(1, 0), a3, 0, x);
            PG8_WAIT_V(8); PG8_WAIT_L(0); PG8_BAR; PG8_MMA(1, 0, At, B0); PG8_MMA(1, 1, At, B1); PG8_BAR; PG8_SCHED;
        }
        if (wr == 0) PG8_BAR;
        E(acc, cur, wr, wc, fr, fq);
        if (!has_next) break;
#pragma unroll
        for (int a = 0; a < 2; ++a)
#pragma unroll
            for (int b = 0; b < 2; ++b)
#pragma unroll
                for (int m = 0; m < 4; ++m)
#pragma unroll
                    for (int n = 0; n < 2; ++n) acc[a][b][m][n] = (f32x4){0.f, 0.f, 0.f, 0.f};
        cur = nxt; cA = nA; cB = nB; ++ui;
        if constexpr (GATHER) {
#pragma unroll
            for (int i = 0; i < 2; ++i) { gc0[i] = gn0[i]; gc1[i] = gn1[i]; }
        }
        if (wr == 1) PG8_BAR;
    }
    PG8_WAIT_V(0);
    PG8_BAR;
#undef PG8_SA
#undef PG8_SB
#undef PG8_STAGE
#undef PG8_STAGE_A
#undef PG8_LDA
#undef PG8_LDB
#undef PG8_MMA
#undef PG8_WAIT_V
#undef PG8_WAIT_L
#undef PG8_BAR
#undef PG8_SCHED
}
}

#define XB_TMO      128
#define XB_XCNT(j)  (256  + 64 * (j))
#define XB_XSUB(j)  (1280 + 64 * (j))
#define XB_XGEN(j)  (2304 + 64 * (j))
#define XB_TOP      3328
#define XB_TOPGEN   3392
#define XCD_BAR_WORDS 3456
#define XB_SPIN_CAP (1u << 22)
__device__ __forceinline__ unsigned xb_ld(unsigned* p)              { return __hip_atomic_load(p, __ATOMIC_RELAXED, __HIP_MEMORY_SCOPE_AGENT); }
__device__ __forceinline__ unsigned xb_add(unsigned* p, unsigned v) { return __hip_atomic_fetch_add(p, v, __ATOMIC_RELAXED, __HIP_MEMORY_SCOPE_AGENT); }
__device__ __forceinline__ unsigned xb_xcc_id() { return (unsigned)__builtin_amdgcn_s_getreg((3 << 11) | 20) & 0xFu; }
#define XB_SPIN(cond, bar) do { unsigned _sp = 0; while (cond) { __builtin_amdgcn_s_sleep(1); \
    if ((++_sp & 255u) == 0u) { if (xb_ld(&(bar)[XB_TMO])) break; if (_sp > XB_SPIN_CAP) { atomicAdd(&(bar)[XB_TMO], 1u); break; } } } } while (0)
struct XcdBarrier { unsigned* bar; unsigned x; volatile LAS unsigned* st; };
__device__ __forceinline__ XcdBarrier xcd_barrier_post(unsigned* bar, volatile LAS unsigned* st) {
    XcdBarrier b; b.bar = bar; b.x = xb_xcc_id(); b.st = st;
    if (threadIdx.x == 0) (void)xb_add(&bar[XB_XCNT(b.x)], 1u);
    return b;
}
__device__ __forceinline__ void xcd_barrier_complete(unsigned* bar, unsigned x, unsigned& nloc, unsigned& nx) {
    const unsigned G = gridDim.x * gridDim.y * gridDim.z;
    unsigned sum, cnt, mine, sp = 0u;
    for (;;) {
        sum = 0u; cnt = 0u; mine = 0u;
#pragma unroll
        for (unsigned j = 0; j < 16; ++j) { const unsigned c = xb_ld(&bar[XB_XCNT(j)]); sum += c; cnt += (c > 0u) ? 1u : 0u; mine = (j == x) ? c : mine; }
        if (sum == G) break;
        __builtin_amdgcn_s_sleep(1);
        if ((++sp & 255u) == 0u) { if (xb_ld(&bar[XB_TMO])) break; if (sp > XB_SPIN_CAP) { atomicAdd(&bar[XB_TMO], 1u); break; } }
    }
    nloc = mine > 0u ? mine : 1u; nx = cnt > 0u ? cnt : 1u;
}
__device__ __forceinline__ void xcd_barrier(const XcdBarrier& b) {
    asm volatile("s_waitcnt vmcnt(0)" ::: "memory");
    __syncthreads();
    if (threadIdx.x == 0) {
        unsigned* bar = b.bar;
        __builtin_amdgcn_s_waitcnt(0);
        unsigned nloc = b.st[0], nx = b.st[1];
        if (nloc == 0u) { xcd_barrier_complete(bar, b.x, nloc, nx); b.st[0] = nloc; b.st[1] = nx; }
        const unsigned old = xb_add(&bar[XB_XSUB(b.x)], 1u);
        const unsigned gen = old / nloc;
        if (old + 1u == (gen + 1u) * nloc) {
            __builtin_amdgcn_fence(__ATOMIC_RELEASE, "agent");
            asm volatile("s_waitcnt vmcnt(0)" ::: "memory");
            const unsigned og = xb_add(&bar[XB_TOP], 1u);
            const unsigned tg = og / nx;
            if (og + 1u == (tg + 1u) * nx) xb_add(&bar[XB_TOPGEN], 1u);
            else XB_SPIN(xb_ld(&bar[XB_TOPGEN]) == tg, bar);
            __builtin_amdgcn_fence(__ATOMIC_ACQUIRE, "agent");
            xb_add(&bar[XB_XGEN(b.x)], 1u);
            asm volatile("s_waitcnt vmcnt(0)" ::: "memory");
        } else {
            XB_SPIN(xb_ld(&bar[XB_XGEN(b.x)]) == gen, bar);
            __builtin_amdgcn_fence(__ATOMIC_ACQUIRE, "agent");
            asm volatile("s_waitcnt vmcnt(0)" ::: "memory");
        }
    }
    __syncthreads();
}

struct Frame {
    LAS unsigned char* lds;
    int tid, lane, wave, bid, G, gw, NGW;
    float* out; unsigned char* ws;
};
struct Args { const float* in[33]; float* out; unsigned char* ws; int ph_lo, ph_hi; };
#define FIN(i) (AR->in[i])
#define CAS __attribute__((address_space(4)))
typedef const CAS Args* ArgsP;
__device__ __forceinline__ ArgsP launder_args(ArgsP p) { asm volatile("" : "+s"(p)); return p; }

__device__ __forceinline__ void phase_mod(Frame& F, ArgsP AR) {
    LAS float* cs = (LAS float*)F.lds;
    LAS float* red = cs + 4096;
    const float* c = FIN(1);
    for (int i = F.tid; i < 4096; i += 512) { const float v = c[i]; cs[i] = v / (1.0f + __expf(-v)); }
    __syncthreads();
    float* MOD = (float*)(F.ws + WS_MOD);
    for (int it = F.bid; it < 192; it += F.G) {
        const int m = it / 48, n0 = (it % 48) * 64, l = m >> 1;
        const float* W = ((m & 1) ? FIN(7) : FIN(4)) + (size_t)l * 1024 * 3072;
        const float* bias = ((m & 1) ? FIN(8) : FIN(5)) + (size_t)l * 3072;
        float a0 = 0.f, a1 = 0.f, a2 = 0.f, a3 = 0.f;
        const int k0 = F.wave * 128;
#pragma unroll 8
        for (int k = k0; k < k0 + 128; ++k) {
            const float w = W[(size_t)k * 3072 + n0 + F.lane];
            a0 += cs[k] * w; a1 += cs[1024 + k] * w; a2 += cs[2048 + k] * w; a3 += cs[3072 + k] * w;
        }
        red[(F.wave * 4 + 0) * 64 + F.lane] = a0; red[(F.wave * 4 + 1) * 64 + F.lane] = a1; red[(F.wave * 4 + 2) * 64 + F.lane] = a2; red[(F.wave * 4 + 3) * 64 + F.lane] = a3;
        __syncthreads();
        if (F.tid < 256) { const int b = F.tid >> 6, n = F.tid & 63; float s = 0.f;
#pragma unroll
            for (int w = 0; w < 8; ++w) s += red[(w * 4 + b) * 64 + n];
            MOD[(size_t)(m * 4 + b) * 3072 + n0 + n] = s + bias[n0 + n]; }
        __syncthreads();
    }
}

__device__ __forceinline__ void transpose_item(const float* W, int ldw, int nvalid, int K, bf16* WT, int mode, LAS float* scr, int kb, int nb, int lane) {
    const int k0 = 64 * kb, n0 = 32 * nb;
    const int nn = n0 + (lane & 31);
#pragma unroll 8
    for (int i = 0; i < 32; ++i) { const int kk = 2 * i + (lane >> 5); scr[kk * 33 + (lane & 31)] = (nn < nvalid) ? W[(size_t)(k0 + kk) * ldw + nn] : 0.f; }
    LDS_WAIT();
    const int c = lane & 7;
#pragma unroll
    for (int j = 0; j < 4; ++j) { const int nl = (lane >> 3) + 8 * j; const LAS float* s = scr + (8 * c) * 33 + nl;
        v4u o; o.x = pk2(s[0 * 33], s[1 * 33]); o.y = pk2(s[2 * 33], s[3 * 33]); o.z = pk2(s[4 * 33], s[5 * 33]); o.w = pk2(s[6 * 33], s[7 * 33]);
        const int n = n0 + nl; const int row = (mode == 0) ? n : (256 * (n >> 7) + (n & 127) + (mode == 2 ? 128 : 0));
        *(v4u*)(WT + (size_t)row * K + k0 + 8 * c) = o; }
    LDS_WAIT();
}
__device__ __forceinline__ void phase_convert_static(Frame& F, ArgsP AR) {
    LAS float* scr = (LAS float*)(F.lds + F.wave * 16384);
    constexpr int I_IN = 16 * 56, I_OUT = 16 * 32, I_POOL = 4 * 4 * 8;
    for (int it = F.gw; it < I_IN + I_OUT + I_POOL; it += F.NGW) {
        int r = it;
        if (r < I_IN) { transpose_item(FIN(9), INW, INW, 1024, (bf16*)(F.ws + WS_WIN), 0, scr, r / 56, r % 56, F.lane); continue; } r -= I_IN;
        if (r < I_OUT) { transpose_item(FIN(10), 1024, 1024, 1024, (bf16*)(F.ws + WS_WOUT), 0, scr, r / 32, r % 32, F.lane); continue; } r -= I_OUT;
        const int g = r / 32, rr = r % 32;
        transpose_item(FIN(23) + (size_t)g * 65536, 256, 256, 256, (bf16*)(F.ws + WS_WPOOL) + (size_t)g * 65536, 0, scr, rr / 8, rr % 8, F.lane);
    }
}
__device__ __forceinline__ void phase_convert_experts(Frame& F, ArgsP AR, int l) {
    LAS float* scr = (LAS float*)(F.lds + F.wave * 16384);
    for (int it = F.gw; it < 65 * 384; it += F.NGW) {
        const int e = it / 384, r = it % 384, type = r >> 7, sub = r & 127;
        if (type < 2) {
            const float* W = (e < 64) ? (FIN(type == 0 ? 27 : 28) + (size_t)(l * 64 + e) * 1024 * 256) : (FIN(type == 0 ? 30 : 31) + (size_t)l * 1024 * 256);
            transpose_item(W, 256, 256, 1024, (bf16*)(F.ws + WS_WGU) + (size_t)e * 512 * 1024, 1 + type, scr, sub >> 3, sub & 7, F.lane);
        } else {
            const float* W = (e < 64) ? (FIN(29) + (size_t)(l * 64 + e) * 256 * 1024) : (FIN(32) + (size_t)l * 256 * 1024);
            transpose_item(W, 1024, 1024, 256, (bf16*)(F.ws + WS_WD) + (size_t)e * 1024 * 256, 0, scr, sub >> 5, sub & 31, F.lane);
        }
    }
}

__device__ __forceinline__ void phase_tables(Frame& F, ArgsP AR) {
    float* S5 = (float*)(F.ws + WS_S5T);
    const int gid = F.bid * 512 + F.tid, NT_ = F.G * 512;
    for (int i = gid; i < 2048; i += NT_) {
        const int g = i >> 6;
        const double lr = FIN(11)[i], li = FIN(12)[i], dt = exp((double)FIN(13)[g]);
        const double mag = exp(lr * dt), ar = mag * cos(li * dt), ai = mag * sin(li * dt);
        const double nr = ar - 1.0, ni = ai, den = lr * lr + li * li;
        const double cr = (nr * lr + ni * li) / den, ci = (ni * lr - nr * li) / den;
        S5[S5_ABAR + 2 * i] = (float)ar; S5[S5_ABAR + 2 * i + 1] = (float)ai;
        double pr = ar, pi = ai;
        for (int s = 0; s < 6; ++s) { const double t = pr * pr - pi * pi; pi = 2.0 * pr * pi; pr = t; }
        S5[S5_A64 + 2 * i] = (float)pr; S5[S5_A64 + 2 * i + 1] = (float)pi;
        for (int h = 0; h < 16; ++h) { const double br = FIN(14)[i * 16 + h], bi = FIN(15)[i * 16 + h];
            S5[S5_BBR + i * 16 + h] = (float)(cr * br - ci * bi); S5[S5_BBI + i * 16 + h] = (float)(cr * bi + ci * br); }
    }
    float* ROPE = (float*)(F.ws + WS_ROPE);
    const int* pos = (const int*)FIN(2);
    for (int i = gid; i < T * 8; i += NT_) {
        const int t = i >> 3, j = i & 7;
        const float inv = (float)pow(500000.0, -(double)(2 * j) / 16.0);
        const float ang = (float)pos[t] * inv;
        ROPE[2 * i] = (float)cos((double)ang); ROPE[2 * i + 1] = (float)sin((double)ang);
    }
}

__device__ __forceinline__ void phase_norm_mod(Frame& F, const float* X, const float* gamma, int m, bf16* Hout, float* Hf) {
    const float* MOD = (const float*)(F.ws + WS_MOD);
    for (int row = F.gw; row < T; row += F.NGW) {
        const int b = row >> 12;
        const float* shift = MOD + (size_t)(m * 4 + b) * 3072; const float* scale = shift + 1024;
        const f32x4* xr = (const f32x4*)(X + (size_t)row * D) + F.lane;
        f32x4 v[4]; float ss = 0.f;
#pragma unroll
        for (int j = 0; j < 4; ++j) { v[j] = xr[64 * j]; ss += v[j].x * v[j].x + v[j].y * v[j].y + v[j].z * v[j].z + v[j].w * v[j].w; }
        const float rstd = rsqrtf(wave_sum(ss) * (1.0f / D) + 1e-6f);
#pragma unroll
        for (int j = 0; j < 4; ++j) {
            const int c0 = 4 * F.lane + 256 * j;
            const f32x4 gg = *(const f32x4*)(gamma + c0), sc = *(const f32x4*)(scale + c0), sh = *(const f32x4*)(shift + c0);
            f32x4 h; h.x = v[j].x * rstd * gg.x * (1.f + sc.x) + sh.x; h.y = v[j].y * rstd * gg.y * (1.f + sc.y) + sh.y;
            h.z = v[j].z * rstd * gg.z * (1.f + sc.z) + sh.z; h.w = v[j].w * rstd * gg.w * (1.f + sc.w) + sh.w;
            if (Hout) { v2u o; o.x = pk2(h.x, h.y); o.y = pk2(h.z, h.w); *(v2u*)(Hout + (size_t)row * D + c0) = o; }
            if (Hf) *(f32x4*)(Hf + (size_t)row * D + c0) = h;
        }
    }
}

struct DenseOrder {
    const char* A; const char* Bt; unsigned lda_b, ldb_b; int nM, nN, nU, chunk, x, q0, qs;
    __device__ __forceinline__ void init(const void* A_, const void* Bt_, unsigned lda, unsigned ldb, int M, int N, int G, int c) {
        A = (const char*)A_; Bt = (const char*)Bt_; lda_b = lda; ldb_b = ldb; nM = M / 256; nN = N / 256; nU = nM * nN; chunk = (nU + 7) / 8; x = c & 7; q0 = c >> 3; qs = G >> 3; }
    __device__ __forceinline__ bool next(int i, pg8::Unit& u) const {
        const int q = i * qs + q0; if (q >= chunk) return false; const int L = x * chunk + q; if (L >= nU) return false;
        u.pm = L / nN; u.pn = L % nN; u.e = 0; u.rows = 256; return true; }
    __device__ __forceinline__ const char* a_base(const pg8::Unit& u) const { return A + (size_t)u.pm * 256 * lda_b; }
    __device__ __forceinline__ const char* b_base(const pg8::Unit& u) const { return Bt + (size_t)u.pn * 256 * ldb_b; }
    __device__ __forceinline__ unsigned a_off(const pg8::Unit&, int) const { return 0u; }
};
struct PoolOrder {
    const char* A; const char* Bt; int nU, chunk, x, q0, qs;
    __device__ __forceinline__ void init(const void* A_, const void* Bt_, int G, int c) { A = (const char*)A_; Bt = (const char*)Bt_; nU = 64 * 4; chunk = (nU + 7) / 8; x = c & 7; q0 = c >> 3; qs = G >> 3; }
    __device__ __forceinline__ bool next(int i, pg8::Unit& u) const {
        const int q = i * qs + q0; if (q >= chunk) return false; const int L = x * chunk + q; if (L >= nU) return false;
        u.pm = L >> 2; u.pn = L & 3; u.e = L & 3; u.rows = 256; return true; }
    __device__ __forceinline__ const char* a_base(const pg8::Unit& u) const { return A + (size_t)u.pm * 256 * 2048 + (size_t)u.e * 512; }
    __device__ __forceinline__ const char* b_base(const pg8::Unit& u) const { return Bt + (size_t)u.e * 256 * 512; }
    __device__ __forceinline__ unsigned a_off(const pg8::Unit&, int) const { return 0u; }
};
template <int NPN, bool GATE_UP>
struct MoeOrder {
    const unsigned* ctl; int l; const unsigned char* ws; int ntr, ntiles, nU, chunk, x, q0, qs; bool with_shared;
    __device__ __forceinline__ void init(const unsigned* ctl_, int l_, const unsigned char* ws_, bool shared_only, bool with_sh, int G, int c) {
        ctl = ctl_; l = l_; ws = ws_; with_shared = with_sh;
        ntr = shared_only ? 0 : (int)ctl[CW_NT + l]; ntiles = ntr + (with_sh ? 64 : 0); nU = ntiles * NPN; chunk = (nU + 7) / 8; x = c & 7; q0 = c >> 3; qs = G >> 3; }
    __device__ __forceinline__ bool next(int i, pg8::Unit& u) const {
        const int q = i * qs + q0; if (q >= chunk) return false; const int L = x * chunk + q; if (L >= nU) return false;
        const int tile = L / NPN; u.pn = L % NPN;
        if (tile < ntr) { u.e = (int)ctl[CW_TE + l * 1024 + tile]; u.pm = (int)ctl[CW_TJ + l * 1024 + tile]; const int cnt = (int)ctl[CW_CNT + l * 64 + u.e]; const int rem = cnt - 256 * u.pm; u.rows = rem < 256 ? rem : 256; }
        else { u.e = 64; u.pm = tile - ntr; u.rows = 256; }
        return true; }
    __device__ __forceinline__ int row0(const pg8::Unit& u) const { return (u.e < 64) ? (int)ctl[CW_EST + l * 128 + u.e] + 256 * u.pm : 256 * u.pm; }
    __device__ __forceinline__ const char* a_base(const pg8::Unit& u) const {
        if (GATE_UP) return (const char*)(ws + WS_H);
        return (u.e < 64) ? (const char*)(ws + BG_HB) + (size_t)row0(u) * 512 : (const char*)(ws + BG_HBSH) + (size_t)row0(u) * 512; }
    __device__ __forceinline__ const char* b_base(const pg8::Unit& u) const {
        if (GATE_UP) return (const char*)(ws + WS_WGU) + (size_t)u.e * 512 * 2048 + (size_t)u.pn * 256 * 2048;
        return (const char*)(ws + WS_WD) + (size_t)u.e * 1024 * 512 + (size_t)u.pn * 256 * 512; }
    __device__ __forceinline__ unsigned a_off(const pg8::Unit& u, int r) const {
        int tok;
        if (u.e < 64) { const int* elt = (const int*)(ws + WS_ELT) + (size_t)u.e * ECAP + 256 * u.pm; tok = (r < u.rows) ? elt[r] : 0; }
        else tok = 256 * u.pm + r;
        return (unsigned)tok * 2048u; }
};

struct EpiF32Store { float* C; int ldc;
    __device__ __forceinline__ void operator()(const pg8::f32x4 (&acc)[2][2][4][2], const pg8::Unit& u, int wr, int wc, int fr, int fq) const {
#pragma unroll
        for (int ai = 0; ai < 2; ++ai)
#pragma unroll
            for (int m = 0; m < 4; ++m) { float* rowp = C + (size_t)(u.pm * 256 + ai * 128 + wr * 64 + m * 16 + fr) * ldc + u.pn * 256 + wc * 32 + 4 * fq;
#pragma unroll
                for (int bj = 0; bj < 2; ++bj)
#pragma unroll
                    for (int n = 0; n < 2; ++n) *(f32x4*)(rowp + bj * 128 + n * 16) = acc[ai][bj][m][n]; }
    }
};
struct EpiResidual { const float* Xin; float* X; const float* gate; const float* colscale; int col_from_e;
    __device__ __forceinline__ void operator()(const pg8::f32x4 (&acc)[2][2][4][2], const pg8::Unit& u, int wr, int wc, int fr, int fq) const {
        const int cbase = (col_from_e ? u.e * 256 : u.pn * 256) + wc * 32 + 4 * fq;
#pragma unroll
        for (int ai = 0; ai < 2; ++ai)
#pragma unroll
            for (int m = 0; m < 4; ++m) { const int row = u.pm * 256 + ai * 128 + wr * 64 + m * 16 + fr; const int b = row >> 12;
#pragma unroll
                for (int bj = 0; bj < 2; ++bj)
#pragma unroll
                    for (int n = 0; n < 2; ++n) { const int col = cbase + bj * 128 + n * 16; const size_t o = (size_t)row * D + col;
                        f32x4 g = *(const f32x4*)(gate + (size_t)b * 3072 + col); if (colscale) { const f32x4 cs = *(const f32x4*)(colscale + col); g = g * cs; }
                        const f32x4 xi = *(const f32x4*)(Xin + o); *(f32x4*)(X + o) = xi + g * acc[ai][bj][m][n]; } }
    }
};
template <class Order> struct EpiGateUp { const Order* S; unsigned char* ws;
    __device__ __forceinline__ void operator()(const pg8::f32x4 (&acc)[2][2][4][2], const pg8::Unit& u, int wr, int wc, int fr, int fq) const {
        const int r0 = S->row0(u); bf16* HB = (bf16*)(ws + (u.e < 64 ? BG_HB : BG_HBSH));
        const float* elw = (const float*)(ws + WS_ELW) + (size_t)(u.e < 64 ? u.e : 0) * ECAP + 256 * u.pm;
#pragma unroll
        for (int ai = 0; ai < 2; ++ai)
#pragma unroll
            for (int m = 0; m < 4; ++m) { const int r = ai * 128 + wr * 64 + m * 16 + fr;
                if (r < u.rows) { const float w = (u.e < 64) ? elw[r] : 1.0f; bf16* rowp = HB + (size_t)(r0 + r) * 256 + u.pn * 128 + wc * 32 + 4 * fq;
#pragma unroll
                    for (int n = 0; n < 2; ++n) { const f32x4 g = acc[ai][0][m][n], up = acc[ai][1][m][n]; f32x4 h;
                        h.x = g.x * sigmoidf_(g.x) * up.x * w; h.y = g.y * sigmoidf_(g.y) * up.y * w; h.z = g.z * sigmoidf_(g.z) * up.z * w; h.w = g.w * sigmoidf_(g.w) * up.w * w;
                        v2u o; o.x = pk2(h.x, h.y); o.y = pk2(h.z, h.w); *(v2u*)(rowp + n * 16) = o; } } }
    }
};
template <class Order, bool SHARED> struct EpiDown { const Order* S; unsigned char* ws; float* X; const float* gate;
    __device__ __forceinline__ void operator()(const pg8::f32x4 (&acc)[2][2][4][2], const pg8::Unit& u, int wr, int wc, int fr, int fq) const {
        const int r0 = S->row0(u); bf16* Y = (bf16*)(ws + BG_Y);
#pragma unroll
        for (int ai = 0; ai < 2; ++ai)
#pragma unroll
            for (int m = 0; m < 4; ++m) { const int r = ai * 128 + wr * 64 + m * 16 + fr;
                if (r < u.rows) {
#pragma unroll
                    for (int bj = 0; bj < 2; ++bj)
#pragma unroll
                        for (int n = 0; n < 2; ++n) { const int col = u.pn * 256 + bj * 128 + wc * 32 + n * 16 + 4 * fq; const f32x4 a = acc[ai][bj][m][n];
                            if constexpr (!SHARED) { v2u o; o.x = pk2(a.x, a.y); o.y = pk2(a.z, a.w); *(v2u*)(Y + (size_t)(r0 + r) * D + col) = o; }
                            else { const int tok = r0 + r; const size_t o = (size_t)tok * D + col; const f32x4 g = *(const f32x4*)(gate + (size_t)(tok >> 12) * 3072 + col);
                                const f32x4 xi = *(const f32x4*)(X + o); *(f32x4*)(X + o) = xi + g * a; } } }
                asm volatile("" ::: "memory"); }
    }
};

__device__ __forceinline__ void phase_postproj(Frame& F, ArgsP AR) {
    const float* PROJ = (const float*)(F.ws + BG_PROJ); const float* ROPE = (const float*)(F.ws + WS_ROPE);
    float* U = (float*)(F.ws + BG_U); bf16* Q = (bf16*)(F.ws + BG_Q); bf16* QI = (bf16*)(F.ws + BG_QI); bf16* Kb = (bf16*)(F.ws + BG_K); bf16* Vb = (bf16*)(F.ws + BG_V); bf16* KIb = (bf16*)(F.ws + BG_KI); float* WI = (float*)(F.ws + BG_WI);
    const float qg = FIN(21)[F.lane], kg = FIN(22)[F.lane];
    const int lane = F.lane;
    for (int t = F.gw; t < T; t += F.NGW) {
        const float* p = PROJ + (size_t)t * INP;
        const float cs = ROPE[(size_t)t * 16 + 2 * (lane & 7)], sn = ROPE[(size_t)t * 16 + 2 * (lane & 7) + 1];
#pragma unroll
        for (int j = 0; j < 8; ++j) U[(size_t)t * 512 + j * 64 + lane] = p[j * 64 + lane];
        auto rope = [&](float y) -> float { const float yp = __shfl_xor(y, 8); float o = y; if (lane < 8) o = y * cs - yp * sn; else if (lane < 16) o = yp * sn + y * cs; return o; };
#pragma unroll
        for (int h = 0; h < 8; ++h) { const float x = p[512 + h * 64 + lane]; const float rstd = rsqrtf(wave_sum(x * x) * (1.0f / 64.0f) + 1e-6f);
            Q[(size_t)t * 512 + h * 64 + lane] = (bf16)f2bf(rope(x * rstd * qg)); }
        { const float x = p[1024 + lane]; const float rstd = rsqrtf(wave_sum(x * x) * (1.0f / 64.0f) + 1e-6f); Kb[(size_t)t * 64 + lane] = (bf16)f2bf(rope(x * rstd * kg)); }
        Vb[(size_t)t * 64 + lane] = (bf16)f2bf(p[1088 + lane]);
#pragma unroll
        for (int h = 0; h < 8; ++h) QI[(size_t)t * 512 + h * 64 + lane] = (bf16)f2bf(rope(p[1152 + h * 64 + lane]));
        KIb[(size_t)t * 64 + lane] = (bf16)f2bf(rope(p[1664 + lane]));
        if (lane < 8) WI[(size_t)t * 8 + lane] = p[1728 + lane] * 0.35355339059327373f;
    }
}

__device__ __forceinline__ void phase_s5a(Frame& F, ArgsP AR) {
    const float* S5 = (const float*)(F.ws + WS_S5T); const float* U = (const float*)(F.ws + BG_U); float* SLOC = (float*)(F.ws + BG_SLOC);
    const int p = F.lane;
    for (int it = F.gw; it < 4 * 32 * 64; it += F.NGW) {
        const int c = it & 63, g = (it >> 6) & 31, b = it >> 11;
        const float ar = S5[S5_ABAR + 2 * (g * 64 + p)], ai = S5[S5_ABAR + 2 * (g * 64 + p) + 1];
        float br[16], bi[16];
#pragma unroll
        for (int h = 0; h < 16; ++h) { br[h] = S5[S5_BBR + (g * 64 + p) * 16 + h]; bi[h] = S5[S5_BBI + (g * 64 + p) * 16 + h]; }
        float sr = 0.f, si = 0.f;
        const float* up = U + ((size_t)b * SEQ + c * 64) * 512 + g * 16;
        for (int tau = 0; tau < 64; ++tau) {
            float bur = 0.f, bui = 0.f;
#pragma unroll
            for (int h = 0; h < 16; ++h) { const float u = up[(size_t)tau * 512 + h]; bur += br[h] * u; bui += bi[h] * u; }
            const float nr = ar * sr - ai * si + bur, ni = ar * si + ai * sr + bui; sr = nr; si = ni;
        }
        SLOC[((size_t)it * 64 + p) * 2] = sr; SLOC[((size_t)it * 64 + p) * 2 + 1] = si;
    }
}
__device__ __forceinline__ void phase_s5b(Frame& F, ArgsP AR) {
    const float* S5 = (const float*)(F.ws + WS_S5T); const float* SLOC = (const float*)(F.ws + BG_SLOC); float* SIN = (float*)(F.ws + BG_SIN);
    const int gid = F.bid * 512 + F.tid;
    for (int i = gid; i < 4 * 32 * 64; i += F.G * 512) {
        const int p = i & 63, g = (i >> 6) & 31, b = i >> 11;
        const float ar = S5[S5_A64 + 2 * (g * 64 + p)], ai = S5[S5_A64 + 2 * (g * 64 + p) + 1];
        float sr = 0.f, si = 0.f;
        for (int c = 0; c < 64; ++c) {
            const size_t o = ((((size_t)b * 32 + g) * 64 + c) * 64 + p) * 2;
            SIN[o] = sr; SIN[o + 1] = si;
            const float lr = SLOC[o], li = SLOC[o + 1];
            const float nr = ar * sr - ai * si + lr, ni = ar * si + ai * sr + li; sr = nr; si = ni;
        }
    }
}
__device__ __forceinline__ void phase_s5c(Frame& F, ArgsP AR) {
    const float* S5 = (const float*)(F.ws + WS_S5T); const float* U = (const float*)(F.ws + BG_U); const float* SIN = (const float*)(F.ws + BG_SIN); bf16* MIX = (bf16*)(F.ws + BG_MIX);
    const float* cre = FIN(16); const float* cim = FIN(17); const float* dsk = FIN(18); const float* gluw = FIN(19); const float* glub = FIN(20);
    LAS float* st = (LAS float*)(F.lds + F.wave * 10240);
    LAS float* yg = st + 2048;
    const int p = F.lane, h = F.lane & 15, tq = F.lane >> 4;
    for (int it = F.gw; it < 4 * 32 * 64; it += F.NGW) {
        const int c = it & 63, g = (it >> 6) & 31, b = it >> 11;
        const float ar = S5[S5_ABAR + 2 * (g * 64 + p)], ai = S5[S5_ABAR + 2 * (g * 64 + p) + 1];
        float br[16], bi[16];
#pragma unroll
        for (int hh = 0; hh < 16; ++hh) { br[hh] = S5[S5_BBR + (g * 64 + p) * 16 + hh]; bi[hh] = S5[S5_BBI + (g * 64 + p) * 16 + hh]; }
        float sr = SIN[((size_t)it * 64 + p) * 2], si = SIN[((size_t)it * 64 + p) * 2 + 1];
        const size_t trow0 = (size_t)b * SEQ + c * 64;
        const float dd = dsk[g * 16 + h], gb = glub[g * 16 + h];
        for (int sub = 0; sub < 4; ++sub) {
            const float* up = U + (trow0 + sub * 16) * 512 + g * 16;
            for (int tau = 0; tau < 16; ++tau) {
                float bur = 0.f, bui = 0.f;
#pragma unroll
                for (int hh = 0; hh < 16; ++hh) { const float u = up[(size_t)tau * 512 + hh]; bur += br[hh] * u; bui += bi[hh] * u; }
                const float nr = ar * sr - ai * si + bur, ni = ar * si + ai * sr + bui; sr = nr; si = ni;
                st[(tau * 64 + p) * 2] = sr; st[(tau * 64 + p) * 2 + 1] = si;
            }
            LDS_WAIT();
            float y[4];
#pragma unroll
            for (int j = 0; j < 4; ++j) { const int tau = tq + 4 * j; float a = 0.f;
                for (int pp = 0; pp < 64; ++pp) a += cre[(g * 16 + h) * 64 + pp] * st[(tau * 64 + pp) * 2] - cim[(g * 16 + h) * 64 + pp] * st[(tau * 64 + pp) * 2 + 1];
                a += dd * up[(size_t)tau * 512 + h];
                const float ge = 0.5f * a * (1.0f + tanhf(0.7978845608028654f * (a + 0.044715f * a * a * a)));
                y[j] = ge; yg[tau * 16 + h] = ge; }
            LDS_WAIT();
#pragma unroll
            for (int j = 0; j < 4; ++j) { const int tau = tq + 4 * j; float z = gb;
#pragma unroll
                for (int hh = 0; hh < 16; ++hh) z += yg[tau * 16 + hh] * gluw[(g * 16 + hh) * 16 + h];
                MIX[(trow0 + sub * 16 + tau) * D + g * 16 + h] = (bf16)f2bf(y[j] * sigmoidf_(z)); }
            LDS_WAIT();
        }
    }
}

__device__ __forceinline__ unsigned fkey(float f) { const unsigned u = __builtin_bit_cast(unsigned, f); return (u & 0x80000000u) ? ~u : (u | 0x80000000u); }
__device__ __forceinline__ void phase_dsa(Frame& F, ArgsP AR) {
    const bf16* Q = (const bf16*)(F.ws + BG_Q); const bf16* QI = (const bf16*)(F.ws + BG_QI); const bf16* Kb = (const bf16*)(F.ws + BG_K); const bf16* Vb = (const bf16*)(F.ws + BG_V);
    const bf16* KIb = (const bf16*)(F.ws + BG_KI); const float* WI = (const float*)(F.ws + BG_WI); bf16* MIX = (bf16*)(F.ws + BG_MIX);
    LAS unsigned char* wl = F.lds + F.wave * 19456;
    LAS float* sc = (LAS float*)wl;
    LAS float* qf = (LAS float*)(wl + 16384);
    LAS int* list = (LAS int*)(wl + 16384 + 2048);
    const int lane = F.lane;
#pragma unroll 1
    for (int it = F.bid; it < T / 8; it += F.G) {
        const int t = (T / 8 - 1 - it) * 8 + F.wave;
        const int b = t >> 12, tp = t & 4095, n = tp + 1;
        const size_t kb0 = (size_t)b * SEQ;
#pragma unroll
        for (int j = 0; j < 8; ++j) qf[j * 64 + lane] = bf2f(QI[(size_t)t * 512 + j * 64 + lane]);
        float wv[8];
#pragma unroll
        for (int h = 0; h < 8; ++h) wv[h] = WI[(size_t)t * 8 + h];
        LDS_WAIT();
#pragma unroll 1
        for (int s0 = 0; s0 < n; s0 += 64) {
            asm volatile("" ::: "memory");
            const int s = s0 + lane;
            float score = -INFINITY;
            if (s < n) {
                const v4u* kp = (const v4u*)(KIb + (kb0 + s) * 64);
                float dh[8];
#pragma unroll
                for (int h = 0; h < 8; ++h) dh[h] = 0.f;
#pragma unroll 1
                for (int half = 0; half < 2; ++half) {
                    asm volatile("" ::: "memory");
                    float kf[32];
#pragma unroll
                    for (int i = 0; i < 4; ++i) { const v4u w = kp[half * 4 + i]; kf[8 * i] = bflo(w.x); kf[8 * i + 1] = bfhi(w.x); kf[8 * i + 2] = bflo(w.y); kf[8 * i + 3] = bfhi(w.y); kf[8 * i + 4] = bflo(w.z); kf[8 * i + 5] = bfhi(w.z); kf[8 * i + 6] = bflo(w.w); kf[8 * i + 7] = bfhi(w.w); }
#pragma unroll
                    for (int h = 0; h < 8; ++h) { float d = 0.f;
#pragma unroll
                        for (int i = 0; i < 8; ++i) { const f32x4 qv = *(const LAS f32x4*)(qf + h * 64 + half * 32 + 4 * i); d += qv.x * kf[4 * i] + qv.y * kf[4 * i + 1] + qv.z * kf[4 * i + 2] + qv.w * kf[4 * i + 3]; }
                        dh[h] += d; __builtin_amdgcn_sched_barrier(0); }
                }
                float a = 0.f;
#pragma unroll
                for (int h = 0; h < 8; ++h) a += wv[h] * fmaxf(dh[h] * 0.125f, 0.f);
                score = a;
            }
            sc[s] = score;
        }
        LDS_WAIT();
        int nsel;
        if (n <= 256) { for (int i = lane; i < n; i += 64) list[i] = i; nsel = n; }
        else {
            const int nch = (n + 63) >> 6;
            unsigned thr = 0u;
#pragma unroll 1
            for (int bit = 31; bit >= 0; --bit) {
                const unsigned cand = thr | (1u << bit); int cnt = 0;
#pragma unroll 1
                for (int j = 0; j < nch; ++j) { const int s = j * 64 + lane; if (s < n) cnt += (fkey(sc[s]) >= cand) ? 1 : 0; }
                cnt = wave_sum_i(cnt);
                if (cnt >= 256) thr = cand;
            }
            int cgt = 0;
            for (int j = 0; j < nch; ++j) { const int s = j * 64 + lane; if (s < n) cgt += (fkey(sc[s]) > thr) ? 1 : 0; }
            cgt = wave_sum_i(cgt);
            const int need_eq = 256 - cgt;
            int run = 0, eqrun = 0;
            const unsigned long long lt = (lane == 0) ? 0ull : (~0ull >> (64 - lane));
            for (int j = 0; j < nch; ++j) {
                const int s = j * 64 + lane; const bool in = s < n; const unsigned k = in ? fkey(sc[s]) : 0u;
                const bool gt = in && k > thr, eq = in && k == thr;
                const unsigned long long beq = __ballot(eq);
                const int myeq = eqrun + __popcll(beq & lt);
                const bool sel = gt || (eq && myeq < need_eq);
                const unsigned long long bs = __ballot(sel);
                if (sel) list[run + __popcll(bs & lt)] = s;
                run += __popcll(bs); eqrun += __popcll(beq);
            }
            nsel = run;
        }
        LDS_WAIT();
#pragma unroll
        for (int j = 0; j < 8; ++j) qf[j * 64 + lane] = bf2f(Q[(size_t)t * 512 + j * 64 + lane]);
        LDS_WAIT();
        float mx[8];
#pragma unroll
        for (int h = 0; h < 8; ++h) mx[h] = -INFINITY;
#pragma unroll 1
        for (int i0 = 0; i0 < nsel; i0 += 64) {
            asm volatile("" ::: "memory");
            const int i = i0 + lane;
            if (i < nsel) {
                const int s = list[i];
                const v4u* kp = (const v4u*)(Kb + (kb0 + s) * 64);
                float dh[8];
#pragma unroll
                for (int h = 0; h < 8; ++h) dh[h] = 0.f;
#pragma unroll 1
                for (int half = 0; half < 2; ++half) {
                    asm volatile("" ::: "memory");
                    float kf[32];
#pragma unroll
                    for (int q = 0; q < 4; ++q) { const v4u w = kp[half * 4 + q]; kf[8 * q] = bflo(w.x); kf[8 * q + 1] = bfhi(w.x); kf[8 * q + 2] = bflo(w.y); kf[8 * q + 3] = bfhi(w.y); kf[8 * q + 4] = bflo(w.z); kf[8 * q + 5] = bfhi(w.z); kf[8 * q + 6] = bflo(w.w); kf[8 * q + 7] = bfhi(w.w); }
#pragma unroll
                    for (int h = 0; h < 8; ++h) { float d = 0.f;
#pragma unroll
                        for (int q = 0; q < 8; ++q) { const f32x4 qv = *(const LAS f32x4*)(qf + h * 64 + half * 32 + 4 * q); d += qv.x * kf[4 * q] + qv.y * kf[4 * q + 1] + qv.z * kf[4 * q + 2] + qv.w * kf[4 * q + 3]; }
                        dh[h] += d; __builtin_amdgcn_sched_barrier(0); }
                }
#pragma unroll
                for (int h = 0; h < 8; ++h) { const float d = dh[h] * 0.125f; sc[i * 8 + h] = d; mx[h] = fmaxf(mx[h], d); }
            }
        }
        float lsum[8];
#pragma unroll
        for (int h = 0; h < 8; ++h) { mx[h] = wave_max(mx[h]); lsum[h] = 0.f; }
        LDS_WAIT();
        for (int i0 = 0; i0 < nsel; i0 += 64) {
            const int i = i0 + lane;
            if (i < nsel) {
#pragma unroll
                for (int h = 0; h < 8; ++h) { const float pv = __expf(sc[i * 8 + h] - mx[h]); sc[i * 8 + h] = pv; lsum[h] += pv; }
            }
        }
#pragma unroll
        for (int h = 0; h < 8; ++h) lsum[h] = wave_sum(lsum[h]);
        LDS_WAIT();
        float o[8];
#pragma unroll
        for (int h = 0; h < 8; ++h) o[h] = 0.f;
#pragma unroll 2
        for (int i = 0; i < nsel; ++i) {
            const int s = list[i];
            const float v = bf2f(Vb[(kb0 + s) * 64 + lane]);
            const f32x4 p0 = *(const LAS f32x4*)(sc + i * 8), p1 = *(const LAS f32x4*)(sc + i * 8 + 4);
            o[0] += p0.x * v; o[1] += p0.y * v; o[2] += p0.z * v; o[3] += p0.w * v; o[4] += p1.x * v; o[5] += p1.y * v; o[6] += p1.z * v; o[7] += p1.w * v;
        }
#pragma unroll
        for (int h = 0; h < 8; ++h) MIX[(size_t)t * D + 512 + h * 64 + lane] = (bf16)f2bf(o[h] / lsum[h]);
        LDS_WAIT();
    }
}

__device__ __forceinline__ void phase_router(Frame& F, ArgsP AR, int l) {
    const float* X = F.out; const float* gamma = FIN(6) + (size_t)l * D; const int m = 2 * l + 1;
    const float* MOD = (const float*)(F.ws + WS_MOD); const float* RW = FIN(25) + (size_t)l * D * 64; const float* RB = FIN(26) + (size_t)l * 64;
    bf16* Hout = (bf16*)(F.ws + WS_H); unsigned* ctl = (unsigned*)(F.ws + WS_CTL);
    int* EIDX = (int*)(F.ws + WS_EIDX); int* SLOT = (int*)(F.ws + WS_SLOT); int* ELT = (int*)(F.ws + WS_ELT); float* ELW = (float*)(F.ws + WS_ELW);
    LAS float* hrow = (LAS float*)(F.lds + F.wave * 4096);
    const int lane = F.lane;
    const float rb = RB[lane];
    for (int row = F.gw; row < T; row += F.NGW) {
        const int b = row >> 12;
        const float* shift = MOD + (size_t)(m * 4 + b) * 3072; const float* scale = shift + 1024;
        const f32x4* xr = (const f32x4*)(X + (size_t)row * D) + lane;
        f32x4 v[4]; float ss = 0.f;
#pragma unroll
        for (int j = 0; j < 4; ++j) { v[j] = xr[64 * j]; ss += v[j].x * v[j].x + v[j].y * v[j].y + v[j].z * v[j].z + v[j].w * v[j].w; }
        const float rstd = rsqrtf(wave_sum(ss) * (1.0f / D) + 1e-6f);
#pragma unroll
        for (int j = 0; j < 4; ++j) {
            const int c0 = 4 * lane + 256 * j;
            const f32x4 gg = *(const f32x4*)(gamma + c0), sc = *(const f32x4*)(scale + c0), sh = *(const f32x4*)(shift + c0);
            f32x4 h; h.x = v[j].x * rstd * gg.x * (1.f + sc.x) + sh.x; h.y = v[j].y * rstd * gg.y * (1.f + sc.y) + sh.y;
            h.z = v[j].z * rstd * gg.z * (1.f + sc.z) + sh.z; h.w = v[j].w * rstd * gg.w * (1.f + sc.w) + sh.w;
            v2u o; o.x = pk2(h.x, h.y); o.y = pk2(h.z, h.w); *(v2u*)(Hout + (size_t)row * D + c0) = o;
            *(LAS f32x4*)(hrow + c0) = h;
        }
        LDS_WAIT();
        float a0 = 0.f, a1 = 0.f, a2 = 0.f, a3 = 0.f;
#pragma unroll 4
        for (int k = 0; k < 1024; k += 4) { const f32x4 hv = *(const LAS f32x4*)(hrow + k);
            a0 += hv.x * RW[(size_t)k * 64 + lane]; a1 += hv.y * RW[(size_t)(k + 1) * 64 + lane]; a2 += hv.z * RW[(size_t)(k + 2) * 64 + lane]; a3 += hv.w * RW[(size_t)(k + 3) * 64 + lane]; }
        const float score = sigmoidf_((a0 + a1) + (a2 + a3));
        const float sel = score + rb;
        float m1 = sel; m1 = fmaxf(m1, __shfl_xor(m1, 1)); m1 = fmaxf(m1, __shfl_xor(m1, 2)); m1 = fmaxf(m1, __shfl_xor(m1, 4));
        const unsigned long long bm = __ballot(sel == m1);
        const int g = lane >> 3; const unsigned gm = (unsigned)((bm >> (8 * g)) & 0xffull); const int first = 8 * g + __builtin_ctz(gm);
        float m2 = (lane == first) ? -INFINITY : sel; m2 = fmaxf(m2, __shfl_xor(m2, 1)); m2 = fmaxf(m2, __shfl_xor(m2, 2)); m2 = fmaxf(m2, __shfl_xor(m2, 4));
        const float gs = m1 + m2;
        int grank = 0;
#pragma unroll
        for (int gg = 0; gg < 8; ++gg) { const float o = __shfl(gs, gg * 8); grank += (o > gs || (o == gs && gg < g)) ? 1 : 0; }
        const float masked = (grank < 4) ? sel : -INFINITY;
        int rank = 0;
        for (int e = 0; e < 64; ++e) { const float o = __shfl(masked, e); rank += (o > masked || (o == masked && e < lane)) ? 1 : 0; }
        const bool chosen = rank < 8;
        const float wsum = wave_sum(chosen ? score : 0.f);
        if (chosen) {
            const float gwt = score / wsum * 2.5f;
            const unsigned pos = atomicAdd(&ctl[CW_CNT + l * 64 + lane], 1u);
            ELT[(size_t)lane * ECAP + pos] = row; ELW[(size_t)lane * ECAP + pos] = gwt;
            EIDX[(size_t)row * 8 + rank] = lane; SLOT[(size_t)row * 8 + rank] = (int)pos;
        }
        LDS_WAIT();
    }
}
__device__ __forceinline__ void phase_offsets(Frame& F, int l) {
    if (F.bid == 0 && F.tid == 0) {
        unsigned* ctl = (unsigned*)(F.ws + WS_CTL);
        unsigned run = 0, nt = 0;
        for (int e = 0; e < 64; ++e) { const unsigned c = ctl[CW_CNT + l * 64 + e]; ctl[CW_EST + l * 128 + e] = run; run += c;
            const unsigned ntl = (c + 255u) / 256u; for (unsigned j = 0; j < ntl; ++j) { ctl[CW_TE + l * 1024 + nt] = (unsigned)e; ctl[CW_TJ + l * 1024 + nt] = j; ++nt; } }
        ctl[CW_EST + l * 128 + 64] = run; ctl[CW_NT + l] = nt;
    }
}
__device__ __forceinline__ void phase_combine(Frame& F, int l) {
    const unsigned* ctl = (const unsigned*)(F.ws + WS_CTL); const int* EIDX = (const int*)(F.ws + WS_EIDX); const int* SLOT = (const int*)(F.ws + WS_SLOT);
    const bf16* Y = (const bf16*)(F.ws + BG_Y); const float* gate = (const float*)(F.ws + WS_MOD) + (size_t)((2 * l + 1) * 4) * 3072 + 2048; float* X = F.out;
    for (int row = F.gw; row < T; row += F.NGW) {
        const int b = row >> 12;
        f32x4 a[4];
#pragma unroll
        for (int j = 0; j < 4; ++j) a[j] = (f32x4){0.f, 0.f, 0.f, 0.f};
        for (int k = 0; k < 8; ++k) {
            const int e = EIDX[(size_t)row * 8 + k], pos = SLOT[(size_t)row * 8 + k];
            const size_t r = (size_t)ctl[CW_EST + l * 128 + e] + pos;
            const v2u* yp = (const v2u*)(Y + r * D) + F.lane;
#pragma unroll
            for (int j = 0; j < 4; ++j) { const v2u w = yp[64 * j]; a[j].x += bflo(w.x); a[j].y += bfhi(w.x); a[j].z += bflo(w.y); a[j].w += bfhi(w.y); }
        }
#pragma unroll
        for (int j = 0; j < 4; ++j) { const int c0 = 4 * F.lane + 256 * j; const f32x4 g = *(const f32x4*)(gate + (size_t)b * 3072 + c0);
            f32x4* xp = (f32x4*)(X + (size_t)row * D + c0); *xp = *xp + g * a[j]; }
    }
}
__device__ __forceinline__ void phase_pool(Frame& F) {
    const float* Hf = (const float*)(F.ws + BG_H2F); bf16* P = (bf16*)(F.ws + WS_H);
    for (int row = F.gw; row < T; row += F.NGW) {
        const int tp = row & 4095;
#pragma unroll
        for (int j = 0; j < 4; ++j) {
            const int win = 2 << j, c0 = 4 * F.lane + 256 * j;
            const int lo = (tp - win + 1) > 0 ? (tp - win + 1) : 0; const int cnt = tp - lo + 1;
            f32x4 s = (f32x4){0.f, 0.f, 0.f, 0.f};
            for (int q = 0; q < cnt; ++q) s = s + *(const f32x4*)(Hf + (size_t)(row - q) * D + c0);
            const f32x4 h = *(const f32x4*)(Hf + (size_t)row * D + c0);
            const float inv = 1.0f / (float)cnt;
            v2u o; o.x = pk2(s.x * inv - h.x, s.y * inv - h.y); o.y = pk2(s.z * inv - h.z, s.w * inv - h.w);
            *(v2u*)(P + (size_t)row * D + c0) = o;
        }
    }
}

constexpr int NPHASE = 29;
__global__ void __launch_bounds__(512, 2) mega(Args args_formal) {
    ArgsP const ap0 = (ArgsP)__builtin_amdgcn_kernarg_segment_ptr();
    extern __shared__ __attribute__((aligned(16))) unsigned char lds_raw[];
    Frame F;
    F.lds = (LAS unsigned char*)lds_raw;
    F.tid = threadIdx.x; F.lane = F.tid & 63; F.wave = __builtin_amdgcn_readfirstlane(F.tid >> 6);
    F.bid = blockIdx.x; F.G = gridDim.x; F.gw = F.bid * 8 + F.wave; F.NGW = F.G * 8;
    F.out = ap0->out; F.ws = ap0->ws;
    unsigned* ctl = (unsigned*)(F.ws + WS_CTL);
    const int lo = ap0->ph_lo, hi = ap0->ph_hi;
    volatile LAS unsigned* bst = (volatile LAS unsigned*)(F.lds + LDS_BYTES - 16);
    XcdBarrier bar; bar.bar = ctl + CW_BAR; bar.x = 0; bar.st = bst;
    const bool multi = (hi - lo) > 1;
    if (multi) { if (F.tid == 0) { bst[0] = 0u; bst[1] = 0u; } __syncthreads(); bar = xcd_barrier_post(ctl + CW_BAR, bst); }
#ifndef PHMASK
#define PHMASK 0xFFFFFFFFull
#endif
#define IN(k) ((((PHMASK) >> ((k) >= 20 ? (k) - 10 : (k))) & 1ull) && lo <= (k) && (k) < hi)
#define SEAM(k) do { if ((k) + 1 < hi) xcd_barrier(bar); } while (0)
#define PH_BEGIN(k) if (IN(k)) { { int t_ = threadIdx.x; asm volatile("" : "+v"(t_)); F.tid = t_; F.lane = t_ & 63; F.wave = __builtin_amdgcn_readfirstlane(t_ >> 6); F.gw = F.bid * 8 + F.wave; } ArgsP args = launder_args(ap0); ArgsP AR = args; (void)AR; F.out = args->out; F.ws = args->ws; ctl = (unsigned*)(F.ws + WS_CTL); const float* MOD = (const float*)(F.ws + WS_MOD); (void)MOD;
#define PH_END(k) } if (lo <= (k) && (k) < hi) SEAM(k);
    PH_BEGIN(0) phase_mod(F, args); __syncthreads(); phase_convert_static(F, args); phase_tables(F, args); PH_END(0)
    PH_BEGIN(1) phase_convert_experts(F, args, 0); PH_END(1)
    PH_BEGIN(2) phase_norm_mod(F, FIN(0), FIN(3), 0, (bf16*)(F.ws + WS_H), nullptr); PH_END(2)
    PH_BEGIN(3) DenseOrder S; S.init(F.ws + WS_H, F.ws + WS_WIN, 2048u, 2048u, T, INP, F.G, F.bid); EpiF32Store E{(float*)(F.ws + BG_PROJ), INP};
        pg8::gemm_phase<EpiF32Store, DenseOrder, false>(F.lds, F.tid, 1024, 2048u, 2048u, S, E); PH_END(3)
    PH_BEGIN(4) phase_postproj(F, args); PH_END(4)
    PH_BEGIN(5) phase_s5a(F, args); PH_END(5)
    PH_BEGIN(6) phase_s5b(F, args); PH_END(6)
    PH_BEGIN(7) phase_s5c(F, args); PH_END(7)
    PH_BEGIN(8) phase_dsa(F, args); PH_END(8)
    PH_BEGIN(9) DenseOrder S; S.init(F.ws + BG_MIX, F.ws + WS_WOUT, 2048u, 2048u, T, D, F.G, F.bid); EpiResidual E{FIN(0), F.out, MOD + 2048, nullptr, 0};
        pg8::gemm_phase<EpiResidual, DenseOrder, false>(F.lds, F.tid, 1024, 2048u, 2048u, S, E); PH_END(9)
#define MOE_PHASES(pb, l) \
    PH_BEGIN(pb) phase_router(F, args, l); PH_END(pb) \
    PH_BEGIN(pb + 1) phase_offsets(F, l); PH_END(pb + 1) \
    PH_BEGIN(pb + 2) typedef MoeOrder<2, true> O; O S; S.init(ctl, l, F.ws, false, true, F.G, F.bid); EpiGateUp<O> E{&S, F.ws}; \
        pg8::gemm_phase<EpiGateUp<O>, O, true>(F.lds, F.tid, 1024, 2048u, 2048u, S, E); PH_END(pb + 2) \
    PH_BEGIN(pb + 3) typedef MoeOrder<4, false> O; O S; S.init(ctl, l, F.ws, false, false, F.G, F.bid); EpiDown<O, false> E{&S, F.ws, F.out, MOD + (size_t)((2 * l + 1) * 4) * 3072 + 2048}; \
        pg8::gemm_phase<EpiDown<O, false>, O, false>(F.lds, F.tid, 256, 512u, 512u, S, E); PH_END(pb + 3) \
    PH_BEGIN(pb + 4) phase_combine(F, l); PH_END(pb + 4) \
    PH_BEGIN(pb + 5) typedef MoeOrder<4, false> O; O S; S.init(ctl, l, F.ws, true, true, F.G, F.bid); EpiDown<O, true> E{&S, F.ws, F.out, MOD + (size_t)((2 * l + 1) * 4) * 3072 + 2048}; \
        pg8::gemm_phase<EpiDown<O, true>, O, false>(F.lds, F.tid, 256, 512u, 512u, S, E); PH_END(pb + 5)
    MOE_PHASES(10, 0)
    PH_BEGIN(16) phase_convert_experts(F, args, 1); PH_END(16)
    PH_BEGIN(17) phase_norm_mod(F, F.out, FIN(3) + D, 2, nullptr, (float*)(F.ws + BG_H2F)); PH_END(17)
    PH_BEGIN(18) phase_pool(F); PH_END(18)
    PH_BEGIN(19) PoolOrder S; S.init(F.ws + WS_H, F.ws + WS_WPOOL, F.G, F.bid); EpiResidual E{F.out, F.out, MOD + (size_t)(2 * 4) * 3072 + 2048, FIN(24), 1};
        pg8::gemm_phase<EpiResidual, PoolOrder, false>(F.lds, F.tid, 256, 2048u, 512u, S, E); PH_END(19)
    MOE_PHASES(20, 1)
}

extern "C" void kernel_launch(void* const* d_in, const int* in_sizes, int n_in, void* d_out, int out_size, void* d_ws, size_t ws_size, hipStream_t stream) {
    static int grid = 0;
    if (grid == 0) {
        int dev = 0, cus = 0;
        if (n_in != 33 || ws_size < WS_END) { fprintf(stderr, "kernel_launch: unexpected n_in %d or ws_size %zu (need %zu)\n", n_in, ws_size, (size_t)WS_END); grid = -1; return; }
        if (hipGetDevice(&dev) != hipSuccess || hipDeviceGetAttribute(&cus, hipDeviceAttributeMultiprocessorCount, dev) != hipSuccess) { grid = -1; return; }
        if (hipFuncSetAttribute((const void*)mega, hipFuncAttributeMaxDynamicSharedMemorySize, LDS_BYTES) != hipSuccess) { fprintf(stderr, "kernel_launch: hipFuncSetAttribute failed\n"); grid = -1; return; }
        (void)hipGetLastError();
        grid = cus - (cus % 8); if (grid <= 0) grid = cus;
    }
    if (grid < 0) return;
    (void)hipMemsetAsync((char*)d_ws + WS_CTL, 0, CTL_ZERO_BYTES, stream);
    Args a{};
    for (int i = 0; i < 33; ++i) a.in[i] = (const float*)d_in[i];
    a.out = (float*)d_out; a.ws = (unsigned char*)d_ws;
    const int last = 26;
#if MK_LAUNCH_PER_PHASE
    for (int p = 0; p < last; ++p) { a.ph_lo = p; a.ph_hi = p + 1; hipLaunchKernelGGL(mega, dim3(grid), dim3(512), LDS_BYTES, stream, a); }
#else
    a.ph_lo = 0; a.ph_hi = last; hipLaunchKernelGGL(mega, dim3(grid), dim3(512), LDS_BYTES, stream, a);
#endif
}
```

```cpp
#include <hip/hip_runtime.h>
#include <cstdio>
#include <cstdint>

#ifndef MK_LAUNCH_PER_PHASE
#define MK_LAUNCH_PER_PHASE 0
#endif

#define GAS __attribute__((address_space(1)))
#define LAS __attribute__((address_space(3)))
typedef unsigned short bf16;
typedef unsigned v4u __attribute__((ext_vector_type(4)));
typedef unsigned v2u __attribute__((ext_vector_type(2)));
typedef float f32x4 __attribute__((ext_vector_type(4)));
typedef short bf16x8 __attribute__((ext_vector_type(8)));
#define LDS_WAIT() asm volatile("s_waitcnt lgkmcnt(0)" ::: "memory")
#define VM_WAIT() asm volatile("s_waitcnt vmcnt(0)" ::: "memory")

constexpr int NB = 4, SEQ = 4096, T = NB * SEQ, D = 1024;
constexpr int INW = 1736, INP = 1792;
constexpr int NEXP = 64, EDIM = 256;
constexpr int NASSIGN = T * 8;
constexpr int ECAP = T;

constexpr size_t MiB = 1u << 20;
constexpr size_t WS_CTL = 0;
constexpr size_t CTL_ZERO_BYTES = 1 * MiB;
constexpr size_t WS_MOD = 1 * MiB;
constexpr size_t WS_ROPE = WS_MOD + 256 * 1024;
constexpr size_t WS_S5T = WS_ROPE + 1 * MiB;
constexpr size_t WS_WIN = 4 * MiB;
constexpr size_t WS_WOUT = WS_WIN + (size_t)INP * D * 2;
constexpr size_t WS_WPOOL = WS_WOUT + (size_t)D * D * 2;
constexpr size_t WS_WGU = 10 * MiB;
constexpr size_t WS_WD = WS_WGU + (size_t)65 * 512 * 1024 * 2;
constexpr size_t WS_H = WS_WD + (size_t)65 * 1024 * 256 * 2;
constexpr size_t WS_EIDX = WS_H + (size_t)T * D * 2;
constexpr size_t WS_SLOT = WS_EIDX + (size_t)T * 8 * 4;
constexpr size_t WS_ELT = WS_SLOT + (size_t)T * 8 * 4;
constexpr size_t WS_ELW = WS_ELT + (size_t)NEXP * ECAP * 4;
constexpr size_t WS_BIG = WS_ELW + (size_t)NEXP * ECAP * 4;
constexpr size_t BG_PROJ = WS_BIG;
constexpr size_t BG_U = BG_PROJ + (size_t)T * INP * 4;
constexpr size_t BG_Q = BG_U + (size_t)T * 512 * 4;
constexpr size_t BG_QI = BG_Q + (size_t)T * 512 * 2;
constexpr size_t BG_K = BG_QI + (size_t)T * 512 * 2;
constexpr size_t BG_V = BG_K + (size_t)T * 64 * 2;
constexpr size_t BG_KI = BG_V + (size_t)T * 64 * 2;
constexpr size_t BG_WI = BG_KI + (size_t)T * 64 * 2;
constexpr size_t BG_SLOC = BG_WI + (size_t)T * 8 * 4;
constexpr size_t BG_SIN = BG_SLOC + (size_t)4 * 32 * 64 * 64 * 2 * 4;
constexpr size_t BG_MIX = BG_SIN + (size_t)4 * 32 * 64 * 64 * 2 * 4;
constexpr size_t BG_MIXER_END = BG_MIX + (size_t)T * D * 2;
constexpr size_t BG_HB = WS_BIG;
constexpr size_t BG_HBSH = BG_HB + (size_t)(NASSIGN + 256) * 256 * 2;
constexpr size_t BG_Y = BG_HBSH + (size_t)T * 256 * 2;
constexpr size_t BG_MOE_END = BG_Y + (size_t)NASSIGN * D * 2;
constexpr size_t BG_H2F = WS_BIG;
constexpr size_t WS_END = (BG_MOE_END > BG_MIXER_END ? BG_MOE_END : BG_MIXER_END);
static_assert(WS_END <= 539993216ull, "workspace map exceeds the guaranteed d_ws size");

constexpr int S5_ABAR = 0;
constexpr int S5_A64 = S5_ABAR + 32 * 64 * 2;
constexpr int S5_BBR = S5_A64 + 32 * 64 * 2;
constexpr int S5_BBI = S5_BBR + 32 * 64 * 16;

constexpr int CW_BAR = 4096;
constexpr int CW_CNT = 16384;
constexpr int CW_EST = 16384 + 256;
constexpr int CW_NT = 16384 + 512;
constexpr int CW_TE = 16384 + 1024;
constexpr int CW_TJ = 16384 + 4096;
constexpr int LDS_BYTES = 163840;

__device__ __forceinline__ unsigned f2bf(float f) { unsigned u = __builtin_bit_cast(unsigned, f); return (u + 0x7fffu + ((u >> 16) & 1u)) >> 16; }
__device__ __forceinline__ unsigned pk2(float lo, float hi) { return f2bf(lo) | (f2bf(hi) << 16); }
__device__ __forceinline__ float bf2f(unsigned b) { return __builtin_bit_cast(float, b << 16); }
__device__ __forceinline__ float bflo(unsigned w) { return __builtin_bit_cast(float, w << 16); }
__device__ __forceinline__ float bfhi(unsigned w) { return __builtin_bit_cast(float, w & 0xffff0000u); }
__device__ __forceinline__ float wave_sum(float v) {
#pragma unroll
    for (int o = 1; o < 64; o <<= 1) v += __shfl_xor(v, o);
    return v;
}
__device__ __forceinline__ float wave_max(float v) {
#pragma unroll
    for (int o = 1; o < 64; o <<= 1) v = fmaxf(v, __shfl_xor(v, o));
    return v;
}
__device__ __forceinline__ int wave_sum_i(int v) {
#pragma unroll
    for (int o = 1; o < 64; o <<= 1) v += __shfl_xor(v, o);
    return v;
}
__device__ __forceinline__ float sigmoidf_(float x) { return 1.0f / (1.0f + __expf(-x)); }

namespace pg8 {
typedef float f32x4 __attribute__((ext_vector_type(4)));
constexpr int BM = 256, BK = 64, HALF = 128, HTB = HALF * BK * 2, STAGE_BYTES = 8 * HTB;
__host__ __device__ __forceinline__ int lds_byte(int r, int c) { const int st = (r >> 4) * 2 + (c >> 5), rr = r & 15, cc = c & 31, ob = rr * 64 + cc * 2; return st * 1024 + (ob ^ (((ob >> 9) & 1) << 5)); }
__host__ __device__ __forceinline__ void stage_rc(int b, int& R, int& C) { const int st = b / 1024, sb = b % 1024, swz = sb ^ (((sb >> 9) & 1) << 5); R = (st >> 1) * 16 + swz / 64; C = (st & 1) * 32 + (swz % 64) / 2; }
struct Unit { int pm, pn, e, rows; };
template <class Epi, class Sched, bool GATHER>
__device__ __forceinline__ void gemm_phase(LAS unsigned char* lds, const int tid, const int K, const unsigned lda_b, const unsigned ldb_b, const Sched& S, const Epi& E) {
    const int wid = __builtin_amdgcn_readfirstlane(tid >> 6), lane = tid & 63, wr = wid >> 2, wc = wid & 3, fr = lane & 15, fq = lane >> 4;
    const int nt = K / BK;
    unsigned voffA[2], voffB[2]; int RA[2], CA[2];
#pragma unroll
    for (int i = 0; i < 2; ++i) { int R, C; stage_rc(tid * 16 + i * 8192, R, C); RA[i] = R; CA[i] = C; voffA[i] = (unsigned)R * lda_b + (unsigned)C * 2u; voffB[i] = (unsigned)R * ldb_b + (unsigned)C * 2u; }
    const size_t kstep = (size_t)(BK * 2);
    const size_t hstepA = (size_t)HALF * lda_b, hstepB = (size_t)HALF * ldb_b;
    const unsigned ldsw = (unsigned)wid * 1024u;
    const int aoff = lds_byte(wr * 64 + fr, fq * 8), boff = lds_byte(wc * 32 + fr, fq * 8);
#define PG8_SA(b, h) (((b) * 2 + (h)) * HTB)
#define PG8_SB(b, h) ((4 + (b) * 2 + (h)) * HTB)
#define PG8_STAGE(bufoff, gbase, voff) do { _Pragma("unroll") for (int _i = 0; _i < 2; ++_i) \
        __builtin_amdgcn_global_load_lds((const unsigned*)((const char*)(gbase) + (voff)[_i]), (LAS unsigned*)(lds + (bufoff) + ldsw + _i * 8192), 16, 0, 0); } while (0)
#define PG8_STAGE_A(bufoff, gbase, h, OS) do { if constexpr (GATHER) { PG8_STAGE(bufoff, gbase, g##OS##h); } else { PG8_STAGE(bufoff, (gbase) + (h) * hstepA, voffA); } } while (0)
#define PG8_LDA(dst, b, h) do { _Pragma("unroll") for (int m = 0; m < 4; ++m) _Pragma("unroll") for (int k = 0; k < 2; ++k) dst[m][k] = *(const LAS bf16x8*)(lds + PG8_SA(b, h) + aoff + m * 2048 + k * 1024); } while (0)
#define PG8_LDB(dst, b, h) do { _Pragma("unroll") for (int n = 0; n < 2; ++n) _Pragma("unroll") for (int k = 0; k < 2; ++k) dst[n][k] = *(const LAS bf16x8*)(lds + PG8_SB(b, h) + boff + n * 2048 + k * 1024); } while (0)
#define PG8_MMA(ai, bj, At, Bt) do { __builtin_amdgcn_s_setprio(1); _Pragma("unroll") for (int m = 0; m < 4; ++m) _Pragma("unroll") for (int n = 0; n < 2; ++n) _Pragma("unroll") for (int k = 0; k < 2; ++k) \
        acc[ai][bj][m][n] = __builtin_amdgcn_mfma_f32_16x16x32_bf16(Bt[n][k], At[m][k], acc[ai][bj][m][n], 0, 0, 0); __builtin_amdgcn_s_setprio(0); } while (0)
#define PG8_WAIT_V(n) asm volatile("s_waitcnt vmcnt(" #n ")" ::: "memory")
#define PG8_WAIT_L(n) asm volatile("s_waitcnt lgkmcnt(" #n ")" ::: "memory")
#define PG8_BAR __builtin_amdgcn_s_barrier()
#define PG8_SCHED __builtin_amdgcn_sched_barrier(0)
    Unit cur, nxt; int ui = 0;
    if (!S.next(0, cur)) return;
    f32x4 acc[2][2][4][2];
#pragma unroll
    for (int a = 0; a < 2; ++a)
#pragma unroll
        for (int b = 0; b < 2; ++b)
#pragma unroll
            for (int m = 0; m < 4; ++m)
#pragma unroll
                for (int n = 0; n < 2; ++n) acc[a][b][m][n] = (f32x4){0.f, 0.f, 0.f, 0.f};
    bf16x8 At[4][2], B0[2][2], B1[2][2];
    unsigned gc0[2] = {0u, 0u}, gc1[2] = {0u, 0u}, gn0[2] = {0u, 0u}, gn1[2] = {0u, 0u};
    const char* cA = S.a_base(cur); const char* cB = S.b_base(cur);
    if constexpr (GATHER) {
#pragma unroll
        for (int i = 0; i < 2; ++i) { gc0[i] = S.a_off(cur, RA[i]) + (unsigned)CA[i] * 2u; gc1[i] = S.a_off(cur, HALF + RA[i]) + (unsigned)CA[i] * 2u; }
    }
    PG8_STAGE(PG8_SB(0, 0), cB, voffB); PG8_STAGE(PG8_SB(0, 1), cB + hstepB, voffB); PG8_STAGE_A(PG8_SA(0, 0), cA, 0, c); PG8_STAGE_A(PG8_SA(0, 1), cA, 1, c);
    if (wr == 1) PG8_BAR;
    PG8_WAIT_V(2); PG8_BAR;
    PG8_STAGE(PG8_SB(1, 0), cB + kstep, voffB); PG8_STAGE_A(PG8_SA(1, 0), cA + kstep, 0, c); PG8_STAGE(PG8_SB(1, 1), cB + hstepB + kstep, voffB);
    PG8_WAIT_V(6); PG8_BAR;
#pragma unroll 1
    for (;;) {
        const bool has_next = S.next(ui + 1, nxt);
        const char* nA = has_next ? S.a_base(nxt) : cA; const char* nB = has_next ? S.b_base(nxt) : cB;
        if constexpr (GATHER) {
            if (has_next) {
#pragma unroll
                for (int i = 0; i < 2; ++i) { gn0[i] = S.a_off(nxt, RA[i]) + (unsigned)CA[i] * 2u; gn1[i] = S.a_off(nxt, HALF + RA[i]) + (unsigned)CA[i] * 2u; }
            } else {
#pragma unroll
                for (int i = 0; i < 2; ++i) { gn0[i] = gc0[i]; gn1[i] = gc1[i]; }
            }
        }
#pragma unroll 1
        for (int t = 0; t < nt; t += 2) {
            const bool last = (t == nt - 2);
            const char* a1 = cA + (size_t)(t + 1) * kstep;
            const char* a2 = last ? nA : cA + (size_t)(t + 2) * kstep; const char* b2 = last ? nB : cB + (size_t)(t + 2) * kstep;
            const char* a3 = a2 + kstep; const char* b3 = b2 + kstep;
            unsigned gx0[2], gx1[2];
#pragma unroll
            for (int i = 0; i < 2; ++i) { gx0[i] = last ? gn0[i] : gc0[i]; gx1[i] = last ? gn1[i] : gc1[i]; }
            (void)gx0; (void)gx1;
            PG8_LDB(B0, 0, 0); PG8_LDB(B1, 0, 1); PG8_SCHED; PG8_LDA(At, 0, 0); PG8_STAGE_A(PG8_SA(1, 1), a1, 1, c);
            PG8_WAIT_V(8); PG8_WAIT_L(0); PG8_BAR; PG8_MMA(0, 0, At, B0); PG8_MMA(0, 1, At, B1); PG8_BAR; PG8_SCHED;
            PG8_LDA(At, 0, 1); PG8_STAGE(PG8_SB(0, 0), b2, voffB); PG8_STAGE(PG8_SB(0, 1), b2 + hstepB, voffB); PG8_STAGE_A(PG8_SA(0, 0), a2, 0, x);
            PG8_WAIT_V(8); PG8_WAIT_L(0); PG8_BAR; PG8_MMA(1, 0, At, B0); PG8_MMA(1, 1, At, B1); PG8_BAR; PG8_SCHED;
            PG8_LDB(B0, 1, 0); PG8_LDB(B1, 1, 1); PG8_SCHED; PG8_LDA(At, 1, 0); PG8_STAGE_A(PG8_SA(0, 1), a2, 1, x);
            PG8_WAIT_V(8); PG8_WAIT_L(0); PG8_BAR; PG8_MMA(0, 0, At, B0); PG8_MMA(0, 1, At, B1); PG8_BAR; PG8_SCHED;
            PG8_LDA(At, 1, 1); PG8_STAGE(PG8_SB(1, 0), b3, voffB); PG8_STAGE(PG8_SB(1, 1), b3 + hstepB, voffB); PG8_STAGE_A(PG8_SA(1, 0), a3, 0, x);
            PG8_WAIT_V(8); PG8_WAIT_L(0); PG8_BAR; PG8_MMA(1, 0, At, B0); PG8_MMA(1, 1, At, B1); PG8_BAR; PG8_SCHED;
        }
        if (wr == 0) PG8_BAR;
        E(acc, cur, wr, wc, fr, fq);
        if (!has_next) break;
#pragma unroll
        for (int a = 0; a < 2; ++a)
#pragma unroll
            for (int b = 0; b < 2; ++b)
#pragma unroll
                for (int m = 0; m < 4; ++m)
#pragma unroll
                    for (int n = 0; n < 2; ++n) acc[a][b][m][n] = (f32x4){0.f, 0.f, 0.f, 0.f};
        cur = nxt; cA = nA; cB = nB; ++ui;
        if constexpr (GATHER) {
#pragma unroll
            for (int i = 0; i < 2; ++i) { gc0[i] = gn0[i]; gc1[i] = gn1[i]; }
        }
        if (wr == 1) PG8_BAR;
    }
    PG8_WAIT_V(0);
    PG8_BAR;
#undef PG8_SA
#undef PG8_SB
#undef PG8_STAGE
#undef PG8_STAGE_A
#undef PG8_LDA
#undef PG8_LDB
#undef PG8_MMA
#undef PG8_WAIT_V
#undef PG8_WAIT_L
#undef PG8_BAR
#undef PG8_SCHED
}
}

#define XB_TMO      128
#define XB_XCNT(j)  (256  + 64 * (j))
#define XB_XSUB(j)  (1280 + 64 * (j))
#define XB_XGEN(j)  (2304 + 64 * (j))
#define XB_TOP      3328
#define XB_TOPGEN   3392
#define XCD_BAR_WORDS 3456
#define XB_SPIN_CAP (1u << 22)
__device__ __forceinline__ unsigned xb_ld(unsigned* p)              { return __hip_atomic_load(p, __ATOMIC_RELAXED, __HIP_MEMORY_SCOPE_AGENT); }
__device__ __forceinline__ unsigned xb_add(unsigned* p, unsigned v) { return __hip_atomic_fetch_add(p, v, __ATOMIC_RELAXED, __HIP_MEMORY_SCOPE_AGENT); }
__device__ __forceinline__ unsigned xb_xcc_id() { return (unsigned)__builtin_amdgcn_s_getreg((3 << 11) | 20) & 0xFu; }
#define XB_SPIN(cond, bar) do { unsigned _sp = 0; while (cond) { __builtin_amdgcn_s_sleep(1); \
    if ((++_sp & 255u) == 0u) { if (xb_ld(&(bar)[XB_TMO])) break; if (_sp > XB_SPIN_CAP) { atomicAdd(&(bar)[XB_TMO], 1u); break; } } } } while (0)
struct XcdBarrier { unsigned* bar; unsigned x; volatile LAS unsigned* st; };
__device__ __forceinline__ XcdBarrier xcd_barrier_post(unsigned* bar, volatile LAS unsigned* st) {
    XcdBarrier b; b.bar = bar; b.x = xb_xcc_id(); b.st = st;
    if (threadIdx.x == 0) (void)xb_add(&bar[XB_XCNT(b.x)], 1u);
    return b;
}
__device__ __forceinline__ void xcd_barrier_complete(unsigned* bar, unsigned x, unsigned& nloc, unsigned& nx) {
    const unsigned G = gridDim.x * gridDim.y * gridDim.z;
    unsigned sum, cnt, mine, sp = 0u;
    for (;;) {
        sum = 0u; cnt = 0u; mine = 0u;
#pragma unroll
        for (unsigned j = 0; j < 16; ++j) { const unsigned c = xb_ld(&bar[XB_XCNT(j)]); sum += c; cnt += (c > 0u) ? 1u : 0u; mine = (j == x) ? c : mine; }
        if (sum == G) break;
        __builtin_amdgcn_s_sleep(1);
        if ((++sp & 255u) == 0u) { if (xb_ld(&bar[XB_TMO])) break; if (sp > XB_SPIN_CAP) { atomicAdd(&bar[XB_TMO], 1u); break; } }
    }
    nloc = mine > 0u ? mine : 1u; nx = cnt > 0u ? cnt : 1u;
}
__device__ __forceinline__ void xcd_barrier(const XcdBarrier& b) {
    asm volatile("s_waitcnt vmcnt(0)" ::: "memory");
    __syncthreads();
    if (threadIdx.x == 0) {
        unsigned* bar = b.bar;
        __builtin_amdgcn_s_waitcnt(0);
        unsigned nloc = b.st[0], nx = b.st[1];
        if (nloc == 0u) { xcd_barrier_complete(bar, b.x, nloc, nx); b.st[0] = nloc; b.st[1] = nx; }
        const unsigned old = xb_add(&bar[XB_XSUB(b.x)], 1u);
        const unsigned gen = old / nloc;
        if (old + 1u == (gen + 1u) * nloc) {
            __builtin_amdgcn_fence(__ATOMIC_RELEASE, "agent");
            asm volatile("s_waitcnt vmcnt(0)" ::: "memory");
            const unsigned og = xb_add(&bar[XB_TOP], 1u);
            const unsigned tg = og / nx;
            if (og + 1u == (tg + 1u) * nx) xb_add(&bar[XB_TOPGEN], 1u);
            else XB_SPIN(xb_ld(&bar[XB_TOPGEN]) == tg, bar);
            __builtin_amdgcn_fence(__ATOMIC_ACQUIRE, "agent");
            xb_add(&bar[XB_XGEN(b.x)], 1u);
            asm volatile("s_waitcnt vmcnt(0)" ::: "memory");
        } else {
            XB_SPIN(xb_ld(&bar[XB_XGEN(b.x)]) == gen, bar);
            __builtin_amdgcn_fence(__ATOMIC_ACQUIRE, "agent");
            asm volatile("s_waitcnt vmcnt(0)" ::: "memory");
        }
    }
    __syncthreads();
}

struct Frame {
    LAS unsigned char* lds;
    int tid, lane, wave, bid, G, gw, NGW;
    float* out; unsigned char* ws;
};
struct Args { const float* in[33]; float* out; unsigned char* ws; int ph_lo, ph_hi; };
#define FIN(i) (AR->in[i])
#define CAS __attribute__((address_space(4)))
typedef const CAS Args* ArgsP;
__device__ __forceinline__ ArgsP launder_args(ArgsP p) { asm volatile("" : "+s"(p)); return p; }

__device__ __forceinline__ void phase_mod(Frame& F, ArgsP AR) {
    LAS float* cs = (LAS float*)F.lds;
    LAS float* red = cs + 4096;
    const float* c = FIN(1);
    for (int i = F.tid; i < 4096; i += 512) { const float v = c[i]; cs[i] = v / (1.0f + __expf(-v)); }
    __syncthreads();
    float* MOD = (float*)(F.ws + WS_MOD);
    for (int it = F.bid; it < 192; it += F.G) {
        const int m = it / 48, n0 = (it % 48) * 64, l = m >> 1;
        const float* W = ((m & 1) ? FIN(7) : FIN(4)) + (size_t)l * 1024 * 3072;
        const float* bias = ((m & 1) ? FIN(8) : FIN(5)) + (size_t)l * 3072;
        float a0 = 0.f, a1 = 0.f, a2 = 0.f, a3 = 0.f;
        const int k0 = F.wave * 128;
#pragma unroll 8
        for (int k = k0; k < k0 + 128; ++k) {
            const float w = W[(size_t)k * 3072 + n0 + F.lane];
            a0 += cs[k] * w; a1 += cs[1024 + k] * w; a2 += cs[2048 + k] * w; a3 += cs[3072 + k] * w;
        }
        red[(F.wave * 4 + 0) * 64 + F.lane] = a0; red[(F.wave * 4 + 1) * 64 + F.lane] = a1; red[(F.wave * 4 + 2) * 64 + F.lane] = a2; red[(F.wave * 4 + 3) * 64 + F.lane] = a3;
        __syncthreads();
        if (F.tid < 256) { const int b = F.tid >> 6, n = F.tid & 63; float s = 0.f;
#pragma unroll
            for (int w = 0; w < 8; ++w) s += red[(w * 4 + b) * 64 + n];
            MOD[(size_t)(m * 4 + b) * 3072 + n0 + n] = s + bias[n0 + n]; }
        __syncthreads();
    }
}

__device__ __forceinline__ void transpose_item(const float* W, int ldw, int nvalid, int K, bf16* WT, int mode, LAS float* scr, int kb, int nb, int lane) {
    const int k0 = 64 * kb, n0 = 32 * nb;
    const int nn = n0 + (lane & 31);
#pragma unroll 8
    for (int i = 0; i < 32; ++i) { const int kk = 2 * i + (lane >> 5); scr[kk * 33 + (lane & 31)] = (nn < nvalid) ? W[(size_t)(k0 + kk) * ldw + nn] : 0.f; }
    LDS_WAIT();
    const int c = lane & 7;
#pragma unroll
    for (int j = 0; j < 4; ++j) { const int nl = (lane >> 3) + 8 * j; const LAS float* s = scr + (8 * c) * 33 + nl;
        v4u o; o.x = pk2(s[0 * 33], s[1 * 33]); o.y = pk2(s[2 * 33], s[3 * 33]); o.z = pk2(s[4 * 33], s[5 * 33]); o.w = pk2(s[6 * 33], s[7 * 33]);
        const int n = n0 + nl; const int row = (mode == 0) ? n : (256 * (n >> 7) + (n & 127) + (mode == 2 ? 128 : 0));
        *(v4u*)(WT + (size_t)row * K + k0 + 8 * c) = o; }
    LDS_WAIT();
}
__device__ __forceinline__ void phase_convert_static(Frame& F, ArgsP AR) {
    LAS float* scr = (LAS float*)(F.lds + F.wave * 16384);
    constexpr int I_IN = 16 * 56, I_OUT = 16 * 32, I_POOL = 4 * 4 * 8;
    for (int it = F.gw; it < I_IN + I_OUT + I_POOL; it += F.NGW) {
        int r = it;
        if (r < I_IN) { transpose_item(FIN(9), INW, INW, 1024, (bf16*)(F.ws + WS_WIN), 0, scr, r / 56, r % 56, F.lane); continue; } r -= I_IN;
        if (r < I_OUT) { transpose_item(FIN(10), 1024, 1024, 1024, (bf16*)(F.ws + WS_WOUT), 0, scr, r / 32, r % 32, F.lane); continue; } r -= I_OUT;
        const int g = r / 32, rr = r % 32;
        transpose_item(FIN(23) + (size_t)g * 65536, 256, 256, 256, (bf16*)(F.ws + WS_WPOOL) + (size_t)g * 65536, 0, scr, rr / 8, rr % 8, F.lane);
    }
}
__device__ __forceinline__ void phase_convert_experts(Frame& F, ArgsP AR, int l) {
    LAS float* scr = (LAS float*)(F.lds + F.wave * 16384);
    for (int it = F.gw; it < 65 * 384; it += F.NGW) {
        const int e = it / 384, r = it % 384, type = r >> 7, sub = r & 127;
        if (type < 2) {
            const float* W = (e < 64) ? (FIN(type == 0 ? 27 : 28) + (size_t)(l * 64 + e) * 1024 * 256) : (FIN(type == 0 ? 30 : 31) + (size_t)l * 1024 * 256);
            transpose_item(W, 256, 256, 1024, (bf16*)(F.ws + WS_WGU) + (size_t)e * 512 * 1024, 1 + type, scr, sub >> 3, sub & 7, F.lane);
        } else {
            const float* W = (e < 64) ? (FIN(29) + (size_t)(l * 64 + e) * 256 * 1024) : (FIN(32) + (size_t)l * 256 * 1024);
            transpose_item(W, 1024, 1024, 256, (bf16*)(F.ws + WS_WD) + (size_t)e * 1024 * 256, 0, scr, sub >> 5, sub & 31, F.lane);
        }
    }
}

__device__ __forceinline__ void phase_tables(Frame& F, ArgsP AR) {
    float* S5 = (float*)(F.ws + WS_S5T);
    const int gid = F.bid * 512 + F.tid, NT_ = F.G * 512;
    for (int i = gid; i < 2048; i += NT_) {
        const int g = i >> 6;
        const double lr = FIN(11)[i], li = FIN(12)[i], dt = exp((double)FIN(13)[g]);
        const double mag = exp(lr * dt), ar = mag * cos(li * dt), ai = mag * sin(li * dt);
        const double nr = ar - 1.0, ni = ai, den = lr * lr + li * li;
        const double cr = (nr * lr + ni * li) / den, ci = (ni * lr - nr * li) / den;
        S5[S5_ABAR + 2 * i] = (float)ar; S5[S5_ABAR + 2 * i + 1] = (float)ai;
        double pr = ar, pi = ai;
        for (int s = 0; s < 6; ++s) { const double t = pr * pr - pi * pi; pi = 2.0 * pr * pi; pr = t; }
        S5[S5_A64 + 2 * i] = (float)pr; S5[S5_A64 + 2 * i + 1] = (float)pi;
        for (int h = 0; h < 16; ++h) { const double br = FIN(14)[i * 16 + h], bi = FIN(15)[i * 16 + h];
            S5[S5_BBR + i * 16 + h] = (float)(cr * br - ci * bi); S5[S5_BBI + i * 16 + h] = (float)(cr * bi + ci * br); }
    }
    float* ROPE = (float*)(F.ws + WS_ROPE);
    const int* pos = (const int*)FIN(2);
    for (int i = gid; i < T * 8; i += NT_) {
        const int t = i >> 3, j = i & 7;
        const float inv = (float)pow(500000.0, -(double)(2 * j) / 16.0);
        const float ang = (float)pos[t] * inv;
        ROPE[2 * i] = (float)cos((double)ang); ROPE[2 * i + 1] = (float)sin((double)ang);
    }
}

__device__ __forceinline__ void phase_norm_mod(Frame& F, const float* X, const float* gamma, int m, bf16* Hout, float* Hf) {
    const float* MOD = (const float*)(F.ws + WS_MOD);
    for (int row = F.gw; row < T; row += F.NGW) {
        const int b = row >> 12;
        const float* shift = MOD + (size_t)(m * 4 + b) * 3072; const float* scale = shift + 1024;
        const f32x4* xr = (const f32x4*)(X + (size_t)row * D) + F.lane;
        f32x4 v[4]; float ss = 0.f;
#pragma unroll
        for (int j = 0; j < 4; ++j) { v[j] = xr[64 * j]; ss += v[j].x * v[j].x + v[j].y * v[j].y + v[j].z * v[j].z + v[j].w * v[j].w; }
        const float rstd = rsqrtf(wave_sum(ss) * (1.0f / D) + 1e-6f);
#pragma unroll
        for (int j = 0; j < 4; ++j) {
            const int c0 = 4 * F.lane + 256 * j;
            const f32x4 gg = *(const f32x4*)(gamma + c0), sc = *(const f32x4*)(scale + c0), sh = *(const f32x4*)(shift + c0);
            f32x4 h; h.x = v[j].x * rstd * gg.x * (1.f + sc.x) + sh.x; h.y = v[j].y * rstd * gg.y * (1.f + sc.y) + sh.y;
            h.z = v[j].z * rstd * gg.z * (1.f + sc.z) + sh.z; h.w = v[j].w * rstd * gg.w * (1.f + sc.w) + sh.w;
            if (Hout) { v2u o; o.x = pk2(h.x, h.y); o.y = pk2(h.z, h.w); *(v2u*)(Hout + (size_t)row * D + c0) = o; }
            if (Hf) *(f32x4*)(Hf + (size_t)row * D + c0) = h;
        }
    }
}

struct DenseOrder {
    const char* A; const char* Bt; unsigned lda_b, ldb_b; int nM, nN, nU, chunk, x, q0, qs;
    __device__ __forceinline__ void init(const void* A_, const void* Bt_, unsigned lda, unsigned ldb, int M, int N, int G, int c) {
        A = (const char*)A_; Bt = (const char*)Bt_; lda_b = lda; ldb_b = ldb; nM = M / 256; nN = N / 256; nU = nM * nN; chunk = (nU + 7) / 8; x = c & 7; q0 = c >> 3; qs = G >> 3; }
    __device__ __forceinline__ bool next(int i, pg8::Unit& u) const {
        const int q = i * qs + q0; if (q >= chunk) return false; const int L = x * chunk + q; if (L >= nU) return false;
        u.pm = L / nN; u.pn = L % nN; u.e = 0; u.rows = 256; return true; }
    __device__ __forceinline__ const char* a_base(const pg8::Unit& u) const { return A + (size_t)u.pm * 256 * lda_b; }
    __device__ __forceinline__ const char* b_base(const pg8::Unit& u) const { return Bt + (size_t)u.pn * 256 * ldb_b; }
    __device__ __forceinline__ unsigned a_off(const pg8::Unit&, int) const { return 0u; }
};
struct PoolOrder {
    const char* A; const char* Bt; int nU, chunk, x, q0, qs;
    __device__ __forceinline__ void init(const void* A_, const void* Bt_, int G, int c) { A = (const char*)A_; Bt = (const char*)Bt_; nU = 64 * 4; chunk = (nU + 7) / 8; x = c & 7; q0 = c >> 3; qs = G >> 3; }
    __device__ __forceinline__ bool next(int i, pg8::Unit& u) const {
        const int q = i * qs + q0; if (q >= chunk) return false; const int L = x * chunk + q; if (L >= nU) return false;
        u.pm = L >> 2; u.pn = L & 3; u.e = L & 3; u.rows = 256; return true; }
    __device__ __forceinline__ const char* a_base(const pg8::Unit& u) const { return A + (size_t)u.pm * 256 * 2048 + (size_t)u.e * 512; }
    __device__ __forceinline__ const char* b_base(const pg8::Unit& u) const { return Bt + (size_t)u.e * 256 * 512; }
    __device__ __forceinline__ unsigned a_off(const pg8::Unit&, int) const { return 0u; }
};
template <int NPN, bool GATE_UP>
struct MoeOrder {
    const unsigned* ctl; int l; const unsigned char* ws; int ntr, ntiles, nU, chunk, x, q0, qs; bool with_shared;
    __device__ __forceinline__ void init(const unsigned* ctl_, int l_, const unsigned char* ws_, bool shared_only, bool with_sh, int G, int c) {
        ctl = ctl_; l = l_; ws = ws_; with_shared = with_sh;
        ntr = shared_only ? 0 : (int)ctl[CW_NT + l]; ntiles = ntr + (with_sh ? 64 : 0); nU = ntiles * NPN; chunk = (nU + 7) / 8; x = c & 7; q0 = c >> 3; qs = G >> 3; }
    __device__ __forceinline__ bool next(int i, pg8::Unit& u) const {
        const int q = i * qs + q0; if (q >= chunk) return false; const int L = x * chunk + q; if (L >= nU) return false;
        const int tile = L / NPN; u.pn = L % NPN;
        if (tile < ntr) { u.e = (int)ctl[CW_TE + l * 1024 + tile]; u.pm = (int)ctl[CW_TJ + l * 1024 + tile]; const int cnt = (int)ctl[CW_CNT + l * 64 + u.e]; const int rem = cnt - 256 * u.pm; u.rows = rem < 256 ? rem : 256; }
        else { u.e = 64; u.pm = tile - ntr; u.rows = 256; }
        return true; }
    __device__ __forceinline__ int row0(const pg8::Unit& u) const { return (u.e < 64) ? (int)ctl[CW_EST + l * 128 + u.e] + 256 * u.pm : 256 * u.pm; }
    __device__ __forceinline__ const char* a_base(const pg8::Unit& u) const {
        if (GATE_UP) return (const char*)(ws + WS_H);
        return (u.e < 64) ? (const char*)(ws + BG_HB) + (size_t)row0(u) * 512 : (const char*)(ws + BG_HBSH) + (size_t)row0(u) * 512; }
    __device__ __forceinline__ const char* b_base(const pg8::Unit& u) const {
        if (GATE_UP) return (const char*)(ws + WS_WGU) + (size_t)u.e * 512 * 2048 + (size_t)u.pn * 256 * 2048;
        return (const char*)(ws + WS_WD) + (size_t)u.e * 1024 * 512 + (size_t)u.pn * 256 * 512; }
    __device__ __forceinline__ unsigned a_off(const pg8::Unit& u, int r) const {
        int tok;
        if (u.e < 64) { const int* elt = (const int*)(ws + WS_ELT) + (size_t)u.e * ECAP + 256 * u.pm; tok = (r < u.rows) ? elt[r] : 0; }
        else tok = 256 * u.pm + r;
        return (unsigned)tok * 2048u; }
};

struct EpiF32Store { float* C; int ldc;
    __device__ __forceinline__ void operator()(const pg8::f32x4 (&acc)[2][2][4][2], const pg8::Unit& u, int wr, int wc, int fr, int fq) const {
#pragma unroll
        for (int ai = 0; ai < 2; ++ai)
#pragma unroll
            for (int m = 0; m < 4; ++m) { float* rowp = C + (size_t)(u.pm * 256 + ai * 128 + wr * 64 + m * 16 + fr) * ldc + u.pn * 256 + wc * 32 + 4 * fq;
#pragma unroll
                for (int bj = 0; bj < 2; ++bj)
#pragma unroll
                    for (int n = 0; n < 2; ++n) *(f32x4*)(rowp + bj * 128 + n * 16) = acc[ai][bj][m][n]; }
    }
};
struct EpiResidual { const float* Xin; float* X; const float* gate; const float* colscale; int col_from_e;
    __device__ __forceinline__ void operator()(const pg8::f32x4 (&acc)[2][2][4][2], const pg8::Unit& u, int wr, int wc, int fr, int fq) const {
        const int cbase = (col_from_e ? u.e * 256 : u.pn * 256) + wc * 32 + 4 * fq;
#pragma unroll
        for (int ai = 0; ai < 2; ++ai)
#pragma unroll
            for (int m = 0; m < 4; ++m) { const int row = u.pm * 256 + ai * 128 + wr * 64 + m * 16 + fr; const int b = row >> 12;
#pragma unroll
                for (int bj = 0; bj < 2; ++bj)
#pragma unroll
                    for (int n = 0; n < 2; ++n) { const int col = cbase + bj * 128 + n * 16; const size_t o = (size_t)row * D + col;
                        f32x4 g = *(const f32x4*)(gate + (size_t)b * 3072 + col); if (colscale) { const f32x4 cs = *(const f32x4*)(colscale + col); g = g * cs; }
                        const f32x4 xi = *(const f32x4*)(Xin + o); *(f32x4*)(X + o) = xi + g * acc[ai][bj][m][n]; } }
    }
};
template <class Order> struct EpiGateUp { const Order* S; unsigned char* ws;
    __device__ __forceinline__ void operator()(const pg8::f32x4 (&acc)[2][2][4][2], const pg8::Unit& u, int wr, int wc, int fr, int fq) const {
        const int r0 = S->row0(u); bf16* HB = (bf16*)(ws + (u.e < 64 ? BG_HB : BG_HBSH));
        const float* elw = (const float*)(ws + WS_ELW) + (size_t)(u.e < 64 ? u.e : 0) * ECAP + 256 * u.pm;
#pragma unroll
        for (int ai = 0; ai < 2; ++ai)
#pragma unroll
            for (int m = 0; m < 4; ++m) { const int r = ai * 128 + wr * 64 + m * 16 + fr;
                if (r < u.rows) { const float w = (u.e < 64) ? elw[r] : 1.0f; bf16* rowp = HB + (size_t)(r0 + r) * 256 + u.pn * 128 + wc * 32 + 4 * fq;
#pragma unroll
                    for (int n = 0; n < 2; ++n) { const f32x4 g = acc[ai][0][m][n], up = acc[ai][1][m][n]; f32x4 h;
                        h.x = g.x * sigmoidf_(g.x) * up.x * w; h.y = g.y * sigmoidf_(g.y) * up.y * w; h.z = g.z * sigmoidf_(g.z) * up.z * w; h.w = g.w * sigmoidf_(g.w) * up.w * w;
                        v2u o; o.x = pk2(h.x, h.y); o.y = pk2(h.z, h.w); *(v2u*)(rowp + n * 16) = o; } } }
    }
};
template <class Order, bool SHARED> struct EpiDown { const Order* S; unsigned char* ws; float* X; const float* gate;
    __device__ __forceinline__ void operator()(const pg8::f32x4 (&acc)[2][2][4][2], const pg8::Unit& u, int wr, int wc, int fr, int fq) const {
        const int r0 = S->row0(u); bf16* Y = (bf16*)(ws + BG_Y);
#pragma unroll
        for (int ai = 0; ai < 2; ++ai)
#pragma unroll
            for (int m = 0; m < 4; ++m) { const int r = ai * 128 + wr * 64 + m * 16 + fr;
                if (r < u.rows) {
#pragma unroll
                    for (int bj = 0; bj < 2; ++bj)
#pragma unroll
                        for (int n = 0; n < 2; ++n) { const int col = u.pn * 256 + bj * 128 + wc * 32 + n * 16 + 4 * fq; const f32x4 a = acc[ai][bj][m][n];
                            if constexpr (!SHARED) { v2u o; o.x = pk2(a.x, a.y); o.y = pk2(a.z, a.w); *(v2u*)(Y + (size_t)(r0 + r) * D + col) = o; }
                            else { const int tok = r0 + r; const size_t o = (size_t)tok * D + col; const f32x4 g = *(const f32x4*)(gate + (size_t)(tok >> 12) * 3072 + col);
                                const f32x4 xi = *(const f32x4*)(X + o); *(f32x4*)(X + o) = xi + g * a; } } }
                asm volatile("" ::: "memory"); }
    }
};

__device__ __forceinline__ void phase_postproj(Frame& F, ArgsP AR) {
    const float* PROJ = (const float*)(F.ws + BG_PROJ); const float* ROPE = (const float*)(F.ws + WS_ROPE);
    float* U = (float*)(F.ws + BG_U); bf16* Q = (bf16*)(F.ws + BG_Q); bf16* QI = (bf16*)(F.ws + BG_QI); bf16* Kb = (bf16*)(F.ws + BG_K); bf16* Vb = (bf16*)(F.ws + BG_V); bf16* KIb = (bf16*)(F.ws + BG_KI); float* WI = (float*)(F.ws + BG_WI);
    const float qg = FIN(21)[F.lane], kg = FIN(22)[F.lane];
    const int lane = F.lane;
    for (int t = F.gw; t < T; t += F.NGW) {
        const float* p = PROJ + (size_t)t * INP;
        const float cs = ROPE[(size_t)t * 16 + 2 * (lane & 7)], sn = ROPE[(size_t)t * 16 + 2 * (lane & 7) + 1];
#pragma unroll
        for (int j = 0; j < 8; ++j) U[(size_t)t * 512 + j * 64 + lane] = p[j * 64 + lane];
        auto rope = [&](float y) -> float { const float yp = __shfl_xor(y, 8); float o = y; if (lane < 8) o = y * cs - yp * sn; else if (lane < 16) o = yp * sn + y * cs; return o; };
#pragma unroll
        for (int h = 0; h < 8; ++h) { const float x = p[512 + h * 64 + lane]; const float rstd = rsqrtf(wave_sum(x * x) * (1.0f / 64.0f) + 1e-6f);
            Q[(size_t)t * 512 + h * 64 + lane] = (bf16)f2bf(rope(x * rstd * qg)); }
        { const float x = p[1024 + lane]; const float rstd = rsqrtf(wave_sum(x * x) * (1.0f / 64.0f) + 1e-6f); Kb[(size_t)t * 64 + lane] = (bf16)f2bf(rope(x * rstd * kg)); }
        Vb[(size_t)t * 64 + lane] = (bf16)f2bf(p[1088 + lane]);
#pragma unroll
        for (int h = 0; h < 8; ++h) QI[(size_t)t * 512 + h * 64 + lane] = (bf16)f2bf(rope(p[1152 + h * 64 + lane]));
        KIb[(size_t)t * 64 + lane] = (bf16)f2bf(rope(p[1664 + lane]));
        if (lane < 8) WI[(size_t)t * 8 + lane] = p[1728 + lane] * 0.35355339059327373f;
    }
}

__device__ __forceinline__ void phase_s5a(Frame& F, ArgsP AR) {
    const float* S5 = (const float*)(F.ws + WS_S5T); const float* U = (const float*)(F.ws + BG_U); float* SLOC = (float*)(F.ws + BG_SLOC);
    const int p = F.lane;
    for (int it = F.gw; it < 4 * 32 * 64; it += F.NGW) {
        const int c = it & 63, g = (it >> 6) & 31, b = it >> 11;
        const float ar = S5[S5_ABAR + 2 * (g * 64 + p)], ai = S5[S5_ABAR + 2 * (g * 64 + p) + 1];
        float br[16], bi[16];
#pragma unroll
        for (int h = 0; h < 16; ++h) { br[h] = S5[S5_BBR + (g * 64 + p) * 16 + h]; bi[h] = S5[S5_BBI + (g * 64 + p) * 16 + h]; }
        float sr = 0.f, si = 0.f;
        const float* up = U + ((size_t)b * SEQ + c * 64) * 512 + g * 16;
        for (int tau = 0; tau < 64; ++tau) {
            float bur = 0.f, bui = 0.f;
#pragma unroll
            for (int h = 0; h < 16; ++h) { const float u = up[(size_t)tau * 512 + h]; bur += br[h] * u; bui += bi[h] * u; }
            const float nr = ar * sr - ai * si + bur, ni = ar * si + ai * sr + bui; sr = nr; si = ni;
        }
        SLOC[((size_t)it * 64 + p) * 2] = sr; SLOC[((size_t)it * 64 + p) * 2 + 1] = si;
    }
}
__device__ __forceinline__ void phase_s5b(Frame& F, ArgsP AR) {
    const float* S5 = (const float*)(F.ws + WS_S5T); const float* SLOC = (const float*)(F.ws + BG_SLOC); float* SIN = (float*)(F.ws + BG_SIN);
    const int gid = F.bid * 512 + F.tid;
    for (int i = gid; i < 4 * 32 * 64; i += F.G * 512) {
        const int p = i & 63, g = (i >> 6) & 31, b = i >> 11;
        const float ar = S5[S5_A64 + 2 * (g * 64 + p)], ai = S5[S5_A64 + 2 * (g * 64 + p) + 1];
        float sr = 0.f, si = 0.f;
        for (int c = 0; c < 64; ++c) {
            const size_t o = ((((size_t)b * 32 + g) * 64 + c) * 64 + p) * 2;
            SIN[o] = sr; SIN[o + 1] = si;
            const float lr = SLOC[o], li = SLOC[o + 1];
            const float nr = ar * sr - ai * si + lr, ni = ar * si + ai * sr + li; sr = nr; si = ni;
        }
    }
}
__device__ __forceinline__ void phase_s5c(Frame& F, ArgsP AR) {
    const float* S5 = (const float*)(F.ws + WS_S5T); const float* U = (const float*)(F.ws + BG_U); const float* SIN = (const float*)(F.ws + BG_SIN); bf16* MIX = (bf16*)(F.ws + BG_MIX);
    const float* cre = FIN(16); const float* cim = FIN(17); const float* dsk = FIN(18); const float* gluw = FIN(19); const float* glub = FIN(20);
    LAS float* st = (LAS float*)(F.lds + F.wave * 10240);
    LAS float* yg = st + 2048;
    const int p = F.lane, h = F.lane & 15, tq = F.lane >> 4;
    for (int it = F.gw; it < 4 * 32 * 64; it += F.NGW) {
        const int c = it & 63, g = (it >> 6) & 31, b = it >> 11;
        const float ar = S5[S5_ABAR + 2 * (g * 64 + p)], ai = S5[S5_ABAR + 2 * (g * 64 + p) + 1];
        float br[16], bi[16];
#pragma unroll
        for (int hh = 0; hh < 16; ++hh) { br[hh] = S5[S5_BBR + (g * 64 + p) * 16 + hh]; bi[hh] = S5[S5_BBI + (g * 64 + p) * 16 + hh]; }
        float sr = SIN[((size_t)it * 64 + p) * 2], si = SIN[((size_t)it * 64 + p) * 2 + 1];
        const size_t trow0 = (size_t)b * SEQ + c * 64;
        const float dd = dsk[g * 16 + h], gb = glub[g * 16 + h];
        for (int sub = 0; sub < 4; ++sub) {
            const float* up = U + (trow0 + sub * 16) * 512 + g * 16;
            for (int tau = 0; tau < 16; ++tau) {
                float bur = 0.f, bui = 0.f;
#pragma unroll
                for (int hh = 0; hh < 16; ++hh) { const float u = up[(size_t)tau * 512 + hh]; bur += br[hh] * u; bui += bi[hh] * u; }
                const float nr = ar * sr - ai * si + bur, ni = ar * si + ai * sr + bui; sr = nr; si = ni;
                st[(tau * 64 + p) * 2] = sr; st[(tau * 64 + p) * 2 + 1] = si;
            }
            LDS_WAIT();
            float y[4];
#pragma unroll
            for (int j = 0; j < 4; ++j) { const int tau = tq + 4 * j; float a = 0.f;
                for (int pp = 0; pp < 64; ++pp) a += cre[(g * 16 + h) * 64 + pp] * st[(tau * 64 + pp) * 2] - cim[(g * 16 + h) * 64 + pp] * st[(tau * 64 + pp) * 2 + 1];
                a += dd * up[(size_t)tau * 512 + h];
                const float ge = 0.5f * a * (1.0f + tanhf(0.7978845608028654f * (a + 0.044715f * a * a * a)));
                y[j] = ge; yg[tau * 16 + h] = ge; }
            LDS_WAIT();
#pragma unroll
            for (int j = 0; j < 4; ++j) { const int tau = tq + 4 * j; float z = gb;
#pragma unroll
                for (int hh = 0; hh < 16; ++hh) z += yg[tau * 16 + hh] * gluw[(g * 16 + hh) * 16 + h];
                MIX[(trow0 + sub * 16 + tau) * D + g * 16 + h] = (bf16)f2bf(y[j] * sigmoidf_(z)); }
            LDS_WAIT();
        }
    }
}

__device__ __forceinline__ unsigned fkey(float f) { const unsigned u = __builtin_bit_cast(unsigned, f); return (u & 0x80000000u) ? ~u : (u | 0x80000000u); }
__device__ __forceinline__ void phase_dsa(Frame& F, ArgsP AR) {
    const bf16* Q = (const bf16*)(F.ws + BG_Q); const bf16* QI = (const bf16*)(F.ws + BG_QI); const bf16* Kb = (const bf16*)(F.ws + BG_K); const bf16* Vb = (const bf16*)(F.ws + BG_V);
    const bf16* KIb = (const bf16*)(F.ws + BG_KI); const float* WI = (const float*)(F.ws + BG_WI); bf16* MIX = (bf16*)(F.ws + BG_MIX);
    LAS unsigned char* wl = F.lds + F.wave * 19456;
    LAS float* sc = (LAS float*)wl;
    LAS float* qf = (LAS float*)(wl + 16384);
    LAS int* list = (LAS int*)(wl + 16384 + 2048);
    const int lane = F.lane;
#pragma unroll 1
    for (int it = F.bid; it < T / 8; it += F.G) {
        const int t = (T / 8 - 1 - it) * 8 + F.wave;
        const int b = t >> 12, tp = t & 4095, n = tp + 1;
        const size_t kb0 = (size_t)b * SEQ;
#pragma unroll
        for (int j = 0; j < 8; ++j) qf[j * 64 + lane] = bf2f(QI[(size_t)t * 512 + j * 64 + lane]);
        float wv[8];
#pragma unroll
        for (int h = 0; h < 8; ++h) wv[h] = WI[(size_t)t * 8 + h];
        LDS_WAIT();
#pragma unroll 1
        for (int s0 = 0; s0 < n; s0 += 64) {
            asm volatile("" ::: "memory");
            const int s = s0 + lane;
            float score = -INFINITY;
            if (s < n) {
                const v4u* kp = (const v4u*)(KIb + (kb0 + s) * 64);
                float dh[8];
#pragma unroll
                for (int h = 0; h < 8; ++h) dh[h] = 0.f;
#pragma unroll 1
                for (int half = 0; half < 2; ++half) {
                    asm volatile("" ::: "memory");
                    float kf[32];
#pragma unroll
                    for (int i = 0; i < 4; ++i) { const v4u w = kp[half * 4 + i]; kf[8 * i] = bflo(w.x); kf[8 * i + 1] = bfhi(w.x); kf[8 * i + 2] = bflo(w.y); kf[8 * i + 3] = bfhi(w.y); kf[8 * i + 4] = bflo(w.z); kf[8 * i + 5] = bfhi(w.z); kf[8 * i + 6] = bflo(w.w); kf[8 * i + 7] = bfhi(w.w); }
#pragma unroll
                    for (int h = 0; h < 8; ++h) { float d = 0.f;
#pragma unroll
                        for (int i = 0; i < 8; ++i) { const f32x4 qv = *(const LAS f32x4*)(qf + h * 64 + half * 32 + 4 * i); d += qv.x * kf[4 * i] + qv.y * kf[4 * i + 1] + qv.z * kf[4 * i + 2] + qv.w * kf[4 * i + 3]; }
                        dh[h] += d; __builtin_amdgcn_sched_barrier(0); }
                }
                float a = 0.f;
#pragma unroll
                for (int h = 0; h < 8; ++h) a += wv[h] * fmaxf(dh[h] * 0.125f, 0.f);
                score = a;
            }
            sc[s] = score;
        }
        LDS_WAIT();
        int nsel;
        if (n <= 256) { for (int i = lane; i < n; i += 64) list[i] = i; nsel = n; }
        else {
            const int nch = (n + 63) >> 6;
            unsigned thr = 0u;
#pragma unroll 1
            for (int bit = 31; bit >= 0; --bit) {
                const unsigned cand = thr | (1u << bit); int cnt = 0;
#pragma unroll 1
                for (int j = 0; j < nch; ++j) { const int s = j * 64 + lane; if (s < n) cnt += (fkey(sc[s]) >= cand) ? 1 : 0; }
                cnt = wave_sum_i(cnt);
                if (cnt >= 256) thr = cand;
            }
            int cgt = 0;
            for (int j = 0; j < nch; ++j) { const int s = j * 64 + lane; if (s < n) cgt += (fkey(sc[s]) > thr) ? 1 : 0; }
            cgt = wave_sum_i(cgt);
            const int need_eq = 256 - cgt;
            int run = 0, eqrun = 0;
            const unsigned long long lt = (lane == 0) ? 0ull : (~0ull >> (64 - lane));
            for (int j = 0; j < nch; ++j) {
                const int s = j * 64 + lane; const bool in = s < n; const unsigned k = in ? fkey(sc[s]) : 0u;
                const bool gt = in && k > thr, eq = in && k == thr;
                const unsigned long long beq = __ballot(eq);
                const int myeq = eqrun + __popcll(beq & lt);
                const bool sel = gt || (eq && myeq < need_eq);
                const unsigned long long bs = __ballot(sel);
                if (sel) list[run + __popcll(bs & lt)] = s;
                run += __popcll(bs); eqrun += __popcll(beq);
            }
            nsel = run;
        }
        LDS_WAIT();
#pragma unroll
        for (int j = 0; j < 8; ++j) qf[j * 64 + lane] = bf2f(Q[(size_t)t * 512 + j * 64 + lane]);
        LDS_WAIT();
        float mx[8];
#pragma unroll
        for (int h = 0; h < 8; ++h) mx[h] = -INFINITY;
#pragma unroll 1
        for (int i0 = 0; i0 < nsel; i0 += 64) {
            asm volatile("" ::: "memory");
            const int i = i0 + lane;
            if (i < nsel) {
                const int s = list[i];
                const v4u* kp = (const v4u*)(Kb + (kb0 + s) * 64);
                float dh[8];
#pragma unroll
                for (int h = 0; h < 8; ++h) dh[h] = 0.f;
#pragma unroll 1
                for (int half = 0; half < 2; ++half) {
                    asm volatile("" ::: "memory");
                    float kf[32];
#pragma unroll
                    for (int q = 0; q < 4; ++q) { const v4u w = kp[half * 4 + q]; kf[8 * q] = bflo(w.x); kf[8 * q + 1] = bfhi(w.x); kf[8 * q + 2] = bflo(w.y); kf[8 * q + 3] = bfhi(w.y); kf[8 * q + 4] = bflo(w.z); kf[8 * q + 5] = bfhi(w.z); kf[8 * q + 6] = bflo(w.w); kf[8 * q + 7] = bfhi(w.w); }
#pragma unroll
                    for (int h = 0; h < 8; ++h) { float d = 0.f;
#pragma unroll
                        for (int q = 0; q < 8; ++q) { const f32x4 qv = *(const LAS f32x4*)(qf + h * 64 + half * 32 + 4 * q); d += qv.x * kf[4 * q] + qv.y * kf[4 * q + 1] + qv.z * kf[4 * q + 2] + qv.w * kf[4 * q + 3]; }
                        dh[h] += d; __builtin_amdgcn_sched_barrier(0); }
                }
#pragma unroll
                for (int h = 0; h < 8; ++h) { const float d = dh[h] * 0.125f; sc[i * 8 + h] = d; mx[h] = fmaxf(mx[h], d); }
            }
        }
        float lsum[8];
#pragma unroll
        for (int h = 0; h < 8; ++h) { mx[h] = wave_max(mx[h]); lsum[h] = 0.f; }
        LDS_WAIT();
        for (int i0 = 0; i0 < nsel; i0 += 64) {
            const int i = i0 + lane;
            if (i < nsel) {
#pragma unroll
                for (int h = 0; h < 8; ++h) { const float pv = __expf(sc[i * 8 + h] - mx[h]); sc[i * 8 + h] = pv; lsum[h] += pv; }
            }
        }
#pragma unroll
        for (int h = 0; h < 8; ++h) lsum[h] = wave_sum(lsum[h]);
        LDS_WAIT();
        float o[8];
#pragma unroll
        for (int h = 0; h < 8; ++h) o[h] = 0.f;
#pragma unroll 2
        for (int i = 0; i < nsel; ++i) {
            const int s = list[i];
            const float v = bf2f(Vb[(kb0 + s) * 64 + lane]);
            const f32x4 p0 = *(const LAS f32x4*)(sc + i * 8), p1 = *(const LAS f32x4*)(sc + i * 8 + 4);
            o[0] += p0.x * v; o[1] += p0.y * v; o[2] += p0.z * v; o[3] += p0.w * v; o[4] += p1.x * v; o[5] += p1.y * v; o[6] += p1.z * v; o[7] += p1.w * v;
        }
#pragma unroll
        for (int h = 0; h < 8; ++h) MIX[(size_t)t * D + 512 + h * 64 + lane] = (bf16)f2bf(o[h] / lsum[h]);
        LDS_WAIT();
    }
}

__device__ __forceinline__ void phase_router(Frame& F, ArgsP AR, int l) {
    const float* X = F.out; const float* gamma = FIN(6) + (size_t)l * D; const int m = 2 * l + 1;
    const float* MOD = (const float*)(F.ws + WS_MOD); const float* RW = FIN(25) + (size_t)l * D * 64; const float* RB = FIN(26) + (size_t)l * 64;
    bf16* Hout = (bf16*)(F.ws + WS_H); unsigned* ctl = (unsigned*)(F.ws + WS_CTL);
    int* EIDX = (int*)(F.ws + WS_EIDX); int* SLOT = (int*)(F.ws + WS_SLOT); int* ELT = (int*)(F.ws + WS_ELT); float* ELW = (float*)(F.ws + WS_ELW);
    LAS float* hrow = (LAS float*)(F.lds + F.wave * 4096);
    const int lane = F.lane;
    const float rb = RB[lane];
    for (int row = F.gw; row < T; row += F.NGW) {
        const int b = row >> 12;
        const float* shift = MOD + (size_t)(m * 4 + b) * 3072; const float* scale = shift + 1024;
        const f32x4* xr = (const f32x4*)(X + (size_t)row * D) + lane;
        f32x4 v[4]; float ss = 0.f;
#pragma unroll
        for (int j = 0; j < 4; ++j) { v[j] = xr[64 * j]; ss += v[j].x * v[j].x + v[j].y * v[j].y + v[j].z * v[j].z + v[j].w * v[j].w; }
        const float rstd = rsqrtf(wave_sum(ss) * (1.0f / D) + 1e-6f);
#pragma unroll
        for (int j = 0; j < 4; ++j) {
            const int c0 = 4 * lane + 256 * j;
            const f32x4 gg = *(const f32x4*)(gamma + c0), sc = *(const f32x4*)(scale + c0), sh = *(const f32x4*)(shift + c0);
            f32x4 h; h.x = v[j].x * rstd * gg.x * (1.f + sc.x) + sh.x; h.y = v[j].y * rstd * gg.y * (1.f + sc.y) + sh.y;
            h.z = v[j].z * rstd * gg.z * (1.f + sc.z) + sh.z; h.w = v[j].w * rstd * gg.w * (1.f + sc.w) + sh.w;
            v2u o; o.x = pk2(h.x, h.y); o.y = pk2(h.z, h.w); *(v2u*)(Hout + (size_t)row * D + c0) = o;
            *(LAS f32x4*)(hrow + c0) = h;
        }
        LDS_WAIT();
        float a0 = 0.f, a1 = 0.f, a2 = 0.f, a3 = 0.f;
#pragma unroll 4
        for (int k = 0; k < 1024; k += 4) { const f32x4 hv = *(const LAS f32x4*)(hrow + k);
            a0 += hv.x * RW[(size_t)k * 64 + lane]; a1 += hv.y * RW[(size_t)(k + 1) * 64 + lane]; a2 += hv.z * RW[(size_t)(k + 2) * 64 + lane]; a3 += hv.w * RW[(size_t)(k + 3) * 64 + lane]; }
        const float score = sigmoidf_((a0 + a1) + (a2 + a3));
        const float sel = score + rb;
        float m1 = sel; m1 = fmaxf(m1, __shfl_xor(m1, 1)); m1 = fmaxf(m1, __shfl_xor(m1, 2)); m1 = fmaxf(m1, __shfl_xor(m1, 4));
        const unsigned long long bm = __ballot(sel == m1);
        const int g = lane >> 3; const unsigned gm = (unsigned)((bm >> (8 * g)) & 0xffull); const int first = 8 * g + __builtin_ctz(gm);
        float m2 = (lane == first) ? -INFINITY : sel; m2 = fmaxf(m2, __shfl_xor(m2, 1)); m2 = fmaxf(m2, __shfl_xor(m2, 2)); m2 = fmaxf(m2, __shfl_xor(m2, 4));
        const float gs = m1 + m2;
        int grank = 0;
#pragma unroll
        for (int gg = 0; gg < 8; ++gg) { const float o = __shfl(gs, gg * 8); grank += (o > gs || (o == gs && gg < g)) ? 1 : 0; }
        const float masked = (grank < 4) ? sel : -INFINITY;
        int rank = 0;
        for (int e = 0; e < 64; ++e) { const float o = __shfl(masked, e); rank += (o > masked || (o == masked && e < lane)) ? 1 : 0; }
        const bool chosen = rank < 8;
        const float wsum = wave_sum(chosen ? score : 0.f);
        if (chosen) {
            const float gwt = score / wsum * 2.5f;
            const unsigned pos = atomicAdd(&ctl[CW_CNT + l * 64 + lane], 1u);
            ELT[(size_t)lane * ECAP + pos] = row; ELW[(size_t)lane * ECAP + pos] = gwt;
            EIDX[(size_t)row * 8 + rank] = lane; SLOT[(size_t)row * 8 + rank] = (int)pos;
        }
        LDS_WAIT();
    }
}
__device__ __forceinline__ void phase_offsets(Frame& F, int l) {
    if (F.bid == 0 && F.tid == 0) {
        unsigned* ctl = (unsigned*)(F.ws + WS_CTL);
        unsigned run = 0, nt = 0;
        for (int e = 0; e < 64; ++e) { const unsigned c = ctl[CW_CNT + l * 64 + e]; ctl[CW_EST + l * 128 + e] = run; run += c;
            const unsigned ntl = (c + 255u) / 256u; for (unsigned j = 0; j < ntl; ++j) { ctl[CW_TE + l * 1024 + nt] = (unsigned)e; ctl[CW_TJ + l * 1024 + nt] = j; ++nt; } }
        ctl[CW_EST + l * 128 + 64] = run; ctl[CW_NT + l] = nt;
    }
}
__device__ __forceinline__ void phase_combine(Frame& F, int l) {
    const unsigned* ctl = (const unsigned*)(F.ws + WS_CTL); const int* EIDX = (const int*)(F.ws + WS_EIDX); const int* SLOT = (const int*)(F.ws + WS_SLOT);
    const bf16* Y = (const bf16*)(F.ws + BG_Y); const float* gate = (const float*)(F.ws + WS_MOD) + (size_t)((2 * l + 1) * 4) * 3072 + 2048; float* X = F.out;
    for (int row = F.gw; row < T; row += F.NGW) {
        const int b = row >> 12;
        f32x4 a[4];
#pragma unroll
        for (int j = 0; j < 4; ++j) a[j] = (f32x4){0.f, 0.f, 0.f, 0.f};
        for (int k = 0; k < 8; ++k) {
            const int e = EIDX[(size_t)row * 8 + k], pos = SLOT[(size_t)row * 8 + k];
            const size_t r = (size_t)ctl[CW_EST + l * 128 + e] + pos;
            const v2u* yp = (const v2u*)(Y + r * D) + F.lane;
#pragma unroll
            for (int j = 0; j < 4; ++j) { const v2u w = yp[64 * j]; a[j].x += bflo(w.x); a[j].y += bfhi(w.x); a[j].z += bflo(w.y); a[j].w += bfhi(w.y); }
        }
#pragma unroll
        for (int j = 0; j < 4; ++j) { const int c0 = 4 * F.lane + 256 * j; const f32x4 g = *(const f32x4*)(gate + (size_t)b * 3072 + c0);
            f32x4* xp = (f32x4*)(X + (size_t)row * D + c0); *xp = *xp + g * a[j]; }
    }
}
__device__ __forceinline__ void phase_pool(Frame& F) {
    const float* Hf = (const float*)(F.ws + BG_H2F); bf16* P = (bf16*)(F.ws + WS_H);
    for (int row = F.gw; row < T; row += F.NGW) {
        const int tp = row & 4095;
#pragma unroll
        for (int j = 0; j < 4; ++j) {
            const int win = 2 << j, c0 = 4 * F.lane + 256 * j;
            const int lo = (tp - win + 1) > 0 ? (tp - win + 1) : 0; const int cnt = tp - lo + 1;
            f32x4 s = (f32x4){0.f, 0.f, 0.f, 0.f};
            for (int q = 0; q < cnt; ++q) s = s + *(const f32x4*)(Hf + (size_t)(row - q) * D + c0);
            const f32x4 h = *(const f32x4*)(Hf + (size_t)row * D + c0);
            const float inv = 1.0f / (float)cnt;
            v2u o; o.x = pk2(s.x * inv - h.x, s.y * inv - h.y); o.y = pk2(s.z * inv - h.z, s.w * inv - h.w);
            *(v2u*)(P + (size_t)row * D + c0) = o;
        }
    }
}

constexpr int NPHASE = 29;
__global__ void __launch_bounds__(512, 2) mega(Args args_formal) {
    ArgsP const ap0 = (ArgsP)__builtin_amdgcn_kernarg_segment_ptr();
    extern __shared__ __attribute__((aligned(16))) unsigned char lds_raw[];
    Frame F;
    F.lds = (LAS unsigned char*)lds_raw;
    F.tid = threadIdx.x; F.lane = F.tid & 63; F.wave = __builtin_amdgcn_readfirstlane(F.tid >> 6);
    F.bid = blockIdx.x; F.G = gridDim.x; F.gw = F.bid * 8 + F.wave; F.NGW = F.G * 8;
    F.out = ap0->out; F.ws = ap0->ws;
    unsigned* ctl = (unsigned*)(F.ws + WS_CTL);
    const int lo = ap0->ph_lo, hi = ap0->ph_hi;
    volatile LAS unsigned* bst = (volatile LAS unsigned*)(F.lds + LDS_BYTES - 16);
    XcdBarrier bar; bar.bar = ctl + CW_BAR; bar.x = 0; bar.st = bst;
    const bool multi = (hi - lo) > 1;
    if (multi) { if (F.tid == 0) { bst[0] = 0u; bst[1] = 0u; } __syncthreads(); bar = xcd_barrier_post(ctl + CW_BAR, bst); }
#ifndef PHMASK
#define PHMASK 0xFFFFFFFFull
#endif
#define IN(k) ((((PHMASK) >> ((k) >= 20 ? (k) - 10 : (k))) & 1ull) && lo <= (k) && (k) < hi)
#define SEAM(k) do { if ((k) + 1 < hi) xcd_barrier(bar); } while (0)
#define PH_BEGIN(k) if (IN(k)) { { int t_ = threadIdx.x; asm volatile("" : "+v"(t_)); F.tid = t_; F.lane = t_ & 63; F.wave = __builtin_amdgcn_readfirstlane(t_ >> 6); F.gw = F.bid * 8 + F.wave; } ArgsP args = launder_args(ap0); ArgsP AR = args; (void)AR; F.out = args->out; F.ws = args->ws; ctl = (unsigned*)(F.ws + WS_CTL); const float* MOD = (const float*)(F.ws + WS_MOD); (void)MOD;
#define PH_END(k) } if (lo <= (k) && (k) < hi) SEAM(k);
    PH_BEGIN(0) phase_mod(F, args); __syncthreads(); phase_convert_static(F, args); phase_tables(F, args); PH_END(0)
    PH_BEGIN(1) phase_convert_experts(F, args, 0); PH_END(1)
    PH_BEGIN(2) phase_norm_mod(F, FIN(0), FIN(3), 0, (bf16*)(F.ws + WS_H), nullptr); PH_END(2)
    PH_BEGIN(3) DenseOrder S; S.init(F.ws + WS_H, F.ws + WS_WIN, 2048u, 2048u, T, INP, F.G, F.bid); EpiF32Store E{(float*)(F.ws + BG_PROJ), INP};
        pg8::gemm_phase<EpiF32Store, DenseOrder, false>(F.lds, F.tid, 1024, 2048u, 2048u, S, E); PH_END(3)
    PH_BEGIN(4) phase_postproj(F, args); PH_END(4)
    PH_BEGIN(5) phase_s5a(F, args); PH_END(5)
    PH_BEGIN(6) phase_s5b(F, args); PH_END(6)
    PH_BEGIN(7) phase_s5c(F, args); PH_END(7)
    PH_BEGIN(8) phase_dsa(F, args); PH_END(8)
    PH_BEGIN(9) DenseOrder S; S.init(F.ws + BG_MIX, F.ws + WS_WOUT, 2048u, 2048u, T, D, F.G, F.bid); EpiResidual E{FIN(0), F.out, MOD + 2048, nullptr, 0};
        pg8::gemm_phase<EpiResidual, DenseOrder, false>(F.lds, F.tid, 1024, 2048u, 2048u, S, E); PH_END(9)
#define MOE_PHASES(pb, l) \
    PH_BEGIN(pb) phase_router(F, args, l); PH_END(pb) \
    PH_BEGIN(pb + 1) phase_offsets(F, l); PH_END(pb + 1) \
    PH_BEGIN(pb + 2) typedef MoeOrder<2, true> O; O S; S.init(ctl, l, F.ws, false, true, F.G, F.bid); EpiGateUp<O> E{&S, F.ws}; \
        pg8::gemm_phase<EpiGateUp<O>, O, true>(F.lds, F.tid, 1024, 2048u, 2048u, S, E); PH_END(pb + 2) \
    PH_BEGIN(pb + 3) typedef MoeOrder<4, false> O; O S; S.init(ctl, l, F.ws, false, false, F.G, F.bid); EpiDown<O, false> E{&S, F.ws, F.out, MOD + (size_t)((2 * l + 1) * 4) * 3072 + 2048}; \
        pg8::gemm_phase<EpiDown<O, false>, O, false>(F.lds, F.tid, 256, 512u, 512u, S, E); PH_END(pb + 3) \
    PH_BEGIN(pb + 4) phase_combine(F, l); PH_END(pb + 4) \
    PH_BEGIN(pb + 5) typedef MoeOrder<4, false> O; O S; S.init(ctl, l, F.ws, true, true, F.G, F.bid); EpiDown<O, true> E{&S, F.ws, F.out, MOD + (size_t)((2 * l + 1) * 4) * 3072 + 2048}; \
        pg8::gemm_phase<EpiDown<O, true>, O, false>(F.lds, F.tid, 256, 512u, 512u, S, E); PH_END(pb + 5)
    MOE_PHASES(10, 0)
    PH_BEGIN(16) phase_convert_experts(F, args, 1); PH_END(16)
    PH_BEGIN(17) phase_norm_mod(F, F.out, FIN(3) + D, 2, nullptr, (float*)(F.ws + BG_H2F)); PH_END(17)
    PH_BEGIN(18) phase_pool(F); PH_END(18)
    PH_BEGIN(19) PoolOrder S; S.init(F.ws + WS_H, F.ws + WS_WPOOL, F.G, F.bid); EpiResidual E{F.out, F.out, MOD + (size_t)(2 * 4) * 3072 + 2048, FIN(24), 1};
        pg8::gemm_phase<EpiResidual, PoolOrder, false>(F.lds, F.tid, 256, 2048u, 512u, S, E); PH_END(19)
    MOE_PHASES(20, 1)
}

extern "C" void kernel_launch(void* const* d_in, const int* in_sizes, int n_in, void* d_out, int out_size, void* d_ws, size_t ws_size, hipStream_t stream) {
    static int grid = 0;
    if (grid == 0) {
        int dev = 0, cus = 0;
        if (n_in != 33 || ws_size < WS_END) { fprintf(stderr, "kernel_launch: unexpected n_in %d or ws_size %zu (need %zu)\n", n_in, ws_size, (size_t)WS_END); grid = -1; return; }
        if (hipGetDevice(&dev) != hipSuccess || hipDeviceGetAttribute(&cus, hipDeviceAttributeMultiprocessorCount, dev) != hipSuccess) { grid = -1; return; }
        if (hipFuncSetAttribute((const void*)mega, hipFuncAttributeMaxDynamicSharedMemorySize, LDS_BYTES) != hipSuccess) { fprintf(stderr, "kernel_launch: hipFuncSetAttribute failed\n"); grid = -1; return; }
        (void)hipGetLastError();
        grid = cus - (cus % 8); if (grid <= 0) grid = cus;
    }
    if (grid < 0) return;
    (void)hipMemsetAsync((char*)d_ws + WS_CTL, 0, CTL_ZERO_BYTES, stream);
    Args a{};
    for (int i = 0; i < 33; ++i) a.in[i] = (const float*)d_in[i];
    a.out = (float*)d_out; a.ws = (unsigned char*)d_ws;
    const int last = 26;
#if MK_LAUNCH_PER_PHASE
    for (int p = 0; p < last; ++p) { a.ph_lo = p; a.ph_hi = p + 1; hipLaunchKernelGGL(mega, dim3(grid), dim3(512), LDS_BYTES, stream, a); }
#else
    a.ph_lo = 0; a.ph_hi = last; hipLaunchKernelGGL(mega, dim3(grid), dim3(512), LDS_BYTES, stream, a);
#endif
}
```

```cpp
#include <hip/hip_runtime.h>
#include <cstdio>
#include <cstdint>

#ifndef MK_LAUNCH_PER_PHASE
#define MK_LAUNCH_PER_PHASE 0
#endif

#define GAS __attribute__((address_space(1)))
#define LAS __attribute__((address_space(3)))
typedef unsigned short bf16;
typedef unsigned v4u __attribute__((ext_vector_type(4)));
typedef unsigned v2u __attribute__((ext_vector_type(2)));
typedef float f32x4 __attribute__((ext_vector_type(4)));
typedef short bf16x8 __attribute__((ext_vector_type(8)));
#define LDS_WAIT() asm volatile("s_waitcnt lgkmcnt(0)" ::: "memory")
#define VM_WAIT() asm volatile("s_waitcnt vmcnt(0)" ::: "memory")

constexpr int NB = 4, SEQ = 4096, T = NB * SEQ, D = 1024;
constexpr int INW = 1736, INP = 1792;
constexpr int NEXP = 64, EDIM = 256;
constexpr int NASSIGN = T * 8;
constexpr int ECAP = T;

constexpr size_t MiB = 1u << 20;
constexpr size_t WS_CTL = 0;
constexpr size_t CTL_ZERO_BYTES = 1 * MiB;
constexpr size_t WS_MOD = 1 * MiB;
constexpr size_t WS_ROPE = WS_MOD + 256 * 1024;
constexpr size_t WS_S5T = WS_ROPE + 1 * MiB;
constexpr size_t WS_WIN = 4 * MiB;
constexpr size_t WS_WOUT = WS_WIN + (size_t)INP * D * 2;
constexpr size_t WS_WPOOL = WS_WOUT + (size_t)D * D * 2;
constexpr size_t WS_WGU = 10 * MiB;
constexpr size_t WS_WD = WS_WGU + (size_t)65 * 512 * 1024 * 2;
constexpr size_t WS_H = WS_WD + (size_t)65 * 1024 * 256 * 2;
constexpr size_t WS_EIDX = WS_H + (size_t)T * D * 2;
constexpr size_t WS_SLOT = WS_EIDX + (size_t)T * 8 * 4;
constexpr size_t WS_ELT = WS_SLOT + (size_t)T * 8 * 4;
constexpr size_t WS_ELW = WS_ELT + (size_t)NEXP * ECAP * 4;
constexpr size_t WS_BIG = WS_ELW + (size_t)NEXP * ECAP * 4;
constexpr size_t BG_PROJ = WS_BIG;
constexpr size_t BG_U = BG_PROJ + (size_t)T * INP * 4;
constexpr size_t BG_Q = BG_U + (size_t)T * 512 * 4;
constexpr size_t BG_QI = BG_Q + (size_t)T * 512 * 2;
constexpr size_t BG_K = BG_QI + (size_t)T * 512 * 2;
constexpr size_t BG_V = BG_K + (size_t)T * 64 * 2;
constexpr size_t BG_KI = BG_V + (size_t)T * 64 * 2;
constexpr size_t BG_WI = BG_KI + (size_t)T * 64 * 2;
constexpr size_t BG_SLOC = BG_WI + (size_t)T * 8 * 4;
constexpr size_t BG_SIN = BG_SLOC + (size_t)4 * 32 * 64 * 64 * 2 * 4;
constexpr size_t BG_MIX = BG_SIN + (size_t)4 * 32 * 64 * 64 * 2 * 4;
constexpr size_t BG_VT = BG_MIX + (size_t)T * D * 2;
constexpr size_t BG_MIXER_END = BG_VT + (size_t)T * 64 * 2;
constexpr size_t BG_HB = WS_BIG;
constexpr size_t BG_HBSH = BG_HB + (size_t)(NASSIGN + 256) * 256 * 2;
constexpr size_t BG_Y = BG_HBSH + (size_t)T * 256 * 2;
constexpr size_t BG_MOE_END = BG_Y + (size_t)NASSIGN * D * 2;
constexpr size_t BG_H2F = WS_BIG;
constexpr size_t WS_END = (BG_MOE_END > BG_MIXER_END ? BG_MOE_END : BG_MIXER_END);
static_assert(WS_END <= 539993216ull, "workspace map exceeds the guaranteed d_ws size");

constexpr int S5_ABAR = 0;
constexpr int S5_A64 = S5_ABAR + 32 * 64 * 2;
constexpr int S5_BBR = S5_A64 + 32 * 64 * 2;
constexpr int S5_BBI = S5_BBR + 32 * 64 * 16;

constexpr int CW_BAR = 4096;
constexpr int CW_CNT = 16384;
constexpr int CW_EST = 16384 + 256;
constexpr int CW_NT = 16384 + 512;
constexpr int CW_TE = 16384 + 1024;
constexpr int CW_TJ = 16384 + 4096;
constexpr int LDS_BYTES = 163840;

__device__ __forceinline__ unsigned f2bf(float f) { unsigned u = __builtin_bit_cast(unsigned, f); return (u + 0x7fffu + ((u >> 16) & 1u)) >> 16; }
__device__ __forceinline__ unsigned pk2(float lo, float hi) { return f2bf(lo) | (f2bf(hi) << 16); }
__device__ __forceinline__ float bf2f(unsigned b) { return __builtin_bit_cast(float, b << 16); }
__device__ __forceinline__ float bflo(unsigned w) { return __builtin_bit_cast(float, w << 16); }
__device__ __forceinline__ float bfhi(unsigned w) { return __builtin_bit_cast(float, w & 0xffff0000u); }
__device__ __forceinline__ float wave_sum(float v) {
#pragma unroll
    for (int o = 1; o < 64; o <<= 1) v += __shfl_xor(v, o);
    return v;
}
__device__ __forceinline__ float wave_max(float v) {
#pragma unroll
    for (int o = 1; o < 64; o <<= 1) v = fmaxf(v, __shfl_xor(v, o));
    return v;
}
__device__ __forceinline__ int wave_sum_i(int v) {
#pragma unroll
    for (int o = 1; o < 64; o <<= 1) v += __shfl_xor(v, o);
    return v;
}
__device__ __forceinline__ float sigmoidf_(float x) { return 1.0f / (1.0f + __expf(-x)); }

namespace pg8 {
typedef float f32x4 __attribute__((ext_vector_type(4)));
constexpr int BM = 256, BK = 64, HALF = 128, HTB = HALF * BK * 2, STAGE_BYTES = 8 * HTB;
__host__ __device__ __forceinline__ int lds_byte(int r, int c) { const int st = (r >> 4) * 2 + (c >> 5), rr = r & 15, cc = c & 31, ob = rr * 64 + cc * 2; return st * 1024 + (ob ^ (((ob >> 9) & 1) << 5)); }
__host__ __device__ __forceinline__ void stage_rc(int b, int& R, int& C) { const int st = b / 1024, sb = b % 1024, swz = sb ^ (((sb >> 9) & 1) << 5); R = (st >> 1) * 16 + swz / 64; C = (st & 1) * 32 + (swz % 64) / 2; }
struct Unit { int pm, pn, e, rows; };
template <class Epi, class Sched, bool GATHER>
__device__ __forceinline__ void gemm_phase(LAS unsigned char* lds, const int tid, const int K, const unsigned lda_b, const unsigned ldb_b, const Sched& S, const Epi& E) {
    const int wid = __builtin_amdgcn_readfirstlane(tid >> 6), lane = tid & 63, wr = wid >> 2, wc = wid & 3, fr = lane & 15, fq = lane >> 4;
    const int nt = K / BK;
    unsigned voffA[2], voffB[2]; int RA[2], CA[2];
#pragma unroll
    for (int i = 0; i < 2; ++i) { int R, C; stage_rc(tid * 16 + i * 8192, R, C); RA[i] = R; CA[i] = C; voffA[i] = (unsigned)R * lda_b + (unsigned)C * 2u; voffB[i] = (unsigned)R * ldb_b + (unsigned)C * 2u; }
    const size_t kstep = (size_t)(BK * 2);
    const size_t hstepA = (size_t)HALF * lda_b, hstepB = (size_t)HALF * ldb_b;
    const unsigned ldsw = (unsigned)wid * 1024u;
    const int aoff = lds_byte(wr * 64 + fr, fq * 8), boff = lds_byte(wc * 32 + fr, fq * 8);
#define PG8_SA(b, h) (((b) * 2 + (h)) * HTB)
#define PG8_SB(b, h) ((4 + (b) * 2 + (h)) * HTB)
#define PG8_STAGE(bufoff, gbase, voff) do { _Pragma("unroll") for (int _i = 0; _i < 2; ++_i) \
        __builtin_amdgcn_global_load_lds((const unsigned*)((const char*)(gbase) + (voff)[_i]), (LAS unsigned*)(lds + (bufoff) + ldsw + _i * 8192), 16, 0, 0); } while (0)
#define PG8_STAGE_A(bufoff, gbase, h, OS) do { if constexpr (GATHER) { PG8_STAGE(bufoff, gbase, g##OS##h); } else { PG8_STAGE(bufoff, (gbase) + (h) * hstepA, voffA); } } while (0)
#define PG8_LDA(dst, b, h) do { _Pragma("unroll") for (int m = 0; m < 4; ++m) _Pragma("unroll") for (int k = 0; k < 2; ++k) dst[m][k] = *(const LAS bf16x8*)(lds + PG8_SA(b, h) + aoff + m * 2048 + k * 1024); } while (0)
#define PG8_LDB(dst, b, h) do { _Pragma("unroll") for (int n = 0; n < 2; ++n) _Pragma("unroll") for (int k = 0; k < 2; ++k) dst[n][k] = *(const LAS bf16x8*)(lds + PG8_SB(b, h) + boff + n * 2048 + k * 1024); } while (0)
#define PG8_MMA(ai, bj, At, Bt) do { __builtin_amdgcn_s_setprio(1); _Pragma("unroll") for (int m = 0; m < 4; ++m) _Pragma("unroll") for (int n = 0; n < 2; ++n) _Pragma("unroll") for (int k = 0; k < 2; ++k) \
        acc[ai][bj][m][n] = __builtin_amdgcn_mfma_f32_16x16x32_bf16(Bt[n][k], At[m][k], acc[ai][bj][m][n], 0, 0, 0); __builtin_amdgcn_s_setprio(0); } while (0)
#define PG8_WAIT_V(n) asm volatile("s_waitcnt vmcnt(" #n ")" ::: "memory")
#define PG8_WAIT_L(n) asm volatile("s_waitcnt lgkmcnt(" #n ")" ::: "memory")
#define PG8_BAR __builtin_amdgcn_s_barrier()
#define PG8_SCHED __builtin_amdgcn_sched_barrier(0)
    Unit cur, nxt; int ui = 0;
    if (!S.next(0, cur)) return;
    f32x4 acc[2][2][4][2];
#pragma unroll
    for (int a = 0; a < 2; ++a)
#pragma unroll
        for (int b = 0; b < 2; ++b)
#pragma unroll
            for (int m = 0; m < 4; ++m)
#pragma unroll
                for (int n = 0; n < 2; ++n) acc[a][b][m][n] = (f32x4){0.f, 0.f, 0.f, 0.f};
    bf16x8 At[4][2], B0[2][2], B1[2][2];
    unsigned gc0[2] = {0u, 0u}, gc1[2] = {0u, 0u}, gn0[2] = {0u, 0u}, gn1[2] = {0u, 0u};
    const char* cA = S.a_base(cur); const char* cB = S.b_base(cur);
    if constexpr (GATHER) {
#pragma unroll
        for (int i = 0; i < 2; ++i) { gc0[i] = S.a_off(cur, RA[i]) + (unsigned)CA[i] * 2u; gc1[i] = S.a_off(cur, HALF + RA[i]) + (unsigned)CA[i] * 2u; }
    }
    PG8_STAGE(PG8_SB(0, 0), cB, voffB); PG8_STAGE(PG8_SB(0, 1), cB + hstepB, voffB); PG8_STAGE_A(PG8_SA(0, 0), cA, 0, c); PG8_STAGE_A(PG8_SA(0, 1), cA, 1, c);
    if (wr == 1) PG8_BAR;
    PG8_WAIT_V(2); PG8_BAR;
    PG8_STAGE(PG8_SB(1, 0), cB + kstep, voffB); PG8_STAGE_A(PG8_SA(1, 0), cA + kstep, 0, c); PG8_STAGE(PG8_SB(1, 1), cB + hstepB + kstep, voffB);
    PG8_WAIT_V(6); PG8_BAR;
#pragma unroll 1
    for (;;) {
        const bool has_next = S.next(ui + 1, nxt);
        const char* nA = has_next ? S.a_base(nxt) : cA; const char* nB = has_next ? S.b_base(nxt) : cB;
        if constexpr (GATHER) {
            if (has_next) {
#pragma unroll
                for (int i = 0; i < 2; ++i) { gn0[i] = S.a_off(nxt, RA[i]) + (unsigned)CA[i] * 2u; gn1[i] = S.a_off(nxt, HALF + RA[i]) + (unsigned)CA[i] * 2u; }
            } else {
#pragma unroll
                for (int i = 0; i < 2; ++i) { gn0[i] = gc0[i]; gn1[i] = gc1[i]; }
            }
        }
#pragma unroll 1
        for (int t = 0; t < nt; t += 2) {
            const bool last = (t == nt - 2);
            const char* a1 = cA + (size_t)(t + 1) * kstep;
            const char* a2 = last ? nA : cA + (size_t)(t + 2) * kstep; const char* b2 = last ? nB : cB + (size_t)(t + 2) * kstep;
            const char* a3 = a2 + kstep; const char* b3 = b2 + kstep;
            unsigned gx0[2], gx1[2];
#pragma unroll
            for (int i = 0; i < 2; ++i) { gx0[i] = last ? gn0[i] : gc0[i]; gx1[i] = last ? gn1[i] : gc1[i]; }
            (void)gx0; (void)gx1;
            PG8_LDB(B0, 0, 0); PG8_LDB(B1, 0, 1); PG8_SCHED; PG8_LDA(At, 0, 0); PG8_STAGE_A(PG8_SA(1, 1), a1, 1, c);
            PG8_WAIT_V(8); PG8_WAIT_L(0); PG8_BAR; PG8_MMA(0, 0, At, B0); PG8_MMA(0, 1, At, B1); PG8_BAR; PG8_SCHED;
            PG8_LDA(At, 0, 1); PG8_STAGE(PG8_SB(0, 0), b2, voffB); PG8_STAGE(PG8_SB(0, 1), b2 + hstepB, voffB); PG8_STAGE_A(PG8_SA(0, 0), a2, 0, x);
            PG8_WAIT_V(8); PG8_WAIT_L(0); PG8_BAR; PG8_MMA(1, 0, At, B0); PG8_MMA(1, 1, At, B1); PG8_BAR; PG8_SCHED;
            PG8_LDB(B0, 1, 0); PG8_LDB(B1, 1, 1); PG8_SCHED; PG8_LDA(At, 1, 0); PG8_STAGE_A(PG8_SA(0, 1), a2, 1, x);
            PG8_WAIT_V(8); PG8_WAIT_L(0); PG8_BAR; PG8_MMA(0, 0, At, B0); PG8_MMA(0, 1, At, B1); PG8_BAR; PG8_SCHED;
            PG8_LDA(At, 1, 1); PG8_STAGE(PG8_SB(1, 0), b3, voffB); PG8_STAGE(PG8_SB(1, 1), b3 + hstepB, voffB); PG8_STAGE_A(PG8_SA(1, 0), a3, 0, x);
            PG8_WAIT_V(8); PG8_WAIT_L(0); PG8_BAR; PG8_MMA(1, 0, At, B0); PG8_MMA(1, 1, At, B1); PG8_BAR; PG8_SCHED;
        }
        if (wr == 0) PG8_BAR;
        E(acc, cur, wr, wc, fr, fq);
        if (!has_next) break;
#pragma unroll
        for (int a = 0; a < 2; ++a)
#pragma unroll
            for (int b = 0; b < 2; ++b)
#pragma unroll
                for (int m = 0; m < 4; ++m)
#pragma unroll
                    for (int n = 0; n < 2; ++n) acc[a][b][m][n] = (f32x4){0.f, 0.f, 0.f, 0.f};
        cur = nxt; cA = nA; cB = nB; ++ui;
        if constexpr (GATHER) {
#pragma unroll
            for (int i = 0; i < 2; ++i) { gc0[i] = gn0[i]; gc1[i] = gn1[i]; }
        }
        if (wr == 1) PG8_BAR;
    }
    PG8_WAIT_V(0);
    PG8_BAR;
#undef PG8_SA
#undef PG8_SB
#undef PG8_STAGE
#undef PG8_STAGE_A
#undef PG8_LDA
#undef PG8_LDB
#undef PG8_MMA
#undef PG8_WAIT_V
#undef PG8_WAIT_L
#undef PG8_BAR
#undef PG8_SCHED
}
}

#define XB_TMO      128
#define XB_XCNT(j)  (256  + 64 * (j))
#define XB_XSUB(j)  (1280 + 64 * (j))
#define XB_XGEN(j)  (2304 + 64 * (j))
#define XB_TOP      3328
#define XB_TOPGEN   3392
#define XCD_BAR_WORDS 3456
#define XB_SPIN_CAP (1u << 22)
__device__ __forceinline__ unsigned xb_ld(unsigned* p)              { return __hip_atomic_load(p, __ATOMIC_RELAXED, __HIP_MEMORY_SCOPE_AGENT); }
__device__ __forceinline__ unsigned xb_add(unsigned* p, unsigned v) { return __hip_atomic_fetch_add(p, v, __ATOMIC_RELAXED, __HIP_MEMORY_SCOPE_AGENT); }
__device__ __forceinline__ unsigned xb_xcc_id() { return (unsigned)__builtin_amdgcn_s_getreg((3 << 11) | 20) & 0xFu; }
#define XB_SPIN(cond, bar) do { unsigned _sp = 0; while (cond) { __builtin_amdgcn_s_sleep(1); \
    if ((++_sp & 255u) == 0u) { if (xb_ld(&(bar)[XB_TMO])) break; if (_sp > XB_SPIN_CAP) { atomicAdd(&(bar)[XB_TMO], 1u); break; } } } } while (0)
struct XcdBarrier { unsigned* bar; unsigned x; volatile LAS unsigned* st; };
__device__ __forceinline__ XcdBarrier xcd_barrier_post(unsigned* bar, volatile LAS unsigned* st) {
    XcdBarrier b; b.bar = bar; b.x = xb_xcc_id(); b.st = st;
    if (threadIdx.x == 0) (void)xb_add(&bar[XB_XCNT(b.x)], 1u);
    return b;
}
__device__ __forceinline__ void xcd_barrier_complete(unsigned* bar, unsigned x, unsigned& nloc, unsigned& nx) {
    const unsigned G = gridDim.x * gridDim.y * gridDim.z;
    unsigned sum, cnt, mine, sp = 0u;
    for (;;) {
        sum = 0u; cnt = 0u; mine = 0u;
#pragma unroll
        for (unsigned j = 0; j < 16; ++j) { const unsigned c = xb_ld(&bar[XB_XCNT(j)]); sum += c; cnt += (c > 0u) ? 1u : 0u; mine = (j == x) ? c : mine; }
        if (sum == G) break;
        __builtin_amdgcn_s_sleep(1);
        if ((++sp & 255u) == 0u) { if (xb_ld(&bar[XB_TMO])) break; if (sp > XB_SPIN_CAP) { atomicAdd(&bar[XB_TMO], 1u); break; } }
    }
    nloc = mine > 0u ? mine : 1u; nx = cnt > 0u ? cnt : 1u;
}
__device__ __forceinline__ void xcd_barrier(const XcdBarrier& b) {
    asm volatile("s_waitcnt vmcnt(0)" ::: "memory");
    __syncthreads();
    if (threadIdx.x == 0) {
        unsigned* bar = b.bar;
        __builtin_amdgcn_s_waitcnt(0);
        unsigned nloc = b.st[0], nx = b.st[1];
        if (nloc == 0u) { xcd_barrier_complete(bar, b.x, nloc, nx); b.st[0] = nloc; b.st[1] = nx; }
        const unsigned old = xb_add(&bar[XB_XSUB(b.x)], 1u);
        const unsigned gen = old / nloc;
        if (old + 1u == (gen + 1u) * nloc) {
            __builtin_amdgcn_fence(__ATOMIC_RELEASE, "agent");
            asm volatile("s_waitcnt vmcnt(0)" ::: "memory");
            const unsigned og = xb_add(&bar[XB_TOP], 1u);
            const unsigned tg = og / nx;
            if (og + 1u == (tg + 1u) * nx) xb_add(&bar[XB_TOPGEN], 1u);
            else XB_SPIN(xb_ld(&bar[XB_TOPGEN]) == tg, bar);
            __builtin_amdgcn_fence(__ATOMIC_ACQUIRE, "agent");
            xb_add(&bar[XB_XGEN(b.x)], 1u);
            asm volatile("s_waitcnt vmcnt(0)" ::: "memory");
        } else {
            XB_SPIN(xb_ld(&bar[XB_XGEN(b.x)]) == gen, bar);
            __builtin_amdgcn_fence(__ATOMIC_ACQUIRE, "agent");
            asm volatile("s_waitcnt vmcnt(0)" ::: "memory");
        }
    }
    __syncthreads();
}

struct Frame {
    LAS unsigned char* lds;
    int tid, lane, wave, bid, G, gw, NGW;
    float* out; unsigned char* ws;
};
struct Args { const float* in[33]; float* out; unsigned char* ws; int ph_lo, ph_hi; };
#define FIN(i) (AR->in[i])
#define CAS __attribute__((address_space(4)))
typedef const CAS Args* ArgsP;
__device__ __forceinline__ ArgsP launder_args(ArgsP p) { asm volatile("" : "+s"(p)); return p; }

__device__ __forceinline__ void phase_mod(Frame& F, ArgsP AR) {
    LAS float* cs = (LAS float*)F.lds;
    LAS float* red = cs + 4096;
    const float* c = FIN(1);
    for (int i = F.tid; i < 4096; i += 512) { const float v = c[i]; cs[i] = v / (1.0f + __expf(-v)); }
    __syncthreads();
    float* MOD = (float*)(F.ws + WS_MOD);
    for (int it = F.bid; it < 192; it += F.G) {
        const int m = it / 48, n0 = (it % 48) * 64, l = m >> 1;
        const float* W = ((m & 1) ? FIN(7) : FIN(4)) + (size_t)l * 1024 * 3072;
        const float* bias = ((m & 1) ? FIN(8) : FIN(5)) + (size_t)l * 3072;
        float a0 = 0.f, a1 = 0.f, a2 = 0.f, a3 = 0.f;
        const int k0 = F.wave * 128;
#pragma unroll 8
        for (int k = k0; k < k0 + 128; ++k) {
            const float w = W[(size_t)k * 3072 + n0 + F.lane];
            a0 += cs[k] * w; a1 += cs[1024 + k] * w; a2 += cs[2048 + k] * w; a3 += cs[3072 + k] * w;
        }
        red[(F.wave * 4 + 0) * 64 + F.lane] = a0; red[(F.wave * 4 + 1) * 64 + F.lane] = a1; red[(F.wave * 4 + 2) * 64 + F.lane] = a2; red[(F.wave * 4 + 3) * 64 + F.lane] = a3;
        __syncthreads();
        if (F.tid < 256) { const int b = F.tid >> 6, n = F.tid & 63; float s = 0.f;
#pragma unroll
            for (int w = 0; w < 8; ++w) s += red[(w * 4 + b) * 64 + n];
            MOD[(size_t)(m * 4 + b) * 3072 + n0 + n] = s + bias[n0 + n]; }
        __syncthreads();
    }
}

__device__ __forceinline__ void transpose_item(const float* W, int ldw, int nvalid, int K, bf16* WT, int mode, LAS float* scr, int kb, int nb, int lane) {
    const int k0 = 64 * kb, n0 = 32 * nb;
    const int nn = n0 + (lane & 31);
#pragma unroll 8
    for (int i = 0; i < 32; ++i) { const int kk = 2 * i + (lane >> 5); scr[kk * 33 + (lane & 31)] = (nn < nvalid) ? W[(size_t)(k0 + kk) * ldw + nn] : 0.f; }
    LDS_WAIT();
    const int c = lane & 7;
#pragma unroll
    for (int j = 0; j < 4; ++j) { const int nl = (lane >> 3) + 8 * j; const LAS float* s = scr + (8 * c) * 33 + nl;
        v4u o; o.x = pk2(s[0 * 33], s[1 * 33]); o.y = pk2(s[2 * 33], s[3 * 33]); o.z = pk2(s[4 * 33], s[5 * 33]); o.w = pk2(s[6 * 33], s[7 * 33]);
        const int n = n0 + nl; const int row = (mode == 0) ? n : (256 * (n >> 7) + (n & 127) + (mode == 2 ? 128 : 0));
        *(v4u*)(WT + (size_t)row * K + k0 + 8 * c) = o; }
    LDS_WAIT();
}
__device__ __forceinline__ void phase_convert_static(Frame& F, ArgsP AR) {
    LAS float* scr = (LAS float*)(F.lds + F.wave * 16384);
    constexpr int I_IN = 16 * 56, I_OUT = 16 * 32, I_POOL = 4 * 4 * 8;
    for (int it = F.gw; it < I_IN + I_OUT + I_POOL; it += F.NGW) {
        int r = it;
        if (r < I_IN) { transpose_item(FIN(9), INW, INW, 1024, (bf16*)(F.ws + WS_WIN), 0, scr, r / 56, r % 56, F.lane); continue; } r -= I_IN;
        if (r < I_OUT) { transpose_item(FIN(10), 1024, 1024, 1024, (bf16*)(F.ws + WS_WOUT), 0, scr, r / 32, r % 32, F.lane); continue; } r -= I_OUT;
        const int g = r / 32, rr = r % 32;
        transpose_item(FIN(23) + (size_t)g * 65536, 256, 256, 256, (bf16*)(F.ws + WS_WPOOL) + (size_t)g * 65536, 0, scr, rr / 8, rr % 8, F.lane);
    }
}
__device__ __forceinline__ void phase_convert_experts(Frame& F, ArgsP AR, int l) {
    LAS float* scr = (LAS float*)(F.lds + F.wave * 16384);
    for (int it = F.gw; it < 65 * 384; it += F.NGW) {
        const int e = it / 384, r = it % 384, type = r >> 7, sub = r & 127;
        if (type < 2) {
            const float* W = (e < 64) ? (FIN(type == 0 ? 27 : 28) + (size_t)(l * 64 + e) * 1024 * 256) : (FIN(type == 0 ? 30 : 31) + (size_t)l * 1024 * 256);
            transpose_item(W, 256, 256, 1024, (bf16*)(F.ws + WS_WGU) + (size_t)e * 512 * 1024, 1 + type, scr, sub >> 3, sub & 7, F.lane);
        } else {
            const float* W = (e < 64) ? (FIN(29) + (size_t)(l * 64 + e) * 256 * 1024) : (FIN(32) + (size_t)l * 256 * 1024);
            transpose_item(W, 1024, 1024, 256, (bf16*)(F.ws + WS_WD) + (size_t)e * 1024 * 256, 0, scr, sub >> 5, sub & 31, F.lane);
        }
    }
}

__device__ __forceinline__ void phase_tables(Frame& F, ArgsP AR) {
    float* S5 = (float*)(F.ws + WS_S5T);
    const int gid = F.bid * 512 + F.tid, NT_ = F.G * 512;
    for (int i = gid; i < 2048; i += NT_) {
        const int g = i >> 6;
        const double lr = FIN(11)[i], li = FIN(12)[i], dt = exp((double)FIN(13)[g]);
        const double mag = exp(lr * dt), ar = mag * cos(li * dt), ai = mag * sin(li * dt);
        const double nr = ar - 1.0, ni = ai, den = lr * lr + li * li;
        const double cr = (nr * lr + ni * li) / den, ci = (ni * lr - nr * li) / den;
        S5[S5_ABAR + 2 * i] = (float)ar; S5[S5_ABAR + 2 * i + 1] = (float)ai;
        double pr = ar, pi = ai;
        for (int s = 0; s < 6; ++s) { const double t = pr * pr - pi * pi; pi = 2.0 * pr * pi; pr = t; }
        S5[S5_A64 + 2 * i] = (float)pr; S5[S5_A64 + 2 * i + 1] = (float)pi;
        for (int h = 0; h < 16; ++h) { const double br = FIN(14)[i * 16 + h], bi = FIN(15)[i * 16 + h];
            S5[S5_BBR + i * 16 + h] = (float)(cr * br - ci * bi); S5[S5_BBI + i * 16 + h] = (float)(cr * bi + ci * br); }
    }
    float* ROPE = (float*)(F.ws + WS_ROPE);
    const int* pos = (const int*)FIN(2);
    for (int i = gid; i < T * 8; i += NT_) {
        const int t = i >> 3, j = i & 7;
        const float inv = (float)pow(500000.0, -(double)(2 * j) / 16.0);
        const float ang = (float)pos[t] * inv;
        ROPE[2 * i] = (float)cos((double)ang); ROPE[2 * i + 1] = (float)sin((double)ang);
    }
}

__device__ __forceinline__ void phase_norm_mod(Frame& F, const float* X, const float* gamma, int m, bf16* Hout, float* Hf) {
    const float* MOD = (const float*)(F.ws + WS_MOD);
    for (int row = F.gw; row < T; row += F.NGW) {
        const int b = row >> 12;
        const float* shift = MOD + (size_t)(m * 4 + b) * 3072; const float* scale = shift + 1024;
        const f32x4* xr = (const f32x4*)(X + (size_t)row * D) + F.lane;
        f32x4 v[4]; float ss = 0.f;
#pragma unroll
        for (int j = 0; j < 4; ++j) { v[j] = xr[64 * j]; ss += v[j].x * v[j].x + v[j].y * v[j].y + v[j].z * v[j].z + v[j].w * v[j].w; }
        const float rstd = rsqrtf(wave_sum(ss) * (1.0f / D) + 1e-6f);
#pragma unroll
        for (int j = 0; j < 4; ++j) {
            const int c0 = 4 * F.lane + 256 * j;
            const f32x4 gg = *(const f32x4*)(gamma + c0), sc = *(const f32x4*)(scale + c0), sh = *(const f32x4*)(shift + c0);
            f32x4 h; h.x = v[j].x * rstd * gg.x * (1.f + sc.x) + sh.x; h.y = v[j].y * rstd * gg.y * (1.f + sc.y) + sh.y;
            h.z = v[j].z * rstd * gg.z * (1.f + sc.z) + sh.z; h.w = v[j].w * rstd * gg.w * (1.f + sc.w) + sh.w;
            if (Hout) { v2u o; o.x = pk2(h.x, h.y); o.y = pk2(h.z, h.w); *(v2u*)(Hout + (size_t)row * D + c0) = o; }
            if (Hf) *(f32x4*)(Hf + (size_t)row * D + c0) = h;
        }
    }
}

struct DenseOrder {
    const char* A; const char* Bt; unsigned lda_b, ldb_b; int nM, nN, nU, chunk, x, q0, qs;
    __device__ __forceinline__ void init(const void* A_, const void* Bt_, unsigned lda, unsigned ldb, int M, int N, int G, int c) {
        A = (const char*)A_; Bt = (const char*)Bt_; lda_b = lda; ldb_b = ldb; nM = M / 256; nN = N / 256; nU = nM * nN; chunk = (nU + 7) / 8; x = c & 7; q0 = c >> 3; qs = G >> 3; }
    __device__ __forceinline__ bool next(int i, pg8::Unit& u) const {
        const int q = i * qs + q0; if (q >= chunk) return false; const int L = x * chunk + q; if (L >= nU) return false;
        u.pm = L / nN; u.pn = L % nN; u.e = 0; u.rows = 256; return true; }
    __device__ __forceinline__ const char* a_base(const pg8::Unit& u) const { return A + (size_t)u.pm * 256 * lda_b; }
    __device__ __forceinline__ const char* b_base(const pg8::Unit& u) const { return Bt + (size_t)u.pn * 256 * ldb_b; }
    __device__ __forceinline__ unsigned a_off(const pg8::Unit&, int) const { return 0u; }
};
struct PoolOrder {
    const char* A; const char* Bt; int nU, chunk, x, q0, qs;
    __device__ __forceinline__ void init(const void* A_, const void* Bt_, int G, int c) { A = (const char*)A_; Bt = (const char*)Bt_; nU = 64 * 4; chunk = (nU + 7) / 8; x = c & 7; q0 = c >> 3; qs = G >> 3; }
    __device__ __forceinline__ bool next(int i, pg8::Unit& u) const {
        const int q = i * qs + q0; if (q >= chunk) return false; const int L = x * chunk + q; if (L >= nU) return false;
        u.pm = L >> 2; u.pn = L & 3; u.e = L & 3; u.rows = 256; return true; }
    __device__ __forceinline__ const char* a_base(const pg8::Unit& u) const { return A + (size_t)u.pm * 256 * 2048 + (size_t)u.e * 512; }
    __device__ __forceinline__ const char* b_base(const pg8::Unit& u) const { return Bt + (size_t)u.e * 256 * 512; }
    __device__ __forceinline__ unsigned a_off(const pg8::Unit&, int) const { return 0u; }
};
template <int NPN, bool GATE_UP>
struct MoeOrder {
    const unsigned* ctl; int l; const unsigned char* ws; int ntr, ntiles, nU, chunk, x, q0, qs; bool with_shared;
    __device__ __forceinline__ void init(const unsigned* ctl_, int l_, const unsigned char* ws_, bool shared_only, bool with_sh, int G, int c) {
        ctl = ctl_; l = l_; ws = ws_; with_shared = with_sh;
        ntr = shared_only ? 0 : (int)ctl[CW_NT + l]; ntiles = ntr + (with_sh ? 64 : 0); nU = ntiles * NPN; chunk = (nU + 7) / 8; x = c & 7; q0 = c >> 3; qs = G >> 3; }
    __device__ __forceinline__ bool next(int i, pg8::Unit& u) const {
        const int q = i * qs + q0; if (q >= chunk) return false; const int L = x * chunk + q; if (L >= nU) return false;
        const int tile = L / NPN; u.pn = L % NPN;
        if (tile < ntr) { u.e = (int)ctl[CW_TE + l * 1024 + tile]; u.pm = (int)ctl[CW_TJ + l * 1024 + tile]; const int cnt = (int)ctl[CW_CNT + l * 64 + u.e]; const int rem = cnt - 256 * u.pm; u.rows = rem < 256 ? rem : 256; }
        else { u.e = 64; u.pm = tile - ntr; u.rows = 256; }
        return true; }
    __device__ __forceinline__ int row0(const pg8::Unit& u) const { return (u.e < 64) ? (int)ctl[CW_EST + l * 128 + u.e] + 256 * u.pm : 256 * u.pm; }
    __device__ __forceinline__ const char* a_base(const pg8::Unit& u) const {
        if (GATE_UP) return (const char*)(ws + WS_H);
        return (u.e < 64) ? (const char*)(ws + BG_HB) + (size_t)row0(u) * 512 : (const char*)(ws + BG_HBSH) + (size_t)row0(u) * 512; }
    __device__ __forceinline__ const char* b_base(const pg8::Unit& u) const {
        if (GATE_UP) return (const char*)(ws + WS_WGU) + (size_t)u.e * 512 * 2048 + (size_t)u.pn * 256 * 2048;
        return (const char*)(ws + WS_WD) + (size_t)u.e * 1024 * 512 + (size_t)u.pn * 256 * 512; }
    __device__ __forceinline__ unsigned a_off(const pg8::Unit& u, int r) const {
        int tok;
        if (u.e < 64) { const int* elt = (const int*)(ws + WS_ELT) + (size_t)u.e * ECAP + 256 * u.pm; tok = (r < u.rows) ? elt[r] : 0; }
        else tok = 256 * u.pm + r;
        return (unsigned)tok * 2048u; }
};

struct EpiF32Store { float* C; int ldc;
    __device__ __forceinline__ void operator()(const pg8::f32x4 (&acc)[2][2][4][2], const pg8::Unit& u, int wr, int wc, int fr, int fq) const {
#pragma unroll
        for (int ai = 0; ai < 2; ++ai)
#pragma unroll
            for (int m = 0; m < 4; ++m) { float* rowp = C + (size_t)(u.pm * 256 + ai * 128 + wr * 64 + m * 16 + fr) * ldc + u.pn * 256 + wc * 32 + 4 * fq;
#pragma unroll
                for (int bj = 0; bj < 2; ++bj)
#pragma unroll
                    for (int n = 0; n < 2; ++n) *(f32x4*)(rowp + bj * 128 + n * 16) = acc[ai][bj][m][n]; }
    }
};
struct EpiResidual { const float* Xin; float* X; const float* gate; const float* colscale; int col_from_e;
    __device__ __forceinline__ void operator()(const pg8::f32x4 (&acc)[2][2][4][2], const pg8::Unit& u, int wr, int wc, int fr, int fq) const {
        const int cbase = (col_from_e ? u.e * 256 : u.pn * 256) + wc * 32 + 4 * fq;
#pragma unroll
        for (int ai = 0; ai < 2; ++ai)
#pragma unroll
            for (int m = 0; m < 4; ++m) { const int row = u.pm * 256 + ai * 128 + wr * 64 + m * 16 + fr; const int b = row >> 12;
#pragma unroll
                for (int bj = 0; bj < 2; ++bj)
#pragma unroll
                    for (int n = 0; n < 2; ++n) { const int col = cbase + bj * 128 + n * 16; const size_t o = (size_t)row * D + col;
                        f32x4 g = *(const f32x4*)(gate + (size_t)b * 3072 + col); if (colscale) { const f32x4 cs = *(const f32x4*)(colscale + col); g = g * cs; }
                        const f32x4 xi = *(const f32x4*)(Xin + o); *(f32x4*)(X + o) = xi + g * acc[ai][bj][m][n]; } }
    }
};
template <class Order> struct EpiGateUp { const Order* S; unsigned char* ws;
    __device__ __forceinline__ void operator()(const pg8::f32x4 (&acc)[2][2][4][2], const pg8::Unit& u, int wr, int wc, int fr, int fq) const {
        const int r0 = S->row0(u); bf16* HB = (bf16*)(ws + (u.e < 64 ? BG_HB : BG_HBSH));
        const float* elw = (const float*)(ws + WS_ELW) + (size_t)(u.e < 64 ? u.e : 0) * ECAP + 256 * u.pm;
#pragma unroll
        for (int ai = 0; ai < 2; ++ai)
#pragma unroll
            for (int m = 0; m < 4; ++m) { const int r = ai * 128 + wr * 64 + m * 16 + fr;
                if (r < u.rows) { const float w = (u.e < 64) ? elw[r] : 1.0f; bf16* rowp = HB + (size_t)(r0 + r) * 256 + u.pn * 128 + wc * 32 + 4 * fq;
#pragma unroll
                    for (int n = 0; n < 2; ++n) { const f32x4 g = acc[ai][0][m][n], up = acc[ai][1][m][n]; f32x4 h;
                        h.x = g.x * sigmoidf_(g.x) * up.x * w; h.y = g.y * sigmoidf_(g.y) * up.y * w; h.z = g.z * sigmoidf_(g.z) * up.z * w; h.w = g.w * sigmoidf_(g.w) * up.w * w;
                        v2u o; o.x = pk2(h.x, h.y); o.y = pk2(h.z, h.w); *(v2u*)(rowp + n * 16) = o; } } }
    }
};
template <class Order, bool SHARED> struct EpiDown { const Order* S; unsigned char* ws; float* X; const float* gate;
    __device__ __forceinline__ void operator()(const pg8::f32x4 (&acc)[2][2][4][2], const pg8::Unit& u, int wr, int wc, int fr, int fq) const {
        const int r0 = S->row0(u); bf16* Y = (bf16*)(ws + BG_Y);
#pragma unroll
        for (int ai = 0; ai < 2; ++ai)
#pragma unroll
            for (int m = 0; m < 4; ++m) { const int r = ai * 128 + wr * 64 + m * 16 + fr;
                if (r < u.rows) {
#pragma unroll
                    for (int bj = 0; bj < 2; ++bj)
#pragma unroll
                        for (int n = 0; n < 2; ++n) { const int col = u.pn * 256 + bj * 128 + wc * 32 + n * 16 + 4 * fq; const f32x4 a = acc[ai][bj][m][n];
                            if constexpr (!SHARED) { v2u o; o.x = pk2(a.x, a.y); o.y = pk2(a.z, a.w); *(v2u*)(Y + (size_t)(r0 + r) * D + col) = o; }
                            else { const int tok = r0 + r; const size_t o = (size_t)tok * D + col; const f32x4 g = *(const f32x4*)(gate + (size_t)(tok >> 12) * 3072 + col);
                                const f32x4 xi = *(const f32x4*)(X + o); *(f32x4*)(X + o) = xi + g * a; } } }
                asm volatile("" ::: "memory"); }
    }
};

__device__ __forceinline__ void phase_postproj(Frame& F, ArgsP AR) {
    const float* PROJ = (const float*)(F.ws + BG_PROJ); const float* ROPE = (const float*)(F.ws + WS_ROPE);
    float* U = (float*)(F.ws + BG_U); bf16* Q = (bf16*)(F.ws + BG_Q); bf16* QI = (bf16*)(F.ws + BG_QI); bf16* Kb = (bf16*)(F.ws + BG_K); bf16* Vb = (bf16*)(F.ws + BG_V); bf16* KIb = (bf16*)(F.ws + BG_KI); float* WI = (float*)(F.ws + BG_WI);
    const float qg = FIN(21)[F.lane], kg = FIN(22)[F.lane];
    const int lane = F.lane;
    for (int t = F.gw; t < T; t += F.NGW) {
        const float* p = PROJ + (size_t)t * INP;
        const float cs = ROPE[(size_t)t * 16 + 2 * (lane & 7)], sn = ROPE[(size_t)t * 16 + 2 * (lane & 7) + 1];
#pragma unroll
        for (int j = 0; j < 8; ++j) U[(size_t)t * 512 + j * 64 + lane] = p[j * 64 + lane];
        auto rope = [&](float y) -> float { const float yp = __shfl_xor(y, 8); float o = y; if (lane < 8) o = y * cs - yp * sn; else if (lane < 16) o = yp * sn + y * cs; return o; };
#pragma unroll
        for (int h = 0; h < 8; ++h) { const float x = p[512 + h * 64 + lane]; const float rstd = rsqrtf(wave_sum(x * x) * (1.0f / 64.0f) + 1e-6f);
            Q[(size_t)t * 512 + h * 64 + lane] = (bf16)f2bf(rope(x * rstd * qg)); }
        { const float x = p[1024 + lane]; const float rstd = rsqrtf(wave_sum(x * x) * (1.0f / 64.0f) + 1e-6f); Kb[(size_t)t * 64 + lane] = (bf16)f2bf(rope(x * rstd * kg)); }
        { const bf16 vv = (bf16)f2bf(p[1088 + lane]); Vb[(size_t)t * 64 + lane] = vv; ((bf16*)(F.ws + BG_VT))[((size_t)(t >> 12) * 64 + lane) * 4096 + (t & 4095)] = vv; }
#pragma unroll
        for (int h = 0; h < 8; ++h) QI[(size_t)t * 512 + h * 64 + lane] = (bf16)f2bf(rope(p[1152 + h * 64 + lane]));
        KIb[(size_t)t * 64 + lane] = (bf16)f2bf(rope(p[1664 + lane]));
        if (lane < 8) WI[(size_t)t * 8 + lane] = p[1728 + lane] * 0.35355339059327373f;
    }
}

__device__ __forceinline__ void phase_s5a(Frame& F, ArgsP AR) {
    const float* S5 = (const float*)(F.ws + WS_S5T); const float* U = (const float*)(F.ws + BG_U); float* SLOC = (float*)(F.ws + BG_SLOC);
    const int p = F.lane;
    for (int it = F.gw; it < 4 * 32 * 64; it += F.NGW) {
        const int c = it & 63, g = (it >> 6) & 31, b = it >> 11;
        const float ar = S5[S5_ABAR + 2 * (g * 64 + p)], ai = S5[S5_ABAR + 2 * (g * 64 + p) + 1];
        float br[16], bi[16];
#pragma unroll
        for (int h = 0; h < 16; ++h) { br[h] = S5[S5_BBR + (g * 64 + p) * 16 + h]; bi[h] = S5[S5_BBI + (g * 64 + p) * 16 + h]; }
        float sr = 0.f, si = 0.f;
        const float* up = U + ((size_t)b * SEQ + c * 64) * 512 + g * 16;
        for (int tau = 0; tau < 64; ++tau) {
            float bur = 0.f, bui = 0.f;
#pragma unroll
            for (int h = 0; h < 16; ++h) { const float u = up[(size_t)tau * 512 + h]; bur += br[h] * u; bui += bi[h] * u; }
            const float nr = ar * sr - ai * si + bur, ni = ar * si + ai * sr + bui; sr = nr; si = ni;
        }
        SLOC[((size_t)it * 64 + p) * 2] = sr; SLOC[((size_t)it * 64 + p) * 2 + 1] = si;
    }
}
__device__ __forceinline__ void phase_s5b(Frame& F, ArgsP AR) {
    const float* S5 = (const float*)(F.ws + WS_S5T); const float* SLOC = (const float*)(F.ws + BG_SLOC); float* SIN = (float*)(F.ws + BG_SIN);
    const int gid = F.bid * 512 + F.tid;
    for (int i = gid; i < 4 * 32 * 64; i += F.G * 512) {
        const int p = i & 63, g = (i >> 6) & 31, b = i >> 11;
        const float ar = S5[S5_A64 + 2 * (g * 64 + p)], ai = S5[S5_A64 + 2 * (g * 64 + p) + 1];
        float sr = 0.f, si = 0.f;
        for (int c = 0; c < 64; ++c) {
            const size_t o = ((((size_t)b * 32 + g) * 64 + c) * 64 + p) * 2;
            SIN[o] = sr; SIN[o + 1] = si;
            const float lr = SLOC[o], li = SLOC[o + 1];
            const float nr = ar * sr - ai * si + lr, ni = ar * si + ai * sr + li; sr = nr; si = ni;
        }
    }
}
__device__ __forceinline__ void phase_s5c(Frame& F, ArgsP AR) {
    const float* S5 = (const float*)(F.ws + WS_S5T); const float* U = (const float*)(F.ws + BG_U); const float* SIN = (const float*)(F.ws + BG_SIN); bf16* MIX = (bf16*)(F.ws + BG_MIX);
    const float* cre = FIN(16); const float* cim = FIN(17); const float* dsk = FIN(18); const float* gluw = FIN(19); const float* glub = FIN(20);
    LAS float* st = (LAS float*)(F.lds + F.wave * 10240);
    LAS float* yg = st + 2048;
    const int p = F.lane, h = F.lane & 15, tq = F.lane >> 4;
    for (int it = F.gw; it < 4 * 32 * 64; it += F.NGW) {
        const int c = it & 63, g = (it >> 6) & 31, b = it >> 11;
        const float ar = S5[S5_ABAR + 2 * (g * 64 + p)], ai = S5[S5_ABAR + 2 * (g * 64 + p) + 1];
        float br[16], bi[16];
#pragma unroll
        for (int hh = 0; hh < 16; ++hh) { br[hh] = S5[S5_BBR + (g * 64 + p) * 16 + hh]; bi[hh] = S5[S5_BBI + (g * 64 + p) * 16 + hh]; }
        float sr = SIN[((size_t)it * 64 + p) * 2], si = SIN[((size_t)it * 64 + p) * 2 + 1];
        const size_t trow0 = (size_t)b * SEQ + c * 64;
        const float dd = dsk[g * 16 + h], gb = glub[g * 16 + h];
        for (int sub = 0; sub < 4; ++sub) {
            const float* up = U + (trow0 + sub * 16) * 512 + g * 16;
            for (int tau = 0; tau < 16; ++tau) {
                float bur = 0.f, bui = 0.f;
#pragma unroll
                for (int hh = 0; hh < 16; ++hh) { const float u = up[(size_t)tau * 512 + hh]; bur += br[hh] * u; bui += bi[hh] * u; }
                const float nr = ar * sr - ai * si + bur, ni = ar * si + ai * sr + bui; sr = nr; si = ni;
                st[(tau * 64 + p) * 2] = sr; st[(tau * 64 + p) * 2 + 1] = si;
            }
            LDS_WAIT();
            float y[4];
#pragma unroll
            for (int j = 0; j < 4; ++j) { const int tau = tq + 4 * j; float a = 0.f;
                for (int pp = 0; pp < 64; ++pp) a += cre[(g * 16 + h) * 64 + pp] * st[(tau * 64 + pp) * 2] - cim[(g * 16 + h) * 64 + pp] * st[(tau * 64 + pp) * 2 + 1];
                a += dd * up[(size_t)tau * 512 + h];
                const float ge = 0.5f * a * (1.0f + tanhf(0.7978845608028654f * (a + 0.044715f * a * a * a)));
                y[j] = ge; yg[tau * 16 + h] = ge; }
            LDS_WAIT();
#pragma unroll
            for (int j = 0; j < 4; ++j) { const int tau = tq + 4 * j; float z = gb;
#pragma unroll
                for (int hh = 0; hh < 16; ++hh) z += yg[tau * 16 + hh] * gluw[(g * 16 + hh) * 16 + h];
                MIX[(trow0 + sub * 16 + tau) * D + g * 16 + h] = (bf16)f2bf(y[j] * sigmoidf_(z)); }
            LDS_WAIT();
        }
    }
}

__device__ __forceinline__ unsigned fkey(float f) { const unsigned u = __builtin_bit_cast(unsigned, f); return (u & 0x80000000u) ? ~u : (u | 0x80000000u); }
__device__ __forceinline__ void phase_dsa(Frame& F, ArgsP AR) {
    const bf16* Q = (const bf16*)(F.ws + BG_Q); const bf16* QI = (const bf16*)(F.ws + BG_QI); const bf16* Kb = (const bf16*)(F.ws + BG_K); const bf16* Vb = (const bf16*)(F.ws + BG_V);
    const bf16* KIb = (const bf16*)(F.ws + BG_KI); const float* WI = (const float*)(F.ws + BG_WI); bf16* MIX = (bf16*)(F.ws + BG_MIX);
    LAS unsigned char* wl = F.lds + F.wave * 19456;
    LAS float* sc = (LAS float*)wl;
    LAS float* qf = (LAS float*)(wl + 16384);
    LAS int* list = (LAS int*)(wl + 16384 + 2048);
    const int lane = F.lane;
#pragma unroll 1
    for (int it = F.bid; it < T / 8; it += F.G) {
        const int t = (T / 8 - 1 - it) * 8 + F.wave;
        const int b = t >> 12, tp = t & 4095, n = tp + 1;
        const size_t kb0 = (size_t)b * SEQ;
#pragma unroll
        for (int j = 0; j < 8; ++j) qf[j * 64 + lane] = bf2f(QI[(size_t)t * 512 + j * 64 + lane]);
        float wv[8];
#pragma unroll
        for (int h = 0; h < 8; ++h) wv[h] = WI[(size_t)t * 8 + h];
        LDS_WAIT();
#pragma unroll 1
        for (int s0 = 0; s0 < n; s0 += 64) {
            asm volatile("" ::: "memory");
            const int s = s0 + lane;
            float score = -INFINITY;
            if (s < n) {
                const v4u* kp = (const v4u*)(KIb + (kb0 + s) * 64);
                float dh[8];
#pragma unroll
                for (int h = 0; h < 8; ++h) dh[h] = 0.f;
#pragma unroll 1
                for (int half = 0; half < 2; ++half) {
                    asm volatile("" ::: "memory");
                    float kf[32];
#pragma unroll
                    for (int i = 0; i < 4; ++i) { const v4u w = kp[half * 4 + i]; kf[8 * i] = bflo(w.x); kf[8 * i + 1] = bfhi(w.x); kf[8 * i + 2] = bflo(w.y); kf[8 * i + 3] = bfhi(w.y); kf[8 * i + 4] = bflo(w.z); kf[8 * i + 5] = bfhi(w.z); kf[8 * i + 6] = bflo(w.w); kf[8 * i + 7] = bfhi(w.w); }
#pragma unroll
                    for (int h = 0; h < 8; ++h) { float d = 0.f;
#pragma unroll
                        for (int i = 0; i < 8; ++i) { const f32x4 qv = *(const LAS f32x4*)(qf + h * 64 + half * 32 + 4 * i); d += qv.x * kf[4 * i] + qv.y * kf[4 * i + 1] + qv.z * kf[4 * i + 2] + qv.w * kf[4 * i + 3]; }
                        dh[h] += d; __builtin_amdgcn_sched_barrier(0); }
                }
                float a = 0.f;
#pragma unroll
                for (int h = 0; h < 8; ++h) a += wv[h] * fmaxf(dh[h] * 0.125f, 0.f);
                score = a;
            }
            sc[s] = score;
        }
        LDS_WAIT();
        int nsel;
        if (n <= 256) { for (int i = lane; i < n; i += 64) list[i] = i; nsel = n; }
        else {
            const int nch = (n + 63) >> 6;
            unsigned thr = 0u;
#pragma unroll 1
            for (int bit = 31; bit >= 0; --bit) {
                const unsigned cand = thr | (1u << bit); int cnt = 0;
#pragma unroll 1
                for (int j = 0; j < nch; ++j) { const int s = j * 64 + lane; if (s < n) cnt += (fkey(sc[s]) >= cand) ? 1 : 0; }
                cnt = wave_sum_i(cnt);
                if (cnt >= 256) thr = cand;
            }
            int cgt = 0;
            for (int j = 0; j < nch; ++j) { const int s = j * 64 + lane; if (s < n) cgt += (fkey(sc[s]) > thr) ? 1 : 0; }
            cgt = wave_sum_i(cgt);
            const int need_eq = 256 - cgt;
            int run = 0, eqrun = 0;
            const unsigned long long lt = (lane == 0) ? 0ull : (~0ull >> (64 - lane));
            for (int j = 0; j < nch; ++j) {
                const int s = j * 64 + lane; const bool in = s < n; const unsigned k = in ? fkey(sc[s]) : 0u;
                const bool gt = in && k > thr, eq = in && k == thr;
                const unsigned long long beq = __ballot(eq);
                const int myeq = eqrun + __popcll(beq & lt);
                const bool sel = gt || (eq && myeq < need_eq);
                const unsigned long long bs = __ballot(sel);
                if (sel) list[run + __popcll(bs & lt)] = s;
                run += __popcll(bs); eqrun += __popcll(beq);
            }
            nsel = run;
        }
        LDS_WAIT();
#pragma unroll
        for (int j = 0; j < 8; ++j) qf[j * 64 + lane] = bf2f(Q[(size_t)t * 512 + j * 64 + lane]);
        LDS_WAIT();
        float mx[8];
#pragma unroll
        for (int h = 0; h < 8; ++h) mx[h] = -INFINITY;
#pragma unroll 1
        for (int i0 = 0; i0 < nsel; i0 += 64) {
            asm volatile("" ::: "memory");
            const int i = i0 + lane;
            if (i < nsel) {
                const int s = list[i];
                const v4u* kp = (const v4u*)(Kb + (kb0 + s) * 64);
                float dh[8];
#pragma unroll
                for (int h = 0; h < 8; ++h) dh[h] = 0.f;
#pragma unroll 1
                for (int half = 0; half < 2; ++half) {
                    asm volatile("" ::: "memory");
                    float kf[32];
#pragma unroll
                    for (int q = 0; q < 4; ++q) { const v4u w = kp[half * 4 + q]; kf[8 * q] = bflo(w.x); kf[8 * q + 1] = bfhi(w.x); kf[8 * q + 2] = bflo(w.y); kf[8 * q + 3] = bfhi(w.y); kf[8 * q + 4] = bflo(w.z); kf[8 * q + 5] = bfhi(w.z); kf[8 * q + 6] = bflo(w.w); kf[8 * q + 7] = bfhi(w.w); }
#pragma unroll
                    for (int h = 0; h < 8; ++h) { float d = 0.f;
#pragma unroll
                        for (int q = 0; q < 8; ++q) { const f32x4 qv = *(const LAS f32x4*)(qf + h * 64 + half * 32 + 4 * q); d += qv.x * kf[4 * q] + qv.y * kf[4 * q + 1] + qv.z * kf[4 * q + 2] + qv.w * kf[4 * q + 3]; }
                        dh[h] += d; __builtin_amdgcn_sched_barrier(0); }
                }
#pragma unroll
                for (int h = 0; h < 8; ++h) { const float d = dh[h] * 0.125f; sc[i * 8 + h] = d; mx[h] = fmaxf(mx[h], d); }
            }
        }
        float lsum[8];
#pragma unroll
        for (int h = 0; h < 8; ++h) { mx[h] = wave_max(mx[h]); lsum[h] = 0.f; }
        LDS_WAIT();
        for (int i0 = 0; i0 < nsel; i0 += 64) {
            const int i = i0 + lane;
            if (i < nsel) {
#pragma unroll
                for (int h = 0; h < 8; ++h) { const float pv = __expf(sc[i * 8 + h] - mx[h]); sc[i * 8 + h] = pv; lsum[h] += pv; }
            }
        }
#pragma unroll
        for (int h = 0; h < 8; ++h) lsum[h] = wave_sum(lsum[h]);
        LDS_WAIT();
        float o[8];
#pragma unroll
        for (int h = 0; h < 8; ++h) o[h] = 0.f;
#pragma unroll 2
        for (int i = 0; i < nsel; ++i) {
            const int s = list[i];
            const float v = bf2f(Vb[(kb0 + s) * 64 + lane]);
            const f32x4 p0 = *(const LAS f32x4*)(sc + i * 8), p1 = *(const LAS f32x4*)(sc + i * 8 + 4);
            o[0] += p0.x * v; o[1] += p0.y * v; o[2] += p0.z * v; o[3] += p0.w * v; o[4] += p1.x * v; o[5] += p1.y * v; o[6] += p1.z * v; o[7] += p1.w * v;
        }
#pragma unroll
        for (int h = 0; h < 8; ++h) MIX[(size_t)t * D + 512 + h * 64 + lane] = (bf16)f2bf(o[h] / lsum[h]);
        LDS_WAIT();
    }
}


typedef float f32x16 __attribute__((ext_vector_type(16)));
constexpr int DS_SC = 0;
constexpr int DS_BM = 131072;
constexpr int DS_WT = DS_BM + 8192;
constexpr int DS_MRG = 32768;
__device__ __forceinline__ float xor32f(float v) { return __shfl_xor(v, 32); }
__device__ __forceinline__ void phase_dsa2(Frame& F, ArgsP AR) {
    const bf16* Q = (const bf16*)(F.ws + BG_Q); const bf16* QI = (const bf16*)(F.ws + BG_QI); const bf16* Kb = (const bf16*)(F.ws + BG_K); const bf16* VT = (const bf16*)(F.ws + BG_VT);
    const bf16* KIb = (const bf16*)(F.ws + BG_KI); const float* WI = (const float*)(F.ws + BG_WI); bf16* MIX = (bf16*)(F.ws + BG_MIX);
    LAS unsigned short* SC = (LAS unsigned short*)(F.lds + DS_SC);
    LAS unsigned char* BM = F.lds + DS_BM;
    LAS float* WT = (LAS float*)(F.lds + DS_WT);
    const int lane = F.lane, w = F.wave, tid = F.tid;
    const int r32 = lane & 31, h = lane >> 5;
    const int nunits = T / 16;
#pragma unroll 1
    for (int i = 0; ; ++i) {
        int j = i * F.G + ((i & 1) ? (F.G - 1 - F.bid) : F.bid);
        if (i * F.G >= nunits) break;
        if (j >= nunits) continue;
        const int b = j & 3, qt = j >> 2;
        const int tp0 = qt * 16, t0 = b * SEQ + tp0;
        const int n_keys = tp0 + 16;
        const int nkt = (n_keys + 31) >> 5, n_comp = nkt * 32, nst = (n_keys + 63) >> 6;
        const size_t kb0 = (size_t)b * SEQ;
        if (tid < 128) WT[tid] = WI[(size_t)t0 * 8 + tid] * 0.125f;
        {
            bf16x8 af[4][4];
#pragma unroll
            for (int rb = 0; rb < 4; ++rb)
#pragma unroll
                for (int ks = 0; ks < 4; ++ks) af[rb][ks] = *(const bf16x8*)(QI + ((size_t)t0 * 8 + rb * 32 + r32) * 64 + ks * 16 + h * 8);
            __syncthreads();
#pragma unroll 1
            for (int kt = w; kt < nkt; kt += 8) {
                const bf16* kp = KIb + (kb0 + kt * 32 + r32) * 64 + h * 8;
                bf16x8 bfr[4];
#pragma unroll
                for (int ks = 0; ks < 4; ++ks) bfr[ks] = *(const bf16x8*)(kp + ks * 16);
                const int s = kt * 32 + r32;
#pragma unroll
                for (int rb = 0; rb < 4; ++rb) {
                    f32x16 acc = {0.f, 0.f, 0.f, 0.f, 0.f, 0.f, 0.f, 0.f, 0.f, 0.f, 0.f, 0.f, 0.f, 0.f, 0.f, 0.f};
#pragma unroll
                    for (int ks = 0; ks < 4; ++ks) acc = __builtin_amdgcn_mfma_f32_32x32x16_bf16(af[rb][ks], bfr[ks], acc, 0, 0, 0);
#pragma unroll
                    for (int tl = 0; tl < 4; ++tl) {
                        const f32x4 wv = *(const LAS f32x4*)(WT + (4 * rb + tl) * 8 + 4 * h);
                        float part = wv.x * fmaxf(acc[4 * tl], 0.f) + wv.y * fmaxf(acc[4 * tl + 1], 0.f) + wv.z * fmaxf(acc[4 * tl + 2], 0.f) + wv.w * fmaxf(acc[4 * tl + 3], 0.f);
                        part += xor32f(part);
                        const int tk = 4 * rb + tl;
                        const _Float16 hf = (_Float16)part; const unsigned hb = (unsigned)__builtin_bit_cast(unsigned short, hf);
                        const unsigned key = (hb & 0x8000u) ? (~hb & 0xffffu) : (hb | 0x8000u);
                        if ((tl & 1) == h) SC[tk * 4096 + s] = (unsigned short)((s <= tp0 + tk) ? key : 0u);
                    }
                }
            }
        }
        __syncthreads();
        {
            const int nch = (n_comp + 511) >> 9;
#pragma unroll 1
            for (int q = 0; q < 2; ++q) {
                const int tk = 2 * w + q; const int n = tp0 + tk + 1;
                const LAS v4u* row = (const LAS v4u*)(SC + tk * 4096);
                unsigned thr = 0u; int cut = -1;
                if (n > 256) {
#pragma unroll 1
                    for (int bit = 15; bit >= 0; --bit) {
                        const unsigned cand = thr | (1u << bit); int cnt = 0;
#pragma unroll 1
                        for (int ch = 0; ch < nch; ++ch) {
                            v4u x = (v4u){0u, 0u, 0u, 0u}; if (ch * 512 + lane * 8 < n_comp) x = row[ch * 64 + lane];
                            cnt += __popcll(__ballot((x.x & 0xffffu) >= cand)) + __popcll(__ballot((x.x >> 16) >= cand)) + __popcll(__ballot((x.y & 0xffffu) >= cand)) + __popcll(__ballot((x.y >> 16) >= cand))
                                 + __popcll(__ballot((x.z & 0xffffu) >= cand)) + __popcll(__ballot((x.z >> 16) >= cand)) + __popcll(__ballot((x.w & 0xffffu) >= cand)) + __popcll(__ballot((x.w >> 16) >= cand));
                        }
                        if (cnt >= 256) thr = cand;
                    }
                    int cgt = 0, ceq = 0;
#pragma unroll 1
                    for (int ch = 0; ch < nch; ++ch) {
                        v4u x = (v4u){0u, 0u, 0u, 0u}; if (ch * 512 + lane * 8 < n_comp) x = row[ch * 64 + lane];
                        const unsigned e[8] = {x.x & 0xffffu, x.x >> 16, x.y & 0xffffu, x.y >> 16, x.z & 0xffffu, x.z >> 16, x.w & 0xffffu, x.w >> 16};
#pragma unroll
                        for (int k = 0; k < 8; ++k) { cgt += __popcll(__ballot(e[k] > thr)); ceq += __popcll(__ballot(e[k] == thr)); }
                    }
                    const int need = 256 - cgt;
                    if (ceq == need) cut = 4096;
                    else {
                        int lo_ = 0, hi_ = 4095;
#pragma unroll 1
                        while (lo_ < hi_) {
                            const int mid = (lo_ + hi_) >> 1; int c = 0;
#pragma unroll 1
                            for (int ch = 0; ch < nch; ++ch) {
                                v4u x = (v4u){0u, 0u, 0u, 0u}; const int i0 = ch * 512 + lane * 8; if (i0 < n_comp) x = row[ch * 64 + lane];
                                const unsigned e[8] = {x.x & 0xffffu, x.x >> 16, x.y & 0xffffu, x.y >> 16, x.z & 0xffffu, x.z >> 16, x.w & 0xffffu, x.w >> 16};
#pragma unroll
                                for (int k = 0; k < 8; ++k) c += __popcll(__ballot(e[k] == thr && (i0 + k) <= mid));
                            }
                            if (c >= need) hi_ = mid; else lo_ = mid + 1;
                        }
                        cut = lo_;
                    }
                }
#pragma unroll 1
                for (int ch = 0; ch < nch; ++ch) {
                    v4u x = (v4u){0u, 0u, 0u, 0u}; const int i0 = ch * 512 + lane * 8; if (i0 < n_comp) x = row[ch * 64 + lane];
                    const unsigned e[8] = {x.x & 0xffffu, x.x >> 16, x.y & 0xffffu, x.y >> 16, x.z & 0xffffu, x.z >> 16, x.w & 0xffffu, x.w >> 16};
                    unsigned byte = 0u;
#pragma unroll
                    for (int k = 0; k < 8; ++k) byte |= ((e[k] > thr) || (e[k] == thr && (i0 + k) <= cut)) ? (1u << k) : 0u;
                    BM[tk * 512 + ch * 64 + lane] = (unsigned char)byte;
                }
            }
        }
        __syncthreads();
        {
            const int rb = w & 3, kh = w >> 2;
            const int tk = 4 * rb + (r32 >> 3);
            bf16x8 qf[4];
#pragma unroll
            for (int ks = 0; ks < 4; ++ks) qf[ks] = *(const bf16x8*)(Q + ((size_t)t0 * 8 + rb * 32 + r32) * 64 + ks * 16 + h * 8);
            f32x16 O0 = {0.f, 0.f, 0.f, 0.f, 0.f, 0.f, 0.f, 0.f, 0.f, 0.f, 0.f, 0.f, 0.f, 0.f, 0.f, 0.f}, O1 = O0;
            float m = -1e30f, l = 0.f;
            const int skey = tid >> 3, sch = tid & 7;
            const bf16* ksrc = Kb + (kb0 + skey) * 64 + sch * 8;
            const bf16* vsrc = VT + ((size_t)b * 64 + skey) * 4096 + sch * 8;
            const int kdst = skey * 128 + ((sch ^ ((skey >> 1) & 7)) << 4);
            const int vf = (skey >> 1) & 15;
            const int vdst0 = skey * 128 + (((2 * sch) ^ vf) << 3), vdst1 = skey * 128 + (((2 * sch + 1) ^ vf) << 3);
            v4u kreg = *(const v4u*)(ksrc), vreg = *(const v4u*)(vsrc);
            { LAS unsigned char* kb_ = F.lds; LAS unsigned char* vb_ = F.lds + 8192;
              *(LAS v4u*)(kb_ + kdst) = kreg; *(LAS v2u*)(vb_ + vdst0) = (v2u){vreg.x, vreg.y}; *(LAS v2u*)(vb_ + vdst1) = (v2u){vreg.z, vreg.w}; }
            __syncthreads();
            const int krow = kh * 32 + r32;
            const int kswz = (krow >> 1) & 7;
            const int vfl0 = ((r32) >> 1) & 15, vfl1 = ((32 + r32) >> 1) & 15;
            constexpr float C2 = 0.125f * 1.4426950408889634f;
#pragma unroll 1
            for (int st = 0; st < nst; ++st) {
                const int cur = (st & 1) * 16384;
                if (st + 1 < nst) { kreg = *(const v4u*)(ksrc + (size_t)(st + 1) * 64 * 64); vreg = *(const v4u*)(vsrc + (st + 1) * 64); }
                const LAS unsigned char* kt_ = F.lds + cur; const LAS unsigned char* vt_ = F.lds + cur + 8192;
                f32x16 sv = {0.f, 0.f, 0.f, 0.f, 0.f, 0.f, 0.f, 0.f, 0.f, 0.f, 0.f, 0.f, 0.f, 0.f, 0.f, 0.f};
#pragma unroll
                for (int ks = 0; ks < 4; ++ks) { const bf16x8 ka = *(const LAS bf16x8*)(kt_ + krow * 128 + (((2 * ks + h) ^ kswz) << 4)); sv = __builtin_amdgcn_mfma_f32_32x32x16_bf16(ka, qf[ks], sv, 0, 0, 0); }
                const unsigned mw = *(const LAS unsigned*)(BM + tk * 512 + (2 * st + kh) * 4) >> (4 * h);
                float mt = -INFINITY;
#pragma unroll
                for (int r = 0; r < 16; ++r) { const int kl = (r & 3) + 8 * (r >> 2); sv[r] = ((mw >> kl) & 1u) ? sv[r] * C2 : -INFINITY; mt = fmaxf(mt, sv[r]); }
                mt = fmaxf(mt, xor32f(mt));
                const float mn = fmaxf(m, mt); const float alpha = __builtin_amdgcn_exp2f(m - mn); m = mn;
                float ls = 0.f;
#pragma unroll
                for (int r = 0; r < 16; ++r) { sv[r] = __builtin_amdgcn_exp2f(sv[r] - mn); ls += sv[r]; }
                l = l * alpha + ls;
#pragma unroll
                for (int r = 0; r < 16; ++r) { O0[r] *= alpha; O1[r] *= alpha; }
                bf16x8 pb[2];
#pragma unroll
                for (int s2 = 0; s2 < 2; ++s2) { v4u pk; pk.x = pk2(sv[8 * s2], sv[8 * s2 + 1]); pk.y = pk2(sv[8 * s2 + 2], sv[8 * s2 + 3]); pk.z = pk2(sv[8 * s2 + 4], sv[8 * s2 + 5]); pk.w = pk2(sv[8 * s2 + 6], sv[8 * s2 + 7]); pb[s2] = __builtin_bit_cast(bf16x8, pk); }
#pragma unroll
                for (int s2 = 0; s2 < 2; ++s2) {
                    const int c8 = 8 * kh + 4 * s2 + h;
                    { const v2u a0 = *(const LAS v2u*)(vt_ + r32 * 128 + ((c8 ^ vfl0) << 3)), a1 = *(const LAS v2u*)(vt_ + r32 * 128 + (((c8 + 2) ^ vfl0) << 3));
                      const v4u av = (v4u){a0.x, a0.y, a1.x, a1.y}; O0 = __builtin_amdgcn_mfma_f32_32x32x16_bf16(__builtin_bit_cast(bf16x8, av), pb[s2], O0, 0, 0, 0); }
                    { const v2u a0 = *(const LAS v2u*)(vt_ + (32 + r32) * 128 + ((c8 ^ vfl1) << 3)), a1 = *(const LAS v2u*)(vt_ + (32 + r32) * 128 + (((c8 + 2) ^ vfl1) << 3));
                      const v4u av = (v4u){a0.x, a0.y, a1.x, a1.y}; O1 = __builtin_amdgcn_mfma_f32_32x32x16_bf16(__builtin_bit_cast(bf16x8, av), pb[s2], O1, 0, 0, 0); }
                }
                if (st + 1 < nst) { LAS unsigned char* kb_ = F.lds + (cur ^ 16384); LAS unsigned char* vb_ = kb_ + 8192;
                    *(LAS v4u*)(kb_ + kdst) = kreg; *(LAS v2u*)(vb_ + vdst0) = (v2u){vreg.x, vreg.y}; *(LAS v2u*)(vb_ + vdst1) = (v2u){vreg.z, vreg.w}; }
                __syncthreads();
            }
            l += xor32f(l);
            LAS float* mg = (LAS float*)(F.lds + DS_MRG + rb * 8704);
            if (kh == 1) {
#pragma unroll
                for (int r = 0; r < 16; ++r) { mg[r * 64 + lane] = O0[r]; mg[(16 + r) * 64 + lane] = O1[r]; }
                if (h == 0) { mg[2048 + r32] = m; mg[2048 + 32 + r32] = l; }
            }
            __syncthreads();
            if (kh == 0) {
                const float m1 = mg[2048 + r32], l1 = mg[2048 + 32 + r32];
                const float mf = fmaxf(m, m1); const float a0 = __builtin_amdgcn_exp2f(m - mf), a1 = __builtin_amdgcn_exp2f(m1 - mf);
                const float inv = 1.0f / (l * a0 + l1 * a1);
                bf16* orow = MIX + (size_t)(t0 + tk) * D + 512 + (r32 & 7) * 64;
#pragma unroll
                for (int g4 = 0; g4 < 4; ++g4) {
                    float o0[4], o1[4];
#pragma unroll
                    for (int k = 0; k < 4; ++k) { const int r = 4 * g4 + k; o0[k] = (O0[r] * a0 + mg[r * 64 + lane] * a1) * inv; o1[k] = (O1[r] * a0 + mg[(16 + r) * 64 + lane] * a1) * inv; }
                    v2u s0; s0.x = pk2(o0[0], o0[1]); s0.y = pk2(o0[2], o0[3]); *(v2u*)(orow + 8 * g4 + 4 * h) = s0;
                    v2u s1; s1.x = pk2(o1[0], o1[1]); s1.y = pk2(o1[2], o1[3]); *(v2u*)(orow + 32 + 8 * g4 + 4 * h) = s1;
                }
            }
            __syncthreads();
        }
    }
}

__device__ __forceinline__ void phase_router(Frame& F, ArgsP AR, int l) {
    const float* X = F.out; const float* gamma = FIN(6) + (size_t)l * D; const int m = 2 * l + 1;
    const float* MOD = (const float*)(F.ws + WS_MOD); const float* RW = FIN(25) + (size_t)l * D * 64; const float* RB = FIN(26) + (size_t)l * 64;
    bf16* Hout = (bf16*)(F.ws + WS_H); unsigned* ctl = (unsigned*)(F.ws + WS_CTL);
    int* EIDX = (int*)(F.ws + WS_EIDX); int* SLOT = (int*)(F.ws + WS_SLOT); int* ELT = (int*)(F.ws + WS_ELT); float* ELW = (float*)(F.ws + WS_ELW);
    LAS float* hrow = (LAS float*)(F.lds + F.wave * 4096);
    const int lane = F.lane;
    const float rb = RB[lane];
    for (int row = F.gw; row < T; row += F.NGW) {
        const int b = row >> 12;
        const float* shift = MOD + (size_t)(m * 4 + b) * 3072; const float* scale = shift + 1024;
        const f32x4* xr = (const f32x4*)(X + (size_t)row * D) + lane;
        f32x4 v[4]; float ss = 0.f;
#pragma unroll
        for (int j = 0; j < 4; ++j) { v[j] = xr[64 * j]; ss += v[j].x * v[j].x + v[j].y * v[j].y + v[j].z * v[j].z + v[j].w * v[j].w; }
        const float rstd = rsqrtf(wave_sum(ss) * (1.0f / D) + 1e-6f);
#pragma unroll
        for (int j = 0; j < 4; ++j) {
            const int c0 = 4 * lane + 256 * j;
            const f32x4 gg = *(const f32x4*)(gamma + c0), sc = *(const f32x4*)(scale + c0), sh = *(const f32x4*)(shift + c0);
            f32x4 h; h.x = v[j].x * rstd * gg.x * (1.f + sc.x) + sh.x; h.y = v[j].y * rstd * gg.y * (1.f + sc.y) + sh.y;
            h.z = v[j].z * rstd * gg.z * (1.f + sc.z) + sh.z; h.w = v[j].w * rstd * gg.w * (1.f + sc.w) + sh.w;
            v2u o; o.x = pk2(h.x, h.y); o.y = pk2(h.z, h.w); *(v2u*)(Hout + (size_t)row * D + c0) = o;
            *(LAS f32x4*)(hrow + c0) = h;
        }
        LDS_WAIT();
        float a0 = 0.f, a1 = 0.f, a2 = 0.f, a3 = 0.f;
#pragma unroll 4
        for (int k = 0; k < 1024; k += 4) { const f32x4 hv = *(const LAS f32x4*)(hrow + k);
            a0 += hv.x * RW[(size_t)k * 64 + lane]; a1 += hv.y * RW[(size_t)(k + 1) * 64 + lane]; a2 += hv.z * RW[(size_t)(k + 2) * 64 + lane]; a3 += hv.w * RW[(size_t)(k + 3) * 64 + lane]; }
        const float score = sigmoidf_((a0 + a1) + (a2 + a3));
        const float sel = score + rb;
        float m1 = sel; m1 = fmaxf(m1, __shfl_xor(m1, 1)); m1 = fmaxf(m1, __shfl_xor(m1, 2)); m1 = fmaxf(m1, __shfl_xor(m1, 4));
        const unsigned long long bm = __ballot(sel == m1);
        const int g = lane >> 3; const unsigned gm = (unsigned)((bm >> (8 * g)) & 0xffull); const int first = 8 * g + __builtin_ctz(gm);
        float m2 = (lane == first) ? -INFINITY : sel; m2 = fmaxf(m2, __shfl_xor(m2, 1)); m2 = fmaxf(m2, __shfl_xor(m2, 2)); m2 = fmaxf(m2, __shfl_xor(m2, 4));
        const float gs = m1 + m2;
        int grank = 0;
#pragma unroll
        for (int gg = 0; gg < 8; ++gg) { const float o = __shfl(gs, gg * 8); grank += (o > gs || (o == gs && gg < g)) ? 1 : 0; }
        const float masked = (grank < 4) ? sel : -INFINITY;
        int rank = 0;
        for (int e = 0; e < 64; ++e) { const float o = __shfl(masked, e); rank += (o > masked || (o == masked && e < lane)) ? 1 : 0; }
        const bool chosen = rank < 8;
        const float wsum = wave_sum(chosen ? score : 0.f);
        if (chosen) {
            const float gwt = score / wsum * 2.5f;
            const unsigned pos = atomicAdd(&ctl[CW_CNT + l * 64 + lane], 1u);
            ELT[(size_t)lane * ECAP + pos] = row; ELW[(size_t)lane * ECAP + pos] = gwt;
            EIDX[(size_t)row * 8 + rank] = lane; SLOT[(size_t)row * 8 + rank] = (int)pos;
        }
        LDS_WAIT();
    }
}
__device__ __forceinline__ void phase_offsets(Frame& F, int l) {
    if (F.bid == 0 && F.tid == 0) {
        unsigned* ctl = (unsigned*)(F.ws + WS_CTL);
        unsigned run = 0, nt = 0;
        for (int e = 0; e < 64; ++e) { const unsigned c = ctl[CW_CNT + l * 64 + e]; ctl[CW_EST + l * 128 + e] = run; run += c;
            const unsigned ntl = (c + 255u) / 256u; for (unsigned j = 0; j < ntl; ++j) { ctl[CW_TE + l * 1024 + nt] = (unsigned)e; ctl[CW_TJ + l * 1024 + nt] = j; ++nt; } }
        ctl[CW_EST + l * 128 + 64] = run; ctl[CW_NT + l] = nt;
    }
}
__device__ __forceinline__ void phase_combine(Frame& F, int l) {
    const unsigned* ctl = (const unsigned*)(F.ws + WS_CTL); const int* EIDX = (const int*)(F.ws + WS_EIDX); const int* SLOT = (const int*)(F.ws + WS_SLOT);
    const bf16* Y = (const bf16*)(F.ws + BG_Y); const float* gate = (const float*)(F.ws + WS_MOD) + (size_t)((2 * l + 1) * 4) * 3072 + 2048; float* X = F.out;
    for (int row = F.gw; row < T; row += F.NGW) {
        const int b = row >> 12;
        f32x4 a[4];
#pragma unroll
        for (int j = 0; j < 4; ++j) a[j] = (f32x4){0.f, 0.f, 0.f, 0.f};
        for (int k = 0; k < 8; ++k) {
            const int e = EIDX[(size_t)row * 8 + k], pos = SLOT[(size_t)row * 8 + k];
            const size_t r = (size_t)ctl[CW_EST + l * 128 + e] + pos;
            const v2u* yp = (const v2u*)(Y + r * D) + F.lane;
#pragma unroll
            for (int j = 0; j < 4; ++j) { const v2u w = yp[64 * j]; a[j].x += bflo(w.x); a[j].y += bfhi(w.x); a[j].z += bflo(w.y); a[j].w += bfhi(w.y); }
        }
#pragma unroll
        for (int j = 0; j < 4; ++j) { const int c0 = 4 * F.lane + 256 * j; const f32x4 g = *(const f32x4*)(gate + (size_t)b * 3072 + c0);
            f32x4* xp = (f32x4*)(X + (size_t)row * D + c0); *xp = *xp + g * a[j]; }
    }
}
__device__ __forceinline__ void phase_pool(Frame& F) {
    const float* Hf = (const float*)(F.ws + BG_H2F); bf16* P = (bf16*)(F.ws + WS_H);
    for (int row = F.gw; row < T; row += F.NGW) {
        const int tp = row & 4095;
#pragma unroll
        for (int j = 0; j < 4; ++j) {
            const int win = 2 << j, c0 = 4 * F.lane + 256 * j;
            const int lo = (tp - win + 1) > 0 ? (tp - win + 1) : 0; const int cnt = tp - lo + 1;
            f32x4 s = (f32x4){0.f, 0.f, 0.f, 0.f};
            for (int q = 0; q < cnt; ++q) s = s + *(const f32x4*)(Hf + (size_t)(row - q) * D + c0);
            const f32x4 h = *(const f32x4*)(Hf + (size_t)row * D + c0);
            const float inv = 1.0f / (float)cnt;
            v2u o; o.x = pk2(s.x * inv - h.x, s.y * inv - h.y); o.y = pk2(s.z * inv - h.z, s.w * inv - h.w);
            *(v2u*)(P + (size_t)row * D + c0) = o;
        }
    }
}

constexpr int NPHASE = 29;
__global__ void __launch_bounds__(512, 2) mega(Args args_formal) {
    ArgsP const ap0 = (ArgsP)__builtin_amdgcn_kernarg_segment_ptr();
    extern __shared__ __attribute__((aligned(16))) unsigned char lds_raw[];
    Frame F;
    F.lds = (LAS unsigned char*)lds_raw;
    F.tid = threadIdx.x; F.lane = F.tid & 63; F.wave = __builtin_amdgcn_readfirstlane(F.tid >> 6);
    F.bid = blockIdx.x; F.G = gridDim.x; F.gw = F.bid * 8 + F.wave; F.NGW = F.G * 8;
    F.out = ap0->out; F.ws = ap0->ws;
    unsigned* ctl = (unsigned*)(F.ws + WS_CTL);
    const int lo = ap0->ph_lo, hi = ap0->ph_hi;
    volatile LAS unsigned* bst = (volatile LAS unsigned*)(F.lds + LDS_BYTES - 16);
    XcdBarrier bar; bar.bar = ctl + CW_BAR; bar.x = 0; bar.st = bst;
    const bool multi = (hi - lo) > 1;
    if (multi) { if (F.tid == 0) { bst[0] = 0u; bst[1] = 0u; } __syncthreads(); bar = xcd_barrier_post(ctl + CW_BAR, bst); }
#ifndef PROBE_DUP
#define PROBE_DUP 0ull
#endif
#ifndef PHMASK
#define PHMASK 0xFFFFFFFFull
#endif
#define IN(k) ((((PHMASK) >> ((k) >= 20 ? (k) - 10 : (k))) & 1ull) && lo <= (k) && (k) < hi)
#define SEAM(k) do { if ((k) + 1 < hi) xcd_barrier(bar); } while (0)
#define PH_BEGIN(k) if (IN(k)) { { int t_ = threadIdx.x; asm volatile("" : "+v"(t_)); F.tid = t_; F.lane = t_ & 63; F.wave = __builtin_amdgcn_readfirstlane(t_ >> 6); F.gw = F.bid * 8 + F.wave; } ArgsP args = launder_args(ap0); ArgsP AR = args; (void)AR; F.out = args->out; F.ws = args->ws; ctl = (unsigned*)(F.ws + WS_CTL); const float* MOD = (const float*)(F.ws + WS_MOD); (void)MOD; _Pragma("unroll 1") for (int rep_ = 0; rep_ < ((((PROBE_DUP) >> ((k) >= 20 ? (k) - 10 : (k))) & 1ull) ? 2 : 1); ++rep_) {
#define PH_END(k) } } if (lo <= (k) && (k) < hi) SEAM(k);
    PH_BEGIN(0) phase_mod(F, args); __syncthreads(); phase_convert_static(F, args); phase_tables(F, args); PH_END(0)
    PH_BEGIN(1) phase_convert_experts(F, args, 0); PH_END(1)
    PH_BEGIN(2) phase_norm_mod(F, FIN(0), FIN(3), 0, (bf16*)(F.ws + WS_H), nullptr); PH_END(2)
    PH_BEGIN(3) DenseOrder S; S.init(F.ws + WS_H, F.ws + WS_WIN, 2048u, 2048u, T, INP, F.G, F.bid); EpiF32Store E{(float*)(F.ws + BG_PROJ), INP};
        pg8::gemm_phase<EpiF32Store, DenseOrder, false>(F.lds, F.tid, 1024, 2048u, 2048u, S, E); PH_END(3)
    PH_BEGIN(4) phase_postproj(F, args); PH_END(4)
    PH_BEGIN(5) phase_s5a(F, args); PH_END(5)
    PH_BEGIN(6) phase_s5b(F, args); PH_END(6)
    PH_BEGIN(7) phase_s5c(F, args); PH_END(7)
    #ifdef DSA_NAIVE
    PH_BEGIN(8) phase_dsa(F, args); PH_END(8)
#else
    PH_BEGIN(8) phase_dsa2(F, args); PH_END(8)
#endif
    PH_BEGIN(9) DenseOrder S; S.init(F.ws + BG_MIX, F.ws + WS_WOUT, 2048u, 2048u, T, D, F.G, F.bid); EpiResidual E{FIN(0), F.out, MOD + 2048, nullptr, 0};
        pg8::gemm_phase<EpiResidual, DenseOrder, false>(F.lds, F.tid, 1024, 2048u, 2048u, S, E); PH_END(9)
#define MOE_PHASES(pb, l) \
    PH_BEGIN(pb) phase_router(F, args, l); PH_END(pb) \
    PH_BEGIN(pb + 1) phase_offsets(F, l); PH_END(pb + 1) \
    PH_BEGIN(pb + 2) typedef MoeOrder<2, true> O; O S; S.init(ctl, l, F.ws, false, true, F.G, F.bid); EpiGateUp<O> E{&S, F.ws}; \
        pg8::gemm_phase<EpiGateUp<O>, O, true>(F.lds, F.tid, 1024, 2048u, 2048u, S, E); PH_END(pb + 2) \
    PH_BEGIN(pb + 3) typedef MoeOrder<4, false> O; O S; S.init(ctl, l, F.ws, false, false, F.G, F.bid); EpiDown<O, false> E{&S, F.ws, F.out, MOD + (size_t)((2 * l + 1) * 4) * 3072 + 2048}; \
        pg8::gemm_phase<EpiDown<O, false>, O, false>(F.lds, F.tid, 256, 512u, 512u, S, E); PH_END(pb + 3) \
    PH_BEGIN(pb + 4) phase_combine(F, l); PH_END(pb + 4) \
    PH_BEGIN(pb + 5) typedef MoeOrder<4, false> O; O S; S.init(ctl, l, F.ws, true, true, F.G, F.bid); EpiDown<O, true> E{&S, F.ws, F.out, MOD + (size_t)((2 * l + 1) * 4) * 3072 + 2048}; \
        pg8::gemm_phase<EpiDown<O, true>, O, false>(F.lds, F.tid, 256, 512u, 512u, S, E); PH_END(pb + 5)
    MOE_PHASES(10, 0)
    PH_BEGIN(16) phase_convert_experts(F, args, 1); PH_END(16)
    PH_BEGIN(17) phase_norm_mod(F, F.out, FIN(3) + D, 2, nullptr, (float*)(F.ws + BG_H2F)); PH_END(17)
    PH_BEGIN(18) phase_pool(F); PH_END(18)
    PH_BEGIN(19) PoolOrder S; S.init(F.ws + WS_H, F.ws + WS_WPOOL, F.G, F.bid); EpiResidual E{F.out, F.out, MOD + (size_t)(2 * 4) * 3072 + 2048, FIN(24), 1};
        pg8::gemm_phase<EpiResidual, PoolOrder, false>(F.lds, F.tid, 256, 2048u, 512u, S, E); PH_END(19)
    MOE_PHASES(20, 1)
}

extern "C" void kernel_launch(void* const* d_in, const int* in_sizes, int n_in, void* d_out, int out_size, void* d_ws, size_t ws_size, hipStream_t stream) {
    static int grid = 0;
    if (grid == 0) {
        int dev = 0, cus = 0;
        if (n_in != 33 || ws_size < WS_END) { fprintf(stderr, "kernel_launch: unexpected n_in %d or ws_size %zu (need %zu)\n", n_in, ws_size, (size_t)WS_END); grid = -1; return; }
        if (hipGetDevice(&dev) != hipSuccess || hipDeviceGetAttribute(&cus, hipDeviceAttributeMultiprocessorCount, dev) != hipSuccess) { grid = -1; return; }
        if (hipFuncSetAttribute((const void*)mega, hipFuncAttributeMaxDynamicSharedMemorySize, LDS_BYTES) != hipSuccess) { fprintf(stderr, "kernel_launch: hipFuncSetAttribute failed\n"); grid = -1; return; }
        (void)hipGetLastError();
        grid = cus - (cus % 8); if (grid <= 0) grid = cus;
    }
    if (grid < 0) return;
    (void)hipMemsetAsync((char*)d_ws + WS_CTL, 0, CTL_ZERO_BYTES, stream);
    Args a{};
    for (int i = 0; i < 33; ++i) a.in[i] = (const float*)d_in[i];
    a.out = (float*)d_out; a.ws = (unsigned char*)d_ws;
    const int last = 26;
#if MK_LAUNCH_PER_PHASE
    for (int p = 0; p < last; ++p) { a.ph_lo = p; a.ph_hi = p + 1; hipLaunchKernelGGL(mega, dim3(grid), dim3(512), LDS_BYTES, stream, a); }
#else
    a.ph_lo = 0; a.ph_hi = last; hipLaunchKernelGGL(mega, dim3(grid), dim3(512), LDS_BYTES, stream, a);
#endif
}
```

```cpp
#include <hip/hip_runtime.h>
#include <cstdio>
#include <cstdint>

#ifndef MK_LAUNCH_PER_PHASE
#define MK_LAUNCH_PER_PHASE 0
#endif

#define GAS __attribute__((address_space(1)))
#define LAS __attribute__((address_space(3)))
typedef unsigned short bf16;
typedef unsigned v4u __attribute__((ext_vector_type(4)));
typedef unsigned v2u __attribute__((ext_vector_type(2)));
typedef float f32x4 __attribute__((ext_vector_type(4)));
typedef short bf16x8 __attribute__((ext_vector_type(8)));
#define LDS_WAIT() asm volatile("s_waitcnt lgkmcnt(0)" ::: "memory")
#define VM_WAIT() asm volatile("s_waitcnt vmcnt(0)" ::: "memory")

constexpr int NB = 4, SEQ = 4096, T = NB * SEQ, D = 1024;
constexpr int INW = 1736, INP = 1792;
constexpr int NEXP = 64, EDIM = 256;
constexpr int NASSIGN = T * 8;
constexpr int ECAP = T;

constexpr size_t MiB = 1u << 20;
constexpr size_t WS_CTL = 0;
constexpr size_t CTL_ZERO_BYTES = 1 * MiB;
constexpr size_t WS_MOD = 1 * MiB;
constexpr size_t WS_ROPE = WS_MOD + 256 * 1024;
constexpr size_t WS_S5T = WS_ROPE + 1 * MiB;
constexpr size_t WS_WIN = 4 * MiB;
constexpr size_t WS_WOUT = WS_WIN + (size_t)INP * D * 2;
constexpr size_t WS_WPOOL = WS_WOUT + (size_t)D * D * 2;
constexpr size_t WS_WGU = 10 * MiB;
constexpr size_t WS_WD = WS_WGU + (size_t)65 * 512 * 1024 * 2;
constexpr size_t WS_H = WS_WD + (size_t)65 * 1024 * 256 * 2;
constexpr size_t WS_EIDX = WS_H + (size_t)T * D * 2;
constexpr size_t WS_SLOT = WS_EIDX + (size_t)T * 8 * 4;
constexpr size_t WS_ELT = WS_SLOT + (size_t)T * 8 * 4;
constexpr size_t WS_ELW = WS_ELT + (size_t)NEXP * ECAP * 4;
constexpr size_t WS_BIG = WS_ELW + (size_t)NEXP * ECAP * 4;
constexpr size_t BG_PROJ = WS_BIG;
constexpr size_t BG_U = BG_PROJ + (size_t)T * INP * 4;
constexpr size_t BG_Q = BG_U + (size_t)T * 512 * 4;
constexpr size_t BG_QI = BG_Q + (size_t)T * 512 * 2;
constexpr size_t BG_K = BG_QI + (size_t)T * 512 * 2;
constexpr size_t BG_V = BG_K + (size_t)T * 64 * 2;
constexpr size_t BG_KI = BG_V + (size_t)T * 64 * 2;
constexpr size_t BG_WI = BG_KI + (size_t)T * 64 * 2;
constexpr size_t BG_SLOC = BG_WI + (size_t)T * 8 * 4;
constexpr size_t BG_SIN = BG_SLOC + (size_t)4 * 32 * 64 * 64 * 2 * 4;
constexpr size_t BG_MIX = BG_SIN + (size_t)4 * 32 * 64 * 64 * 2 * 4;
constexpr size_t BG_VT = BG_MIX + (size_t)T * D * 2;
constexpr size_t BG_POW = BG_VT + (size_t)T * 64 * 2;
constexpr size_t BG_S5MB = BG_POW + (size_t)32 * 64 * 33 * 16;
constexpr size_t BG_S5WE = BG_S5MB + (size_t)32 * 512 * 640 * 2;
constexpr size_t BG_AUG = BG_S5WE + (size_t)32 * 256 * 512 * 2;
constexpr size_t BG_SL2 = BG_AUG + (size_t)32 * 512 * 640 * 2;
constexpr size_t BG_MIXER_END = BG_SL2 + (size_t)32 * 512 * 128 * 4;
constexpr size_t BG_HB = WS_BIG;
constexpr size_t BG_HBSH = BG_HB + (size_t)(NASSIGN + 256) * 256 * 2;
constexpr size_t BG_Y = BG_HBSH + (size_t)T * 256 * 2;
constexpr size_t BG_MOE_END = BG_Y + (size_t)NASSIGN * D * 2;
constexpr size_t BG_H2F = WS_BIG;
constexpr size_t WS_END = (BG_MOE_END > BG_MIXER_END ? BG_MOE_END : BG_MIXER_END);
static_assert(WS_END <= 539993216ull, "workspace map exceeds the guaranteed d_ws size");

constexpr int S5_ABAR = 0;
constexpr int S5_A64 = S5_ABAR + 32 * 64 * 2;
constexpr int S5_BBR = S5_A64 + 32 * 64 * 2;
constexpr int S5_BBI = S5_BBR + 32 * 64 * 16;

constexpr int CW_BAR = 4096;
constexpr int CW_CNT = 16384;
constexpr int CW_EST = 16384 + 256;
constexpr int CW_NT = 16384 + 512;
constexpr int CW_TE = 16384 + 1024;
constexpr int CW_TJ = 16384 + 4096;
constexpr int LDS_BYTES = 163840;

__device__ __forceinline__ unsigned f2bf(float f) { unsigned u = __builtin_bit_cast(unsigned, f); return (u + 0x7fffu + ((u >> 16) & 1u)) >> 16; }
__device__ __forceinline__ unsigned pk2(float lo, float hi) { return f2bf(lo) | (f2bf(hi) << 16); }
__device__ __forceinline__ float bf2f(unsigned b) { return __builtin_bit_cast(float, b << 16); }
__device__ __forceinline__ float bflo(unsigned w) { return __builtin_bit_cast(float, w << 16); }
__device__ __forceinline__ float bfhi(unsigned w) { return __builtin_bit_cast(float, w & 0xffff0000u); }
__device__ __forceinline__ float wave_sum(float v) {
#pragma unroll
    for (int o = 1; o < 64; o <<= 1) v += __shfl_xor(v, o);
    return v;
}
__device__ __forceinline__ float wave_max(float v) {
#pragma unroll
    for (int o = 1; o < 64; o <<= 1) v = fmaxf(v, __shfl_xor(v, o));
    return v;
}
__device__ __forceinline__ int wave_sum_i(int v) {
#pragma unroll
    for (int o = 1; o < 64; o <<= 1) v += __shfl_xor(v, o);
    return v;
}
__device__ __forceinline__ float sigmoidf_(float x) { return 1.0f / (1.0f + __expf(-x)); }

namespace pg8 {
typedef float f32x4 __attribute__((ext_vector_type(4)));
constexpr int BM = 256, BK = 64, HALF = 128, HTB = HALF * BK * 2, STAGE_BYTES = 8 * HTB;
__host__ __device__ __forceinline__ int lds_byte(int r, int c) { const int st = (r >> 4) * 2 + (c >> 5), rr = r & 15, cc = c & 31, ob = rr * 64 + cc * 2; return st * 1024 + (ob ^ (((ob >> 9) & 1) << 5)); }
__host__ __device__ __forceinline__ void stage_rc(int b, int& R, int& C) { const int st = b / 1024, sb = b % 1024, swz = sb ^ (((sb >> 9) & 1) << 5); R = (st >> 1) * 16 + swz / 64; C = (st & 1) * 32 + (swz % 64) / 2; }
struct Unit { int pm, pn, e, rows; };
template <class Epi, class Sched, bool GATHER>
__device__ __forceinline__ void gemm_phase(LAS unsigned char* lds, const int tid, const int K, const unsigned lda_b, const unsigned ldb_b, const Sched& S, const Epi& E) {
    const int wid = __builtin_amdgcn_readfirstlane(tid >> 6), lane = tid & 63, wr = wid >> 2, wc = wid & 3, fr = lane & 15, fq = lane >> 4;
    const int nt = K / BK;
    unsigned voffA[2], voffB[2]; int RA[2], CA[2];
#pragma unroll
    for (int i = 0; i < 2; ++i) { int R, C; stage_rc(tid * 16 + i * 8192, R, C); RA[i] = R; CA[i] = C; voffA[i] = (unsigned)R * lda_b + (unsigned)C * 2u; voffB[i] = (unsigned)R * ldb_b + (unsigned)C * 2u; }
    const size_t kstep = (size_t)(BK * 2);
    const size_t hstepA = (size_t)HALF * lda_b, hstepB = (size_t)HALF * ldb_b;
    const unsigned ldsw = (unsigned)wid * 1024u;
    const int aoff = lds_byte(wr * 64 + fr, fq * 8), boff = lds_byte(wc * 32 + fr, fq * 8);
#define PG8_SA(b, h) (((b) * 2 + (h)) * HTB)
#define PG8_SB(b, h) ((4 + (b) * 2 + (h)) * HTB)
#define PG8_STAGE(bufoff, gbase, voff) do { _Pragma("unroll") for (int _i = 0; _i < 2; ++_i) \
        __builtin_amdgcn_global_load_lds((const unsigned*)((const char*)(gbase) + (voff)[_i]), (LAS unsigned*)(lds + (bufoff) + ldsw + _i * 8192), 16, 0, 0); } while (0)
#define PG8_STAGE_A(bufoff, gbase, h, OS) do { if constexpr (GATHER) { PG8_STAGE(bufoff, gbase, g##OS##h); } else { PG8_STAGE(bufoff, (gbase) + (h) * hstepA, voffA); } } while (0)
#define PG8_LDA(dst, b, h) do { _Pragma("unroll") for (int m = 0; m < 4; ++m) _Pragma("unroll") for (int k = 0; k < 2; ++k) dst[m][k] = *(const LAS bf16x8*)(lds + PG8_SA(b, h) + aoff + m * 2048 + k * 1024); } while (0)
#define PG8_LDB(dst, b, h) do { _Pragma("unroll") for (int n = 0; n < 2; ++n) _Pragma("unroll") for (int k = 0; k < 2; ++k) dst[n][k] = *(const LAS bf16x8*)(lds + PG8_SB(b, h) + boff + n * 2048 + k * 1024); } while (0)
#define PG8_MMA(ai, bj, At, Bt) do { __builtin_amdgcn_s_setprio(1); _Pragma("unroll") for (int m = 0; m < 4; ++m) _Pragma("unroll") for (int n = 0; n < 2; ++n) _Pragma("unroll") for (int k = 0; k < 2; ++k) \
        acc[ai][bj][m][n] = __builtin_amdgcn_mfma_f32_16x16x32_bf16(Bt[n][k], At[m][k], acc[ai][bj][m][n], 0, 0, 0); __builtin_amdgcn_s_setprio(0); } while (0)
#define PG8_WAIT_V(n) asm volatile("s_waitcnt vmcnt(" #n ")" ::: "memory")
#define PG8_WAIT_L(n) asm volatile("s_waitcnt lgkmcnt(" #n ")" ::: "memory")
#define PG8_BAR __builtin_amdgcn_s_barrier()
#define PG8_SCHED __builtin_amdgcn_sched_barrier(0)
    Unit cur, nxt; int ui = 0;
    if (!S.next(0, cur)) return;
    f32x4 acc[2][2][4][2];
#pragma unroll
    for (int a = 0; a < 2; ++a)
#pragma unroll
        for (int b = 0; b < 2; ++b)
#pragma unroll
            for (int m = 0; m < 4; ++m)
#pragma unroll
                for (int n = 0; n < 2; ++n) acc[a][b][m][n] = (f32x4){0.f, 0.f, 0.f, 0.f};
    bf16x8 At[4][2], B0[2][2], B1[2][2];
    unsigned gc0[2] = {0u, 0u}, gc1[2] = {0u, 0u}, gn0[2] = {0u, 0u}, gn1[2] = {0u, 0u};
    const char* cA = S.a_base(cur); const char* cB = S.b_base(cur);
    if constexpr (GATHER) {
#pragma unroll
        for (int i = 0; i < 2; ++i) { gc0[i] = S.a_off(cur, RA[i]) + (unsigned)CA[i] * 2u; gc1[i] = S.a_off(cur, HALF + RA[i]) + (unsigned)CA[i] * 2u; }
    }
    PG8_STAGE(PG8_SB(0, 0), cB, voffB); PG8_STAGE(PG8_SB(0, 1), cB + hstepB, voffB); PG8_STAGE_A(PG8_SA(0, 0), cA, 0, c); PG8_STAGE_A(PG8_SA(0, 1), cA, 1, c);
    if (wr == 1) PG8_BAR;
    PG8_WAIT_V(2); PG8_BAR;
    PG8_STAGE(PG8_SB(1, 0), cB + kstep, voffB); PG8_STAGE_A(PG8_SA(1, 0), cA + kstep, 0, c); PG8_STAGE(PG8_SB(1, 1), cB + hstepB + kstep, voffB);
    PG8_WAIT_V(6); PG8_BAR;
#pragma unroll 1
    for (;;) {
        const bool has_next = S.next(ui + 1, nxt);
        const char* nA = has_next ? S.a_base(nxt) : cA; const char* nB = has_next ? S.b_base(nxt) : cB;
        if constexpr (GATHER) {
            if (has_next) {
#pragma unroll
                for (int i = 0; i < 2; ++i) { gn0[i] = S.a_off(nxt, RA[i]) + (unsigned)CA[i] * 2u; gn1[i] = S.a_off(nxt, HALF + RA[i]) + (unsigned)CA[i] * 2u; }
            } else {
#pragma unroll
                for (int i = 0; i < 2; ++i) { gn0[i] = gc0[i]; gn1[i] = gc1[i]; }
            }
        }
#pragma unroll 1
        for (int t = 0; t < nt; t += 2) {
            const bool last = (t == nt - 2);
            const char* a1 = cA + (size_t)(t + 1) * kstep;
            const char* a2 = last ? nA : cA + (size_t)(t + 2) * kstep; const char* b2 = last ? nB : cB + (size_t)(t + 2) * kstep;
            const char* a3 = a2 + kstep; const char* b3 = b2 + kstep;
            unsigned gx0[2], gx1[2];
#pragma unroll
            for (int i = 0; i < 2; ++i) { gx0[i] = last ? gn0[i] : gc0[i]; gx1[i] = last ? gn1[i] : gc1[i]; }
            (void)gx0; (void)gx1;
            PG8_LDB(B0, 0, 0); PG8_LDB(B1, 0, 1); PG8_SCHED; PG8_LDA(At, 0, 0); PG8_STAGE_A(PG8_SA(1, 1), a1, 1, c);
            PG8_WAIT_V(8); PG8_WAIT_L(0); PG8_BAR; PG8_MMA(0, 0, At, B0); PG8_MMA(0, 1, At, B1); PG8_BAR; PG8_SCHED;
            PG8_LDA(At, 0, 1); PG8_STAGE(PG8_SB(0, 0), b2, voffB); PG8_STAGE(PG8_SB(0, 1), b2 + hstepB, voffB); PG8_STAGE_A(PG8_SA(0, 0), a2, 0, x);
            PG8_WAIT_V(8); PG8_WAIT_L(0); PG8_BAR; PG8_MMA(1, 0, At, B0); PG8_MMA(1, 1, At, B1); PG8_BAR; PG8_SCHED;
            PG8_LDB(B0, 1, 0); PG8_LDB(B1, 1, 1); PG8_SCHED; PG8_LDA(At, 1, 0); PG8_STAGE_A(PG8_SA(0, 1), a2, 1, x);
            PG8_WAIT_V(8); PG8_WAIT_L(0); PG8_BAR; PG8_MMA(0, 0, At, B0); PG8_MMA(0, 1, At, B1); PG8_BAR; PG8_SCHED;
            PG8_LDA(At, 1, 1); PG8_STAGE(PG8_SB(1, 0), b3, voffB); PG8_STAGE(PG8_SB(1, 1), b3 + hstepB, voffB); PG8_STAGE_A(PG8_SA(1, 0), a3, 0, x);
            PG8_WAIT_V(8); PG8_WAIT_L(0); PG8_BAR; PG8_MMA(1, 0, At, B0); PG8_MMA(1, 1, At, B1); PG8_BAR; PG8_SCHED;
        }
        if (wr == 0) PG8_BAR;
        E(acc, cur, wr, wc, fr, fq);
        if (!has_next) break;
#pragma unroll
        for (int a = 0; a < 2; ++a)
#pragma unroll
            for (int b = 0; b < 2; ++b)
#pragma unroll
                for (int m = 0; m < 4; ++m)
#pragma unroll
                    for (int n = 0; n < 2; ++n) acc[a][b][m][n] = (f32x4){0.f, 0.f, 0.f, 0.f};
        cur = nxt; cA = nA; cB = nB; ++ui;
        if constexpr (GATHER) {
#pragma unroll
            for (int i = 0; i < 2; ++i) { gc0[i] = gn0[i]; gc1[i] = gn1[i]; }
        }
        if (wr == 1) PG8_BAR;
    }
    PG8_WAIT_V(0);
    PG8_BAR;
#undef PG8_SA
#undef PG8_SB
#undef PG8_STAGE
#undef PG8_STAGE_A
#undef PG8_LDA
#undef PG8_LDB
#undef PG8_MMA
#undef PG8_WAIT_V
#undef PG8_WAIT_L
#undef PG8_BAR
#undef PG8_SCHED
}
}

#define XB_TMO      128
#define XB_XCNT(j)  (256  + 64 * (j))
#define XB_XSUB(j)  (1280 + 64 * (j))
#define XB_XGEN(j)  (2304 + 64 * (j))
#define XB_TOP      3328
#define XB_TOPGEN   3392
#define XCD_BAR_WORDS 3456
#define XB_SPIN_CAP (1u << 22)
__device__ __forceinline__ unsigned xb_ld(unsigned* p)              { return __hip_atomic_load(p, __ATOMIC_RELAXED, __HIP_MEMORY_SCOPE_AGENT); }
__device__ __forceinline__ unsigned xb_add(unsigned* p, unsigned v) { return __hip_atomic_fetch_add(p, v, __ATOMIC_RELAXED, __HIP_MEMORY_SCOPE_AGENT); }
__device__ __forceinline__ unsigned xb_xcc_id() { return (unsigned)__builtin_amdgcn_s_getreg((3 << 11) | 20) & 0xFu; }
#define XB_SPIN(cond, bar) do { unsigned _sp = 0; while (cond) { __builtin_amdgcn_s_sleep(1); \
    if ((++_sp & 255u) == 0u) { if (xb_ld(&(bar)[XB_TMO])) break; if (_sp > XB_SPIN_CAP) { atomicAdd(&(bar)[XB_TMO], 1u); break; } } } } while (0)
struct XcdBarrier { unsigned* bar; unsigned x; volatile LAS unsigned* st; };
__device__ __forceinline__ XcdBarrier xcd_barrier_post(unsigned* bar, volatile LAS unsigned* st) {
    XcdBarrier b; b.bar = bar; b.x = xb_xcc_id(); b.st = st;
    if (threadIdx.x == 0) (void)xb_add(&bar[XB_XCNT(b.x)], 1u);
    return b;
}
__device__ __forceinline__ void xcd_barrier_complete(unsigned* bar, unsigned x, unsigned& nloc, unsigned& nx) {
    const unsigned G = gridDim.x * gridDim.y * gridDim.z;
    unsigned sum, cnt, mine, sp = 0u;
    for (;;) {
        sum = 0u; cnt = 0u; mine = 0u;
#pragma unroll
        for (unsigned j = 0; j < 16; ++j) { const unsigned c = xb_ld(&bar[XB_XCNT(j)]); sum += c; cnt += (c > 0u) ? 1u : 0u; mine = (j == x) ? c : mine; }
        if (sum == G) break;
        __builtin_amdgcn_s_sleep(1);
        if ((++sp & 255u) == 0u) { if (xb_ld(&bar[XB_TMO])) break; if (sp > XB_SPIN_CAP) { atomicAdd(&bar[XB_TMO], 1u); break; } }
    }
    nloc = mine > 0u ? mine : 1u; nx = cnt > 0u ? cnt : 1u;
}
__device__ __forceinline__ void xcd_barrier(const XcdBarrier& b) {
    asm volatile("s_waitcnt vmcnt(0)" ::: "memory");
    __syncthreads();
    if (threadIdx.x == 0) {
        unsigned* bar = b.bar;
        __builtin_amdgcn_s_waitcnt(0);
        unsigned nloc = b.st[0], nx = b.st[1];
        if (nloc == 0u) { xcd_barrier_complete(bar, b.x, nloc, nx); b.st[0] = nloc; b.st[1] = nx; }
        const unsigned old = xb_add(&bar[XB_XSUB(b.x)], 1u);
        const unsigned gen = old / nloc;
        if (old + 1u == (gen + 1u) * nloc) {
            __builtin_amdgcn_fence(__ATOMIC_RELEASE, "agent");
            asm volatile("s_waitcnt vmcnt(0)" ::: "memory");
            const unsigned og = xb_add(&bar[XB_TOP], 1u);
            const unsigned tg = og / nx;
            if (og + 1u == (tg + 1u) * nx) xb_add(&bar[XB_TOPGEN], 1u);
            else XB_SPIN(xb_ld(&bar[XB_TOPGEN]) == tg, bar);
            __builtin_amdgcn_fence(__ATOMIC_ACQUIRE, "agent");
            xb_add(&bar[XB_XGEN(b.x)], 1u);
            asm volatile("s_waitcnt vmcnt(0)" ::: "memory");
        } else {
            XB_SPIN(xb_ld(&bar[XB_XGEN(b.x)]) == gen, bar);
            __builtin_amdgcn_fence(__ATOMIC_ACQUIRE, "agent");
            asm volatile("s_waitcnt vmcnt(0)" ::: "memory");
        }
    }
    __syncthreads();
}

struct Frame {
    LAS unsigned char* lds;
    int tid, lane, wave, bid, G, gw, NGW;
    float* out; unsigned char* ws;
};
struct Args { const float* in[33]; float* out; unsigned char* ws; int ph_lo, ph_hi; };
#define FIN(i) (AR->in[i])
#define CAS __attribute__((address_space(4)))
typedef const CAS Args* ArgsP;
__device__ __forceinline__ ArgsP launder_args(ArgsP p) { asm volatile("" : "+s"(p)); return p; }

__device__ __forceinline__ void phase_mod(Frame& F, ArgsP AR) {
    LAS float* cs = (LAS float*)F.lds;
    LAS float* red = cs + 4096;
    const float* c = FIN(1);
    for (int i = F.tid; i < 4096; i += 512) { const float v = c[i]; cs[i] = v / (1.0f + __expf(-v)); }
    __syncthreads();
    float* MOD = (float*)(F.ws + WS_MOD);
    for (int it = F.bid; it < 192; it += F.G) {
        const int m = it / 48, n0 = (it % 48) * 64, l = m >> 1;
        const float* W = ((m & 1) ? FIN(7) : FIN(4)) + (size_t)l * 1024 * 3072;
        const float* bias = ((m & 1) ? FIN(8) : FIN(5)) + (size_t)l * 3072;
        float a0 = 0.f, a1 = 0.f, a2 = 0.f, a3 = 0.f;
        const int k0 = F.wave * 128;
#pragma unroll 32
        for (int k = k0; k < k0 + 128; ++k) {
            const float w = W[(size_t)k * 3072 + n0 + F.lane];
            a0 += cs[k] * w; a1 += cs[1024 + k] * w; a2 += cs[2048 + k] * w; a3 += cs[3072 + k] * w;
        }
        red[(F.wave * 4 + 0) * 64 + F.lane] = a0; red[(F.wave * 4 + 1) * 64 + F.lane] = a1; red[(F.wave * 4 + 2) * 64 + F.lane] = a2; red[(F.wave * 4 + 3) * 64 + F.lane] = a3;
        __syncthreads();
        if (F.tid < 256) { const int b = F.tid >> 6, n = F.tid & 63; float s = 0.f;
#pragma unroll
            for (int w = 0; w < 8; ++w) s += red[(w * 4 + b) * 64 + n];
            MOD[(size_t)(m * 4 + b) * 3072 + n0 + n] = s + bias[n0 + n]; }
        __syncthreads();
    }
}

__device__ __forceinline__ void transpose_item(const float* W, int ldw, int nvalid, int K, bf16* WT, int mode, LAS float* scr, int kb, int nb, int lane) {
    const int k0 = 64 * kb, n0 = 32 * nb;
    const int nn = n0 + (lane & 31);
#pragma unroll 8
    for (int i = 0; i < 32; ++i) { const int kk = 2 * i + (lane >> 5); scr[kk * 33 + (lane & 31)] = (nn < nvalid) ? W[(size_t)(k0 + kk) * ldw + nn] : 0.f; }
    LDS_WAIT();
    const int c = lane & 7;
#pragma unroll
    for (int j = 0; j < 4; ++j) { const int nl = (lane >> 3) + 8 * j; const LAS float* s = scr + (8 * c) * 33 + nl;
        v4u o; o.x = pk2(s[0 * 33], s[1 * 33]); o.y = pk2(s[2 * 33], s[3 * 33]); o.z = pk2(s[4 * 33], s[5 * 33]); o.w = pk2(s[6 * 33], s[7 * 33]);
        const int n = n0 + nl; const int row = (mode == 0) ? n : (256 * (n >> 7) + (n & 127) + (mode == 2 ? 128 : 0));
        *(v4u*)(WT + (size_t)row * K + k0 + 8 * c) = o; }
    LDS_WAIT();
}
__device__ __forceinline__ void phase_convert_static(Frame& F, ArgsP AR) {
    LAS float* scr = (LAS float*)(F.lds + F.wave * 16384);
    constexpr int I_IN = 16 * 56, I_OUT = 16 * 32, I_POOL = 4 * 4 * 8;
    for (int it = F.gw; it < I_IN + I_OUT + I_POOL; it += F.NGW) {
        int r = it;
        if (r < I_IN) { transpose_item(FIN(9), INW, INW, 1024, (bf16*)(F.ws + WS_WIN), 0, scr, r / 56, r % 56, F.lane); continue; } r -= I_IN;
        if (r < I_OUT) { transpose_item(FIN(10), 1024, 1024, 1024, (bf16*)(F.ws + WS_WOUT), 0, scr, r / 32, r % 32, F.lane); continue; } r -= I_OUT;
        const int g = r / 32, rr = r % 32;
        transpose_item(FIN(23) + (size_t)g * 65536, 256, 256, 256, (bf16*)(F.ws + WS_WPOOL) + (size_t)g * 65536, 0, scr, rr / 8, rr % 8, F.lane);
    }
}
__device__ __forceinline__ void phase_convert_experts(Frame& F, ArgsP AR, int l) {
    LAS float* scr = (LAS float*)(F.lds + F.wave * 16384);
    for (int it = F.gw; it < 65 * 384; it += F.NGW) {
        const int e = it / 384, r = it % 384, type = r >> 7, sub = r & 127;
        if (type < 2) {
            const float* W = (e < 64) ? (FIN(type == 0 ? 27 : 28) + (size_t)(l * 64 + e) * 1024 * 256) : (FIN(type == 0 ? 30 : 31) + (size_t)l * 1024 * 256);
            transpose_item(W, 256, 256, 1024, (bf16*)(F.ws + WS_WGU) + (size_t)e * 512 * 1024, 1 + type, scr, sub >> 3, sub & 7, F.lane);
        } else {
            const float* W = (e < 64) ? (FIN(29) + (size_t)(l * 64 + e) * 256 * 1024) : (FIN(32) + (size_t)l * 256 * 1024);
            transpose_item(W, 1024, 1024, 256, (bf16*)(F.ws + WS_WD) + (size_t)e * 1024 * 256, 0, scr, sub >> 5, sub & 31, F.lane);
        }
    }
}

__device__ __forceinline__ void phase_tables(Frame& F, ArgsP AR) {
    float* S5 = (float*)(F.ws + WS_S5T);
    const int gid = F.bid * 512 + F.tid, NT_ = F.G * 512;
    for (int i = gid; i < 2048; i += NT_) {
        const int g = i >> 6;
        const double lr = FIN(11)[i], li = FIN(12)[i], dt = exp((double)FIN(13)[g]);
        const double mag = exp(lr * dt), ar = mag * cos(li * dt), ai = mag * sin(li * dt);
        const double nr = ar - 1.0, ni = ai, den = lr * lr + li * li;
        const double cr = (nr * lr + ni * li) / den, ci = (ni * lr - nr * li) / den;
        S5[S5_ABAR + 2 * i] = (float)ar; S5[S5_ABAR + 2 * i + 1] = (float)ai;
        double pr = ar, pi = ai;
        for (int s = 0; s < 6; ++s) { const double t = pr * pr - pi * pi; pi = 2.0 * pr * pi; pr = t; }
        S5[S5_A64 + 2 * i] = (float)pr; S5[S5_A64 + 2 * i + 1] = (float)pi;
        for (int h = 0; h < 16; ++h) { const double br = FIN(14)[i * 16 + h], bi = FIN(15)[i * 16 + h];
            S5[S5_BBR + i * 16 + h] = (float)(cr * br - ci * bi); S5[S5_BBI + i * 16 + h] = (float)(cr * bi + ci * br); }
    }
    double* POW = (double*)(F.ws + BG_POW);
    for (int i = gid; i < 2048 * 33; i += NT_) {
        const int gp = i / 33, dl = i % 33, g = gp >> 6;
        const double lr = FIN(11)[gp], li = FIN(12)[gp], dt = exp((double)FIN(13)[g]);
        const double mag = exp(lr * dt * dl), ang = li * dt * dl;
        POW[2 * i] = mag * cos(ang); POW[2 * i + 1] = mag * sin(ang);
    }
    float* ROPE = (float*)(F.ws + WS_ROPE);
    const int* pos = (const int*)FIN(2);
    for (int i = gid; i < T * 8; i += NT_) {
        const int t = i >> 3, j = i & 7;
        const float inv = (j == 0) ? 1.0f : (j == 1) ? 0.1939227432f : (j == 2) ? 0.03760603070f : (j == 3) ? 0.007292664610f : (j == 4) ? 0.001414213562f : (j == 5) ? 0.0002742481884f : (j == 6) ? 5.318295734e-05f : 1.031338525e-05f;
        const float ang = (float)pos[t] * inv;
        float sn, cs; sincosf(ang, &sn, &cs);
        ROPE[2 * i] = cs; ROPE[2 * i + 1] = sn;
    }
}

__device__ __forceinline__ void phase_norm_mod(Frame& F, const float* X, const float* gamma, int m, bf16* Hout, float* Hf) {
    const float* MOD = (const float*)(F.ws + WS_MOD);
    for (int row = F.gw; row < T; row += F.NGW) {
        const int b = row >> 12;
        const float* shift = MOD + (size_t)(m * 4 + b) * 3072; const float* scale = shift + 1024;
        const f32x4* xr = (const f32x4*)(X + (size_t)row * D) + F.lane;
        f32x4 v[4]; float ss = 0.f;
#pragma unroll
        for (int j = 0; j < 4; ++j) { v[j] = xr[64 * j]; ss += v[j].x * v[j].x + v[j].y * v[j].y + v[j].z * v[j].z + v[j].w * v[j].w; }
        const float rstd = rsqrtf(wave_sum(ss) * (1.0f / D) + 1e-6f);
#pragma unroll
        for (int j = 0; j < 4; ++j) {
            const int c0 = 4 * F.lane + 256 * j;
            const f32x4 gg = *(const f32x4*)(gamma + c0), sc = *(const f32x4*)(scale + c0), sh = *(const f32x4*)(shift + c0);
            f32x4 h; h.x = v[j].x * rstd * gg.x * (1.f + sc.x) + sh.x; h.y = v[j].y * rstd * gg.y * (1.f + sc.y) + sh.y;
            h.z = v[j].z * rstd * gg.z * (1.f + sc.z) + sh.z; h.w = v[j].w * rstd * gg.w * (1.f + sc.w) + sh.w;
            if (Hout) { v2u o; o.x = pk2(h.x, h.y); o.y = pk2(h.z, h.w); *(v2u*)(Hout + (size_t)row * D + c0) = o; }
            if (Hf) *(f32x4*)(Hf + (size_t)row * D + c0) = h;
        }
    }
}

struct DenseOrder {
    const char* A; const char* Bt; unsigned lda_b, ldb_b; int nM, nN, nU, chunk, x, q0, qs;
    __device__ __forceinline__ void init(const void* A_, const void* Bt_, unsigned lda, unsigned ldb, int M, int N, int G, int c) {
        A = (const char*)A_; Bt = (const char*)Bt_; lda_b = lda; ldb_b = ldb; nM = M / 256; nN = N / 256; nU = nM * nN; chunk = (nU + 7) / 8; x = c & 7; q0 = c >> 3; qs = G >> 3; }
    __device__ __forceinline__ bool next(int i, pg8::Unit& u) const {
        const int q = i * qs + q0; if (q >= chunk) return false; const int L = x * chunk + q; if (L >= nU) return false;
        u.pm = L / nN; u.pn = L % nN; u.e = 0; u.rows = 256; return true; }
    __device__ __forceinline__ const char* a_base(const pg8::Unit& u) const { return A + (size_t)u.pm * 256 * lda_b; }
    __device__ __forceinline__ const char* b_base(const pg8::Unit& u) const { return Bt + (size_t)u.pn * 256 * ldb_b; }
    __device__ __forceinline__ unsigned a_off(const pg8::Unit&, int) const { return 0u; }
};
struct PoolOrder {
    const char* A; const char* Bt; int nU, chunk, x, q0, qs;
    __device__ __forceinline__ void init(const void* A_, const void* Bt_, int G, int c) { A = (const char*)A_; Bt = (const char*)Bt_; nU = 64 * 4; chunk = (nU + 7) / 8; x = c & 7; q0 = c >> 3; qs = G >> 3; }
    __device__ __forceinline__ bool next(int i, pg8::Unit& u) const {
        const int q = i * qs + q0; if (q >= chunk) return false; const int L = x * chunk + q; if (L >= nU) return false;
        u.pm = L >> 2; u.pn = L & 3; u.e = L & 3; u.rows = 256; return true; }
    __device__ __forceinline__ const char* a_base(const pg8::Unit& u) const { return A + (size_t)u.pm * 256 * 2048 + (size_t)u.e * 512; }
    __device__ __forceinline__ const char* b_base(const pg8::Unit& u) const { return Bt + (size_t)u.e * 256 * 512; }
    __device__ __forceinline__ unsigned a_off(const pg8::Unit&, int) const { return 0u; }
};
constexpr int LDS_MOE = 131072;
__device__ __forceinline__ void moe_tables(Frame& F, int l) {
    LAS int* est = (LAS int*)(F.lds + LDS_MOE); LAS int* tst = est + 128;
    if (F.wave == 0) {
        const unsigned* ctl = (const unsigned*)(F.ws + WS_CTL);
        const int c = (int)__hip_atomic_load(&ctl[CW_CNT + (l * 64 + F.lane) * 64], __ATOMIC_RELAXED, __HIP_MEMORY_SCOPE_AGENT);
        const int nt = (c + 255) >> 8;
        int ic = c, it = nt;
#pragma unroll
        for (int o = 1; o < 64; o <<= 1) { const int a = __shfl_up(ic, o), b2 = __shfl_up(it, o); if (F.lane >= o) { ic += a; it += b2; } }
        est[F.lane] = ic - c; tst[F.lane] = it - nt;
        if (F.lane == 63) { est[64] = ic; tst[64] = it; }
    }
    __syncthreads();
}
template <int NPN, bool GATE_UP>
struct MoeOrder {
    const LAS int* est; const LAS int* tst; const unsigned char* ws; int ntr, ntiles, nU, chunk, x, q0, qs;
    __device__ __forceinline__ void init(LAS unsigned char* lds, const unsigned char* ws_, bool shared_only, bool with_sh, int G, int c) {
        est = (const LAS int*)(lds + LDS_MOE); tst = est + 128; ws = ws_;
        ntr = shared_only ? 0 : __builtin_amdgcn_readfirstlane(tst[64]); ntiles = ntr + (with_sh ? 64 : 0); nU = ntiles * NPN; chunk = (nU + 7) / 8; x = c & 7; q0 = c >> 3; qs = G >> 3; }
    __device__ __forceinline__ bool next(int i, pg8::Unit& u) const {
        const int q = i * qs + q0; if (q >= chunk) return false; const int L = x * chunk + q; if (L >= nU) return false;
        const int tile = L / NPN; u.pn = L % NPN;
        if (tile < ntr) { int e = 0;
#pragma unroll
            for (int s_ = 32; s_ >= 1; s_ >>= 1) { if (tst[e + s_] <= tile) e += s_; }
            e = __builtin_amdgcn_readfirstlane(e); u.e = e; u.pm = __builtin_amdgcn_readfirstlane(tile - tst[e]); const int rem = __builtin_amdgcn_readfirstlane(est[e + 1] - est[e]) - 256 * u.pm; u.rows = rem < 256 ? rem : 256; }
        else { u.e = 64; u.pm = tile - ntr; u.rows = 256; }
        return true; }
    __device__ __forceinline__ int row0(const pg8::Unit& u) const { return (u.e < 64) ? __builtin_amdgcn_readfirstlane(est[u.e]) + 256 * u.pm : 256 * u.pm; }
    __device__ __forceinline__ const char* a_base(const pg8::Unit& u) const {
        if (GATE_UP) return (const char*)(ws + WS_H);
        return (u.e < 64) ? (const char*)(ws + BG_HB) + (size_t)row0(u) * 512 : (const char*)(ws + BG_HBSH) + (size_t)row0(u) * 512; }
    __device__ __forceinline__ const char* b_base(const pg8::Unit& u) const {
        if (GATE_UP) return (const char*)(ws + WS_WGU) + (size_t)u.e * 512 * 2048 + (size_t)u.pn * 256 * 2048;
        return (const char*)(ws + WS_WD) + (size_t)u.e * 1024 * 512 + (size_t)u.pn * 256 * 512; }
    __device__ __forceinline__ unsigned a_off(const pg8::Unit& u, int r) const {
        int tok;
        if (u.e < 64) { const int* elt = (const int*)(ws + WS_ELT) + (size_t)u.e * ECAP + 256 * u.pm; tok = (r < u.rows) ? elt[r] : 0; }
        else tok = 256 * u.pm + r;
        return (unsigned)tok * 2048u; }
};

struct EpiF32Store { float* C; int ldc;
    __device__ __forceinline__ void operator()(const pg8::f32x4 (&acc)[2][2][4][2], const pg8::Unit& u, int wr, int wc, int fr, int fq) const {
#pragma unroll
        for (int ai = 0; ai < 2; ++ai)
#pragma unroll
            for (int m = 0; m < 4; ++m) { float* rowp = C + (size_t)(u.pm * 256 + ai * 128 + wr * 64 + m * 16 + fr) * ldc + u.pn * 256 + wc * 32 + 4 * fq;
#pragma unroll
                for (int bj = 0; bj < 2; ++bj)
#pragma unroll
                    for (int n = 0; n < 2; ++n) *(f32x4*)(rowp + bj * 128 + n * 16) = acc[ai][bj][m][n]; }
    }
};
struct EpiResidual { const float* Xin; float* X; const float* gate; const float* colscale; int col_from_e;
    __device__ __forceinline__ void operator()(const pg8::f32x4 (&acc)[2][2][4][2], const pg8::Unit& u, int wr, int wc, int fr, int fq) const {
        const int cbase = (col_from_e ? u.e * 256 : u.pn * 256) + wc * 32 + 4 * fq;
#pragma unroll
        for (int ai = 0; ai < 2; ++ai)
#pragma unroll
            for (int m = 0; m < 4; ++m) { const int row = u.pm * 256 + ai * 128 + wr * 64 + m * 16 + fr; const int b = row >> 12;
#pragma unroll
                for (int bj = 0; bj < 2; ++bj)
#pragma unroll
                    for (int n = 0; n < 2; ++n) { const int col = cbase + bj * 128 + n * 16; const size_t o = (size_t)row * D + col;
                        f32x4 g = *(const f32x4*)(gate + (size_t)b * 3072 + col); if (colscale) { const f32x4 cs = *(const f32x4*)(colscale + col); g = g * cs; }
                        const f32x4 xi = *(const f32x4*)(Xin + o); *(f32x4*)(X + o) = xi + g * acc[ai][bj][m][n]; } }
    }
};
template <class Order> struct EpiGateUp { const Order* S; unsigned char* ws;
    __device__ __forceinline__ void operator()(const pg8::f32x4 (&acc)[2][2][4][2], const pg8::Unit& u, int wr, int wc, int fr, int fq) const {
        const int r0 = S->row0(u); bf16* HB = (bf16*)(ws + (u.e < 64 ? BG_HB : BG_HBSH));
        const float* elw = (const float*)(ws + WS_ELW) + (size_t)(u.e < 64 ? u.e : 0) * ECAP + 256 * u.pm;
#pragma unroll
        for (int ai = 0; ai < 2; ++ai)
#pragma unroll
            for (int m = 0; m < 4; ++m) { const int r = ai * 128 + wr * 64 + m * 16 + fr;
                if (r < u.rows) { const float w = (u.e < 64) ? elw[r] : 1.0f; bf16* rowp = HB + (size_t)(r0 + r) * 256 + u.pn * 128 + wc * 32 + 4 * fq;
#pragma unroll
                    for (int n = 0; n < 2; ++n) { const f32x4 g = acc[ai][0][m][n], up = acc[ai][1][m][n]; f32x4 h;
                        h.x = g.x * sigmoidf_(g.x) * up.x * w; h.y = g.y * sigmoidf_(g.y) * up.y * w; h.z = g.z * sigmoidf_(g.z) * up.z * w; h.w = g.w * sigmoidf_(g.w) * up.w * w;
                        v2u o; o.x = pk2(h.x, h.y); o.y = pk2(h.z, h.w); *(v2u*)(rowp + n * 16) = o; } } }
    }
};
template <class Order, bool SHARED> struct EpiDown { const Order* S; unsigned char* ws; float* X; const float* gate;
    __device__ __forceinline__ void operator()(const pg8::f32x4 (&acc)[2][2][4][2], const pg8::Unit& u, int wr, int wc, int fr, int fq) const {
        const int r0 = S->row0(u); bf16* Y = (bf16*)(ws + BG_Y);
#pragma unroll
        for (int ai = 0; ai < 2; ++ai)
#pragma unroll
            for (int m = 0; m < 4; ++m) { const int r = ai * 128 + wr * 64 + m * 16 + fr;
                if constexpr (!SHARED) {
                    if (r < u.rows) {
#pragma unroll
                        for (int bj = 0; bj < 2; ++bj)
#pragma unroll
                            for (int n = 0; n < 2; ++n) { const int col = u.pn * 256 + bj * 128 + wc * 32 + n * 16 + 4 * fq; const f32x4 a = acc[ai][bj][m][n];
                                v2u o; o.x = pk2(a.x, a.y); o.y = pk2(a.z, a.w); *(v2u*)(Y + (size_t)(r0 + r) * D + col) = o; } }
                } else {
                    const int tok = r0 + r;
                    const int* ei = (const int*)(ws + WS_EIDX) + (size_t)tok * 8; const int* sl = (const int*)(ws + WS_SLOT) + (size_t)tok * 8;
                    const v4u e0 = *(const v4u*)ei, e1 = *(const v4u*)(ei + 4), p0 = *(const v4u*)sl, p1 = *(const v4u*)(sl + 4);
                    size_t yr[8];
                    yr[0] = (size_t)(S->est[e0.x] + (int)p0.x); yr[1] = (size_t)(S->est[e0.y] + (int)p0.y); yr[2] = (size_t)(S->est[e0.z] + (int)p0.z); yr[3] = (size_t)(S->est[e0.w] + (int)p0.w);
                    yr[4] = (size_t)(S->est[e1.x] + (int)p1.x); yr[5] = (size_t)(S->est[e1.y] + (int)p1.y); yr[6] = (size_t)(S->est[e1.z] + (int)p1.z); yr[7] = (size_t)(S->est[e1.w] + (int)p1.w);
#pragma unroll
                    for (int bj = 0; bj < 2; ++bj)
#pragma unroll
                        for (int n = 0; n < 2; ++n) { const int col = u.pn * 256 + bj * 128 + wc * 32 + n * 16 + 4 * fq; f32x4 a = acc[ai][bj][m][n];
#pragma unroll
                            for (int k = 0; k < 8; ++k) { const v2u yw = *(const v2u*)(Y + yr[k] * D + col); a.x += bflo(yw.x); a.y += bfhi(yw.x); a.z += bflo(yw.y); a.w += bfhi(yw.y); }
                            const size_t o = (size_t)tok * D + col; const f32x4 g = *(const f32x4*)(gate + (size_t)(tok >> 12) * 3072 + col);
                            const f32x4 xi = *(const f32x4*)(X + o); *(f32x4*)(X + o) = xi + g * a; }
                }
                asm volatile("" ::: "memory"); }
    }
};

__device__ __forceinline__ void phase_postproj(Frame& F, ArgsP AR) {
    const float* PROJ = (const float*)(F.ws + BG_PROJ); const float* ROPE = (const float*)(F.ws + WS_ROPE);
    float* U = (float*)(F.ws + BG_U); bf16* Q = (bf16*)(F.ws + BG_Q); bf16* QI = (bf16*)(F.ws + BG_QI); bf16* Kb = (bf16*)(F.ws + BG_K); bf16* Vb = (bf16*)(F.ws + BG_V); bf16* KIb = (bf16*)(F.ws + BG_KI); float* WI = (float*)(F.ws + BG_WI);
    const float qg = FIN(21)[F.lane], kg = FIN(22)[F.lane];
    const int lane = F.lane;
    for (int t = F.gw; t < T; t += F.NGW) {
        const float* p = PROJ + (size_t)t * INP;
        const float cs = ROPE[(size_t)t * 16 + 2 * (lane & 7)], sn = ROPE[(size_t)t * 16 + 2 * (lane & 7) + 1];
#pragma unroll
        for (int j = 0; j < 8; ++j) { const float uv = p[j * 64 + lane]; U[(size_t)t * 512 + j * 64 + lane] = uv;
            const int col = j * 64 + lane; ((bf16*)(F.ws + BG_AUG))[((size_t)(col >> 4) * 512 + (t >> 5)) * 640 + (t & 31) * 16 + (col & 15)] = (bf16)f2bf(uv); }
        auto rope = [&](float y) -> float { const float yp = __shfl_xor(y, 8); float o = y; if (lane < 8) o = y * cs - yp * sn; else if (lane < 16) o = yp * sn + y * cs; return o; };
#pragma unroll
        for (int h = 0; h < 8; ++h) { const float x = p[512 + h * 64 + lane]; const float rstd = rsqrtf(wave_sum(x * x) * (1.0f / 64.0f) + 1e-6f);
            Q[(size_t)t * 512 + h * 64 + lane] = (bf16)f2bf(rope(x * rstd * qg)); }
        { const float x = p[1024 + lane]; const float rstd = rsqrtf(wave_sum(x * x) * (1.0f / 64.0f) + 1e-6f); Kb[(size_t)t * 64 + lane] = (bf16)f2bf(rope(x * rstd * kg)); }
        { const bf16 vv = (bf16)f2bf(p[1088 + lane]); Vb[(size_t)t * 64 + lane] = vv; ((bf16*)(F.ws + BG_VT))[((size_t)(t >> 12) * 64 + lane) * 4096 + (t & 4095)] = vv; }
#pragma unroll
        for (int h = 0; h < 8; ++h) QI[(size_t)t * 512 + h * 64 + lane] = (bf16)f2bf(rope(p[1152 + h * 64 + lane]));
        KIb[(size_t)t * 64 + lane] = (bf16)f2bf(rope(p[1664 + lane]));
        if (lane < 8) WI[(size_t)t * 8 + lane] = p[1728 + lane] * 0.35355339059327373f;
    }
}

__device__ __forceinline__ void phase_s5a(Frame& F, ArgsP AR) {
    const float* S5 = (const float*)(F.ws + WS_S5T); const float* U = (const float*)(F.ws + BG_U); float* SLOC = (float*)(F.ws + BG_SLOC);
    const int p = F.lane;
    for (int it = F.gw; it < 4 * 32 * 64; it += F.NGW) {
        const int c = it & 63, g = (it >> 6) & 31, b = it >> 11;
        const float ar = S5[S5_ABAR + 2 * (g * 64 + p)], ai = S5[S5_ABAR + 2 * (g * 64 + p) + 1];
        float br[16], bi[16];
#pragma unroll
        for (int h = 0; h < 16; ++h) { br[h] = S5[S5_BBR + (g * 64 + p) * 16 + h]; bi[h] = S5[S5_BBI + (g * 64 + p) * 16 + h]; }
        float sr = 0.f, si = 0.f;
        const float* up = U + ((size_t)b * SEQ + c * 64) * 512 + g * 16;
        for (int tau = 0; tau < 64; ++tau) {
            float bur = 0.f, bui = 0.f;
#pragma unroll
            for (int h = 0; h < 16; ++h) { const float u = up[(size_t)tau * 512 + h]; bur += br[h] * u; bui += bi[h] * u; }
            const float nr = ar * sr - ai * si + bur, ni = ar * si + ai * sr + bui; sr = nr; si = ni;
        }
        SLOC[((size_t)it * 64 + p) * 2] = sr; SLOC[((size_t)it * 64 + p) * 2 + 1] = si;
    }
}
__device__ __forceinline__ void phase_s5b(Frame& F, ArgsP AR) {
    const float* S5 = (const float*)(F.ws + WS_S5T); const float* SLOC = (const float*)(F.ws + BG_SLOC); float* SIN = (float*)(F.ws + BG_SIN);
    const int gid = F.bid * 512 + F.tid;
    for (int i = gid; i < 4 * 32 * 64; i += F.G * 512) {
        const int p = i & 63, g = (i >> 6) & 31, b = i >> 11;
        const float ar = S5[S5_A64 + 2 * (g * 64 + p)], ai = S5[S5_A64 + 2 * (g * 64 + p) + 1];
        float sr = 0.f, si = 0.f;
        for (int c = 0; c < 64; ++c) {
            const size_t o = ((((size_t)b * 32 + g) * 64 + c) * 64 + p) * 2;
            SIN[o] = sr; SIN[o + 1] = si;
            const float lr = SLOC[o], li = SLOC[o + 1];
            const float nr = ar * sr - ai * si + lr, ni = ar * si + ai * sr + li; sr = nr; si = ni;
        }
    }
}
__device__ __forceinline__ void phase_s5c(Frame& F, ArgsP AR) {
    const float* S5 = (const float*)(F.ws + WS_S5T); const float* U = (const float*)(F.ws + BG_U); const float* SIN = (const float*)(F.ws + BG_SIN); bf16* MIX = (bf16*)(F.ws + BG_MIX);
    const float* cre = FIN(16); const float* cim = FIN(17); const float* dsk = FIN(18); const float* gluw = FIN(19); const float* glub = FIN(20);
    LAS float* st = (LAS float*)(F.lds + F.wave * 10240);
    LAS float* yg = st + 2048;
    const int p = F.lane, h = F.lane & 15, tq = F.lane >> 4;
    for (int it = F.gw; it < 4 * 32 * 64; it += F.NGW) {
        const int c = it & 63, g = (it >> 6) & 31, b = it >> 11;
        const float ar = S5[S5_ABAR + 2 * (g * 64 + p)], ai = S5[S5_ABAR + 2 * (g * 64 + p) + 1];
        float br[16], bi[16];
#pragma unroll
        for (int hh = 0; hh < 16; ++hh) { br[hh] = S5[S5_BBR + (g * 64 + p) * 16 + hh]; bi[hh] = S5[S5_BBI + (g * 64 + p) * 16 + hh]; }
        float sr = SIN[((size_t)it * 64 + p) * 2], si = SIN[((size_t)it * 64 + p) * 2 + 1];
        const size_t trow0 = (size_t)b * SEQ + c * 64;
        const float dd = dsk[g * 16 + h], gb = glub[g * 16 + h];
        for (int sub = 0; sub < 4; ++sub) {
            const float* up = U + (trow0 + sub * 16) * 512 + g * 16;
            for (int tau = 0; tau < 16; ++tau) {
                float bur = 0.f, bui = 0.f;
#pragma unroll
                for (int hh = 0; hh < 16; ++hh) { const float u = up[(size_t)tau * 512 + hh]; bur += br[hh] * u; bui += bi[hh] * u; }
                const float nr = ar * sr - ai * si + bur, ni = ar * si + ai * sr + bui; sr = nr; si = ni;
                st[(tau * 64 + p) * 2] = sr; st[(tau * 64 + p) * 2 + 1] = si;
            }
            LDS_WAIT();
            float y[4];
#pragma unroll
            for (int j = 0; j < 4; ++j) { const int tau = tq + 4 * j; float a = 0.f;
                for (int pp = 0; pp < 64; ++pp) a += cre[(g * 16 + h) * 64 + pp] * st[(tau * 64 + pp) * 2] - cim[(g * 16 + h) * 64 + pp] * st[(tau * 64 + pp) * 2 + 1];
                a += dd * up[(size_t)tau * 512 + h];
                const float ge = 0.5f * a * (1.0f + tanhf(0.7978845608028654f * (a + 0.044715f * a * a * a)));
                y[j] = ge; yg[tau * 16 + h] = ge; }
            LDS_WAIT();
#pragma unroll
            for (int j = 0; j < 4; ++j) { const int tau = tq + 4 * j; float z = gb;
#pragma unroll
                for (int hh = 0; hh < 16; ++hh) z += yg[tau * 16 + hh] * gluw[(g * 16 + hh) * 16 + h];
                MIX[(trow0 + sub * 16 + tau) * D + g * 16 + h] = (bf16)f2bf(y[j] * sigmoidf_(z)); }
            LDS_WAIT();
        }
    }
}


__device__ __forceinline__ void phase_s5mats(Frame& F, ArgsP AR) {
    const double* POW = (const double*)(F.ws + BG_POW); const float* S5 = (const float*)(F.ws + WS_S5T);
    const float* cre = FIN(16); const float* cim = FIN(17);
    bf16* MB = (bf16*)(F.ws + BG_S5MB); bf16* WE = (bf16*)(F.ws + BG_S5WE);
    const int gid = F.bid * 512 + F.tid, NT_ = F.G * 512;
    for (int i = gid; i < 32 * 32 * 256; i += NT_) {
        const int h2 = i & 15, h = (i >> 4) & 15, dl = (i >> 8) & 31, g = i >> 13;
        double acc = 0.0;
#pragma unroll 16
        for (int p = 0; p < 64; ++p) {
            const int gp = g * 64 + p;
            const double pr = POW[2 * (gp * 33 + dl)], pi = POW[2 * (gp * 33 + dl) + 1];
            const double br = S5[S5_BBR + gp * 16 + h2], bi = S5[S5_BBI + gp * 16 + h2];
            const double zr = pr * br - pi * bi, zi = pr * bi + pi * br;
            acc += (double)cre[(g * 16 + h) * 64 + p] * zr - (double)cim[(g * 16 + h) * 64 + p] * zi;
        }
        const bf16 kv = (bf16)f2bf((float)acc);
        bf16* Mg = MB + (size_t)g * 512 * 640;
        for (int t2 = 0; t2 + dl < 32; ++t2) {
            Mg[(size_t)((t2 + dl) * 16 + h) * 640 + t2 * 16 + h2] = kv;
            if (dl > 0) Mg[(size_t)(t2 * 16 + h) * 640 + (t2 + dl) * 16 + h2] = (bf16)0;
        }
    }
    for (int i = gid; i < 32 * 32 * 16 * 64; i += NT_) {
        const int p = i & 63, h = (i >> 6) & 15, tau = (i >> 10) & 31, g = i >> 15;
        const int gp = g * 64 + p;
        const double pr = POW[2 * (gp * 33 + tau + 1)], pi = POW[2 * (gp * 33 + tau + 1) + 1];
        const double cr = cre[(g * 16 + h) * 64 + p], ci = cim[(g * 16 + h) * 64 + p];
        const double zr = cr * pr - ci * pi, zi = cr * pi + ci * pr;
        bf16* row = MB + ((size_t)g * 512 + tau * 16 + h) * 640 + 512 + 2 * p;
        *(unsigned*)row = pk2((float)zr, (float)(-zi));
    }
    for (int i = gid; i < 32 * 64 * 512; i += NT_) {
        const int k = i & 511, p = (i >> 9) & 63, g = i >> 15;
        const int tau = k >> 4, h2 = k & 15, gp = g * 64 + p;
        const double pr = POW[2 * (gp * 33 + 31 - tau)], pi = POW[2 * (gp * 33 + 31 - tau) + 1];
        const double br = S5[S5_BBR + gp * 16 + h2], bi = S5[S5_BBI + gp * 16 + h2];
        bf16* Wg = WE + (size_t)g * 256 * 512;
        Wg[(size_t)(2 * p) * 512 + k] = (bf16)f2bf((float)(pr * br - pi * bi));
        Wg[(size_t)(2 * p + 1) * 512 + k] = (bf16)f2bf((float)(pr * bi + pi * br));
        Wg[(size_t)(128 + 2 * p) * 512 + k] = (bf16)0; Wg[(size_t)(128 + 2 * p + 1) * 512 + k] = (bf16)0;
    }
}
struct S5AOrder {
    const unsigned char* ws; int c, G;
    __device__ __forceinline__ bool next(int i, pg8::Unit& u) const { const int L = i * G + c; if (L >= 64) return false; u.e = L >> 1; u.pm = L & 1; u.pn = 0; u.rows = 256; return true; }
    __device__ __forceinline__ const char* a_base(const pg8::Unit& u) const { return (const char*)(ws + BG_AUG) + ((size_t)u.e * 512 + u.pm * 256) * 1280; }
    __device__ __forceinline__ const char* b_base(const pg8::Unit& u) const { return (const char*)(ws + BG_S5WE) + (size_t)u.e * 256 * 1024; }
    __device__ __forceinline__ unsigned a_off(const pg8::Unit&, int) const { return 0u; }
};
struct EpiS5A { float* SL;
    __device__ __forceinline__ void operator()(const pg8::f32x4 (&acc)[2][2][4][2], const pg8::Unit& u, int wr, int wc, int fr, int fq) const {
#pragma unroll
        for (int ai = 0; ai < 2; ++ai)
#pragma unroll
            for (int m = 0; m < 4; ++m) { float* rowp = SL + ((size_t)u.e * 512 + u.pm * 256 + ai * 128 + wr * 64 + m * 16 + fr) * 128 + wc * 32 + 4 * fq;
#pragma unroll
                for (int n = 0; n < 2; ++n) *(f32x4*)(rowp + n * 16) = acc[ai][0][m][n]; }
    }
};
struct S5BOrder {
    const unsigned char* ws; int c, G;
    __device__ __forceinline__ bool next(int i, pg8::Unit& u) const { const int L = i * G + c; if (L >= 128) return false; u.e = L >> 2; u.pm = (L >> 1) & 1; u.pn = L & 1; u.rows = 256; return true; }
    __device__ __forceinline__ const char* a_base(const pg8::Unit& u) const { return (const char*)(ws + BG_AUG) + ((size_t)u.e * 512 + u.pm * 256) * 1280; }
    __device__ __forceinline__ const char* b_base(const pg8::Unit& u) const { return (const char*)(ws + BG_S5MB) + ((size_t)u.e * 512 + u.pn * 256) * 1280; }
    __device__ __forceinline__ unsigned a_off(const pg8::Unit&, int) const { return 0u; }
};
struct EpiS5B { const unsigned char* ws; const float* dsk; const float* gluw; const float* glub; bf16* MIX;
    __device__ __forceinline__ void operator()(const pg8::f32x4 (&acc)[2][2][4][2], const pg8::Unit& u, int wr, int wc, int fr, int fq) const {
        const int g = u.e; const bf16* AUG = (const bf16*)(ws + BG_AUG);
        const f32x4 d4 = *(const f32x4*)(dsk + g * 16 + 4 * fq), b4 = *(const f32x4*)(glub + g * 16 + 4 * fq);
#pragma unroll
        for (int ai = 0; ai < 2; ++ai)
#pragma unroll
            for (int m = 0; m < 4; ++m) { const int nidx = u.pm * 256 + ai * 128 + wr * 64 + m * 16 + fr;
#pragma unroll
                for (int bj = 0; bj < 2; ++bj)
#pragma unroll
                    for (int n = 0; n < 2; ++n) {
                        const int tau = 16 * u.pn + 8 * bj + 2 * wc + n;
                        const v2u uw = *(const v2u*)(AUG + ((size_t)g * 512 + nidx) * 640 + tau * 16 + 4 * fq);
                        const f32x4 a = acc[ai][bj][m][n];
                        float y[4] = {a.x + d4.x * bflo(uw.x), a.y + d4.y * bfhi(uw.x), a.z + d4.z * bflo(uw.y), a.w + d4.w * bfhi(uw.y)};
#pragma unroll
                        for (int k = 0; k < 4; ++k) { const float v = y[k]; y[k] = 0.5f * v * (1.0f + tanhf(0.7978845608028654f * (v + 0.044715f * v * v * v))); }
                        float z[4] = {b4.x, b4.y, b4.z, b4.w};
#pragma unroll
                        for (int x = 0; x < 4; ++x) {
                            float o[4];
#pragma unroll
                            for (int k = 0; k < 4; ++k) o[k] = (x == 0) ? y[k] : __shfl_xor(y[k], 16 * x);
                            const int hb = 4 * (fq ^ x);
#pragma unroll
                            for (int k = 0; k < 4; ++k) { const f32x4 wv = *(const f32x4*)(gluw + (g * 16 + hb + k) * 16 + 4 * fq);
                                z[0] += o[k] * wv.x; z[1] += o[k] * wv.y; z[2] += o[k] * wv.z; z[3] += o[k] * wv.w; }
                        }
                        const size_t t = (size_t)nidx * 32 + tau;
                        v2u ov; ov.x = pk2(y[0] * sigmoidf_(z[0]), y[1] * sigmoidf_(z[1])); ov.y = pk2(y[2] * sigmoidf_(z[2]), y[3] * sigmoidf_(z[3]));
                        *(v2u*)(MIX + t * D + g * 16 + 4 * fq) = ov;
                        asm volatile("" ::: "memory");
                    } }
    }
};
__device__ __forceinline__ void phase_s5carry(Frame& F) {
    const double* POW = (const double*)(F.ws + BG_POW); const float* SL = (const float*)(F.ws + BG_SL2); bf16* AUG = (bf16*)(F.ws + BG_AUG);
    const int gid = F.bid * 512 + F.tid;
    for (int i = gid; i < 4 * 32 * 64; i += F.G * 512) {
        const int p = i & 63, g = (i >> 6) & 31, b = i >> 11;
        const float ar = (float)POW[2 * ((g * 64 + p) * 33 + 32)], ai = (float)POW[2 * ((g * 64 + p) * 33 + 32) + 1];
        float sr = 0.f, si = 0.f;
#pragma unroll 8
        for (int c = 0; c < 128; ++c) {
            const size_t n = (size_t)g * 512 + b * 128 + c;
            *(unsigned*)(AUG + n * 640 + 512 + 2 * p) = pk2(sr, si);
            const float lr = SL[n * 128 + 2 * p], li = SL[n * 128 + 2 * p + 1];
            const float nr = ar * sr - ai * si + lr, ni = ar * si + ai * sr + li; sr = nr; si = ni;
        }
    }
}

__device__ __forceinline__ unsigned fkey(float f) { const unsigned u = __builtin_bit_cast(unsigned, f); return (u & 0x80000000u) ? ~u : (u | 0x80000000u); }
__device__ __forceinline__ void phase_dsa(Frame& F, ArgsP AR) {
    const bf16* Q = (const bf16*)(F.ws + BG_Q); const bf16* QI = (const bf16*)(F.ws + BG_QI); const bf16* Kb = (const bf16*)(F.ws + BG_K); const bf16* Vb = (const bf16*)(F.ws + BG_V);
    const bf16* KIb = (const bf16*)(F.ws + BG_KI); const float* WI = (const float*)(F.ws + BG_WI); bf16* MIX = (bf16*)(F.ws + BG_MIX);
    LAS unsigned char* wl = F.lds + F.wave * 19456;
    LAS float* sc = (LAS float*)wl;
    LAS float* qf = (LAS float*)(wl + 16384);
    LAS int* list = (LAS int*)(wl + 16384 + 2048);
    const int lane = F.lane;
#pragma unroll 1
    for (int it = F.bid; it < T / 8; it += F.G) {
        const int t = (T / 8 - 1 - it) * 8 + F.wave;
        const int b = t >> 12, tp = t & 4095, n = tp + 1;
        const size_t kb0 = (size_t)b * SEQ;
#pragma unroll
        for (int j = 0; j < 8; ++j) qf[j * 64 + lane] = bf2f(QI[(size_t)t * 512 + j * 64 + lane]);
        float wv[8];
#pragma unroll
        for (int h = 0; h < 8; ++h) wv[h] = WI[(size_t)t * 8 + h];
        LDS_WAIT();
#pragma unroll 1
        for (int s0 = 0; s0 < n; s0 += 64) {
            asm volatile("" ::: "memory");
            const int s = s0 + lane;
            float score = -INFINITY;
            if (s < n) {
                const v4u* kp = (const v4u*)(KIb + (kb0 + s) * 64);
                float dh[8];
#pragma unroll
                for (int h = 0; h < 8; ++h) dh[h] = 0.f;
#pragma unroll 1
                for (int half = 0; half < 2; ++half) {
                    asm volatile("" ::: "memory");
                    float kf[32];
#pragma unroll
                    for (int i = 0; i < 4; ++i) { const v4u w = kp[half * 4 + i]; kf[8 * i] = bflo(w.x); kf[8 * i + 1] = bfhi(w.x); kf[8 * i + 2] = bflo(w.y); kf[8 * i + 3] = bfhi(w.y); kf[8 * i + 4] = bflo(w.z); kf[8 * i + 5] = bfhi(w.z); kf[8 * i + 6] = bflo(w.w); kf[8 * i + 7] = bfhi(w.w); }
#pragma unroll
                    for (int h = 0; h < 8; ++h) { float d = 0.f;
#pragma unroll
                        for (int i = 0; i < 8; ++i) { const f32x4 qv = *(const LAS f32x4*)(qf + h * 64 + half * 32 + 4 * i); d += qv.x * kf[4 * i] + qv.y * kf[4 * i + 1] + qv.z * kf[4 * i + 2] + qv.w * kf[4 * i + 3]; }
                        dh[h] += d; __builtin_amdgcn_sched_barrier(0); }
                }
                float a = 0.f;
#pragma unroll
                for (int h = 0; h < 8; ++h) a += wv[h] * fmaxf(dh[h] * 0.125f, 0.f);
                score = a;
            }
            sc[s] = score;
        }
        LDS_WAIT();
        int nsel;
        if (n <= 256) { for (int i = lane; i < n; i += 64) list[i] = i; nsel = n; }
        else {
            const int nch = (n + 63) >> 6;
            unsigned thr = 0u;
#pragma unroll 1
            for (int bit = 31; bit >= 0; --bit) {
                const unsigned cand = thr | (1u << bit); int cnt = 0;
#pragma unroll 1
                for (int j = 0; j < nch; ++j) { const int s = j * 64 + lane; if (s < n) cnt += (fkey(sc[s]) >= cand) ? 1 : 0; }
                cnt = wave_sum_i(cnt);
                if (cnt >= 256) thr = cand;
            }
            int cgt = 0;
            for (int j = 0; j < nch; ++j) { const int s = j * 64 + lane; if (s < n) cgt += (fkey(sc[s]) > thr) ? 1 : 0; }
            cgt = wave_sum_i(cgt);
            const int need_eq = 256 - cgt;
            int run = 0, eqrun = 0;
            const unsigned long long lt = (lane == 0) ? 0ull : (~0ull >> (64 - lane));
            for (int j = 0; j < nch; ++j) {
                const int s = j * 64 + lane; const bool in = s < n; const unsigned k = in ? fkey(sc[s]) : 0u;
                const bool gt = in && k > thr, eq = in && k == thr;
                const unsigned long long beq = __ballot(eq);
                const int myeq = eqrun + __popcll(beq & lt);
                const bool sel = gt || (eq && myeq < need_eq);
                const unsigned long long bs = __ballot(sel);
                if (sel) list[run + __popcll(bs & lt)] = s;
                run += __popcll(bs); eqrun += __popcll(beq);
            }
            nsel = run;
        }
        LDS_WAIT();
#pragma unroll
        for (int j = 0; j < 8; ++j) qf[j * 64 + lane] = bf2f(Q[(size_t)t * 512 + j * 64 + lane]);
        LDS_WAIT();
        float mx[8];
#pragma unroll
        for (int h = 0; h < 8; ++h) mx[h] = -INFINITY;
#pragma unroll 1
        for (int i0 = 0; i0 < nsel; i0 += 64) {
            asm volatile("" ::: "memory");
            const int i = i0 + lane;
            if (i < nsel) {
                const int s = list[i];
                const v4u* kp = (const v4u*)(Kb + (kb0 + s) * 64);
                float dh[8];
#pragma unroll
                for (int h = 0; h < 8; ++h) dh[h] = 0.f;
#pragma unroll 1
                for (int half = 0; half < 2; ++half) {
                    asm volatile("" ::: "memory");
                    float kf[32];
#pragma unroll
                    for (int q = 0; q < 4; ++q) { const v4u w = kp[half * 4 + q]; kf[8 * q] = bflo(w.x); kf[8 * q + 1] = bfhi(w.x); kf[8 * q + 2] = bflo(w.y); kf[8 * q + 3] = bfhi(w.y); kf[8 * q + 4] = bflo(w.z); kf[8 * q + 5] = bfhi(w.z); kf[8 * q + 6] = bflo(w.w); kf[8 * q + 7] = bfhi(w.w); }
#pragma unroll
                    for (int h = 0; h < 8; ++h) { float d = 0.f;
#pragma unroll
                        for (int q = 0; q < 8; ++q) { const f32x4 qv = *(const LAS f32x4*)(qf + h * 64 + half * 32 + 4 * q); d += qv.x * kf[4 * q] + qv.y * kf[4 * q + 1] + qv.z * kf[4 * q + 2] + qv.w * kf[4 * q + 3]; }
                        dh[h] += d; __builtin_amdgcn_sched_barrier(0); }
                }
#pragma unroll
                for (int h = 0; h < 8; ++h) { const float d = dh[h] * 0.125f; sc[i * 8 + h] = d; mx[h] = fmaxf(mx[h], d); }
            }
        }
        float lsum[8];
#pragma unroll
        for (int h = 0; h < 8; ++h) { mx[h] = wave_max(mx[h]); lsum[h] = 0.f; }
        LDS_WAIT();
        for (int i0 = 0; i0 < nsel; i0 += 64) {
            const int i = i0 + lane;
            if (i < nsel) {
#pragma unroll
                for (int h = 0; h < 8; ++h) { const float pv = __expf(sc[i * 8 + h] - mx[h]); sc[i * 8 + h] = pv; lsum[h] += pv; }
            }
        }
#pragma unroll
        for (int h = 0; h < 8; ++h) lsum[h] = wave_sum(lsum[h]);
        LDS_WAIT();
        float o[8];
#pragma unroll
        for (int h = 0; h < 8; ++h) o[h] = 0.f;
#pragma unroll 2
        for (int i = 0; i < nsel; ++i) {
            const int s = list[i];
            const float v = bf2f(Vb[(kb0 + s) * 64 + lane]);
            const f32x4 p0 = *(const LAS f32x4*)(sc + i * 8), p1 = *(const LAS f32x4*)(sc + i * 8 + 4);
            o[0] += p0.x * v; o[1] += p0.y * v; o[2] += p0.z * v; o[3] += p0.w * v; o[4] += p1.x * v; o[5] += p1.y * v; o[6] += p1.z * v; o[7] += p1.w * v;
        }
#pragma unroll
        for (int h = 0; h < 8; ++h) MIX[(size_t)t * D + 512 + h * 64 + lane] = (bf16)f2bf(o[h] / lsum[h]);
        LDS_WAIT();
    }
}


typedef float f32x16 __attribute__((ext_vector_type(16)));
constexpr int DS_SC = 0;
constexpr int DS_BM = 131072;
constexpr int DS_WT = DS_BM + 8192;
constexpr int DS_MRG = 32768;
__device__ __forceinline__ float xor32f(float v) { return __shfl_xor(v, 32); }
__device__ __forceinline__ void phase_dsa2(Frame& F, ArgsP AR) {
    const bf16* Q = (const bf16*)(F.ws + BG_Q); const bf16* QI = (const bf16*)(F.ws + BG_QI); const bf16* Kb = (const bf16*)(F.ws + BG_K); const bf16* VT = (const bf16*)(F.ws + BG_VT);
    const bf16* KIb = (const bf16*)(F.ws + BG_KI); const float* WI = (const float*)(F.ws + BG_WI); bf16* MIX = (bf16*)(F.ws + BG_MIX);
    LAS unsigned short* SC = (LAS unsigned short*)(F.lds + DS_SC);
    LAS unsigned char* BM = F.lds + DS_BM;
    LAS float* WT = (LAS float*)(F.lds + DS_WT);
    const int lane = F.lane, w = F.wave, tid = F.tid;
    const int r32 = lane & 31, h = lane >> 5;
    const int nunits = T / 16;
#pragma unroll 1
    for (int i = 0; ; ++i) {
        int j = i * F.G + ((i & 1) ? (F.G - 1 - F.bid) : F.bid);
        if (i * F.G >= nunits) break;
        if (j >= nunits) continue;
        const int b = j & 3, qt = j >> 2;
        const int tp0 = qt * 16, t0 = b * SEQ + tp0;
        const int n_keys = tp0 + 16;
        const int nkt = (n_keys + 31) >> 5, n_comp = nkt * 32, nst = (n_keys + 63) >> 6;
        const size_t kb0 = (size_t)b * SEQ;
        if (tid < 128) WT[tid] = WI[(size_t)t0 * 8 + tid] * 0.125f;
        {
            bf16x8 af[4][4];
#pragma unroll
            for (int rb = 0; rb < 4; ++rb)
#pragma unroll
                for (int ks = 0; ks < 4; ++ks) af[rb][ks] = *(const bf16x8*)(QI + ((size_t)t0 * 8 + rb * 32 + r32) * 64 + ks * 16 + h * 8);
            __syncthreads();
#pragma unroll 1
            for (int kt = w; kt < nkt; kt += 8) {
                const bf16* kp = KIb + (kb0 + kt * 32 + r32) * 64 + h * 8;
                bf16x8 bfr[4];
#pragma unroll
                for (int ks = 0; ks < 4; ++ks) bfr[ks] = *(const bf16x8*)(kp + ks * 16);
                const int s = kt * 32 + r32;
#pragma unroll
                for (int rb = 0; rb < 4; ++rb) {
                    f32x16 acc = {0.f, 0.f, 0.f, 0.f, 0.f, 0.f, 0.f, 0.f, 0.f, 0.f, 0.f, 0.f, 0.f, 0.f, 0.f, 0.f};
#pragma unroll
                    for (int ks = 0; ks < 4; ++ks) acc = __builtin_amdgcn_mfma_f32_32x32x16_bf16(af[rb][ks], bfr[ks], acc, 0, 0, 0);
#pragma unroll
                    for (int tl = 0; tl < 4; ++tl) {
                        const f32x4 wv = *(const LAS f32x4*)(WT + (4 * rb + tl) * 8 + 4 * h);
                        float part = wv.x * fmaxf(acc[4 * tl], 0.f) + wv.y * fmaxf(acc[4 * tl + 1], 0.f) + wv.z * fmaxf(acc[4 * tl + 2], 0.f) + wv.w * fmaxf(acc[4 * tl + 3], 0.f);
                        part += xor32f(part);
                        const int tk = 4 * rb + tl;
                        const _Float16 hf = (_Float16)part; const unsigned hb = (unsigned)__builtin_bit_cast(unsigned short, hf);
                        const unsigned key = (hb & 0x8000u) ? (~hb & 0xffffu) : (hb | 0x8000u);
                        if ((tl & 1) == h) SC[tk * 4096 + s] = (unsigned short)((s <= tp0 + tk) ? key : 0u);
                    }
                }
            }
        }
        __syncthreads();
        {
            const int nch = (n_comp + 511) >> 9;
#pragma unroll 1
            for (int q = 0; q < 2; ++q) {
                const int tk = 2 * w + q; const int n = tp0 + tk + 1;
                const LAS v4u* row = (const LAS v4u*)(SC + tk * 4096);
                unsigned thr = 0u; int cut = -1;
                if (n > 256) {
#pragma unroll 1
                    for (int bit = 15; bit >= 0; --bit) {
                        const unsigned cand = thr | (1u << bit); int cnt = 0;
#pragma unroll 1
                        for (int ch = 0; ch < nch; ++ch) {
                            v4u x = (v4u){0u, 0u, 0u, 0u}; if (ch * 512 + lane * 8 < n_comp) x = row[ch * 64 + lane];
                            cnt += __popcll(__ballot((x.x & 0xffffu) >= cand)) + __popcll(__ballot((x.x >> 16) >= cand)) + __popcll(__ballot((x.y & 0xffffu) >= cand)) + __popcll(__ballot((x.y >> 16) >= cand))
                                 + __popcll(__ballot((x.z & 0xffffu) >= cand)) + __popcll(__ballot((x.z >> 16) >= cand)) + __popcll(__ballot((x.w & 0xffffu) >= cand)) + __popcll(__ballot((x.w >> 16) >= cand));
                        }
                        if (cnt >= 256) thr = cand;
                    }
                    int cgt = 0, ceq = 0;
#pragma unroll 1
                    for (int ch = 0; ch < nch; ++ch) {
                        v4u x = (v4u){0u, 0u, 0u, 0u}; if (ch * 512 + lane * 8 < n_comp) x = row[ch * 64 + lane];
                        const unsigned e[8] = {x.x & 0xffffu, x.x >> 16, x.y & 0xffffu, x.y >> 16, x.z & 0xffffu, x.z >> 16, x.w & 0xffffu, x.w >> 16};
#pragma unroll
                        for (int k = 0; k < 8; ++k) { cgt += __popcll(__ballot(e[k] > thr)); ceq += __popcll(__ballot(e[k] == thr)); }
                    }
                    const int need = 256 - cgt;
                    if (ceq == need) cut = 4096;
                    else {
                        int lo_ = 0, hi_ = 4095;
#pragma unroll 1
                        while (lo_ < hi_) {
                            const int mid = (lo_ + hi_) >> 1; int c = 0;
#pragma unroll 1
                            for (int ch = 0; ch < nch; ++ch) {
                                v4u x = (v4u){0u, 0u, 0u, 0u}; const int i0 = ch * 512 + lane * 8; if (i0 < n_comp) x = row[ch * 64 + lane];
                                const unsigned e[8] = {x.x & 0xffffu, x.x >> 16, x.y & 0xffffu, x.y >> 16, x.z & 0xffffu, x.z >> 16, x.w & 0xffffu, x.w >> 16};
#pragma unroll
                                for (int k = 0; k < 8; ++k) c += __popcll(__ballot(e[k] == thr && (i0 + k) <= mid));
                            }
                            if (c >= need) hi_ = mid; else lo_ = mid + 1;
                        }
                        cut = lo_;
                    }
                }
#pragma unroll 1
                for (int ch = 0; ch < nch; ++ch) {
                    v4u x = (v4u){0u, 0u, 0u, 0u}; const int i0 = ch * 512 + lane * 8; if (i0 < n_comp) x = row[ch * 64 + lane];
                    const unsigned e[8] = {x.x & 0xffffu, x.x >> 16, x.y & 0xffffu, x.y >> 16, x.z & 0xffffu, x.z >> 16, x.w & 0xffffu, x.w >> 16};
                    unsigned byte = 0u;
#pragma unroll
                    for (int k = 0; k < 8; ++k) byte |= ((e[k] > thr) || (e[k] == thr && (i0 + k) <= cut)) ? (1u << k) : 0u;
                    BM[tk * 512 + ch * 64 + lane] = (unsigned char)byte;
                }
            }
        }
        __syncthreads();
        {
            const int rb = w & 3, kh = w >> 2;
            const int tk = 4 * rb + (r32 >> 3);
            bf16x8 qf[4];
#pragma unroll
            for (int ks = 0; ks < 4; ++ks) qf[ks] = *(const bf16x8*)(Q + ((size_t)t0 * 8 + rb * 32 + r32) * 64 + ks * 16 + h * 8);
            f32x16 O0 = {0.f, 0.f, 0.f, 0.f, 0.f, 0.f, 0.f, 0.f, 0.f, 0.f, 0.f, 0.f, 0.f, 0.f, 0.f, 0.f}, O1 = O0;
            float m = -1e30f, l = 0.f;
            const int skey = tid >> 3, sch = tid & 7;
            const bf16* ksrc = Kb + (kb0 + skey) * 64 + sch * 8;
            const bf16* vsrc = VT + ((size_t)b * 64 + skey) * 4096 + sch * 8;
            const int kdst = skey * 128 + ((sch ^ ((skey >> 1) & 7)) << 4);
            const int vf = (skey >> 1) & 15;
            const int vdst0 = skey * 128 + (((2 * sch) ^ vf) << 3), vdst1 = skey * 128 + (((2 * sch + 1) ^ vf) << 3);
            v4u kreg = *(const v4u*)(ksrc), vreg = *(const v4u*)(vsrc);
            { LAS unsigned char* kb_ = F.lds; LAS unsigned char* vb_ = F.lds + 8192;
              *(LAS v4u*)(kb_ + kdst) = kreg; *(LAS v2u*)(vb_ + vdst0) = (v2u){vreg.x, vreg.y}; *(LAS v2u*)(vb_ + vdst1) = (v2u){vreg.z, vreg.w}; }
            __syncthreads();
            const int krow = kh * 32 + r32;
            const int kswz = (krow >> 1) & 7;
            const int vfl0 = ((r32) >> 1) & 15, vfl1 = ((32 + r32) >> 1) & 15;
            constexpr float C2 = 0.125f * 1.4426950408889634f;
#pragma unroll 1
            for (int st = 0; st < nst; ++st) {
                const int cur = (st & 1) * 16384;
                if (st + 1 < nst) { kreg = *(const v4u*)(ksrc + (size_t)(st + 1) * 64 * 64); vreg = *(const v4u*)(vsrc + (st + 1) * 64); }
                const LAS unsigned char* kt_ = F.lds + cur; const LAS unsigned char* vt_ = F.lds + cur + 8192;
                f32x16 sv = {0.f, 0.f, 0.f, 0.f, 0.f, 0.f, 0.f, 0.f, 0.f, 0.f, 0.f, 0.f, 0.f, 0.f, 0.f, 0.f};
#pragma unroll
                for (int ks = 0; ks < 4; ++ks) { const bf16x8 ka = *(const LAS bf16x8*)(kt_ + krow * 128 + (((2 * ks + h) ^ kswz) << 4)); sv = __builtin_amdgcn_mfma_f32_32x32x16_bf16(ka, qf[ks], sv, 0, 0, 0); }
                const unsigned mw = *(const LAS unsigned*)(BM + tk * 512 + (2 * st + kh) * 4) >> (4 * h);
                float mt = -INFINITY;
#pragma unroll
                for (int r = 0; r < 16; ++r) { const int kl = (r & 3) + 8 * (r >> 2); sv[r] = ((mw >> kl) & 1u) ? sv[r] * C2 : -INFINITY; mt = fmaxf(mt, sv[r]); }
                mt = fmaxf(mt, xor32f(mt));
                const float mn = fmaxf(m, mt); const float alpha = __builtin_amdgcn_exp2f(m - mn); m = mn;
                float ls = 0.f;
#pragma unroll
                for (int r = 0; r < 16; ++r) { sv[r] = __builtin_amdgcn_exp2f(sv[r] - mn); ls += sv[r]; }
                l = l * alpha + ls;
#pragma unroll
                for (int r = 0; r < 16; ++r) { O0[r] *= alpha; O1[r] *= alpha; }
                bf16x8 pb[2];
#pragma unroll
                for (int s2 = 0; s2 < 2; ++s2) { v4u pk; pk.x = pk2(sv[8 * s2], sv[8 * s2 + 1]); pk.y = pk2(sv[8 * s2 + 2], sv[8 * s2 + 3]); pk.z = pk2(sv[8 * s2 + 4], sv[8 * s2 + 5]); pk.w = pk2(sv[8 * s2 + 6], sv[8 * s2 + 7]); pb[s2] = __builtin_bit_cast(bf16x8, pk); }
#pragma unroll
                for (int s2 = 0; s2 < 2; ++s2) {
                    const int c8 = 8 * kh + 4 * s2 + h;
                    { const v2u a0 = *(const LAS v2u*)(vt_ + r32 * 128 + ((c8 ^ vfl0) << 3)), a1 = *(const LAS v2u*)(vt_ + r32 * 128 + (((c8 + 2) ^ vfl0) << 3));
                      const v4u av = (v4u){a0.x, a0.y, a1.x, a1.y}; O0 = __builtin_amdgcn_mfma_f32_32x32x16_bf16(__builtin_bit_cast(bf16x8, av), pb[s2], O0, 0, 0, 0); }
                    { const v2u a0 = *(const LAS v2u*)(vt_ + (32 + r32) * 128 + ((c8 ^ vfl1) << 3)), a1 = *(const LAS v2u*)(vt_ + (32 + r32) * 128 + (((c8 + 2) ^ vfl1) << 3));
                      const v4u av = (v4u){a0.x, a0.y, a1.x, a1.y}; O1 = __builtin_amdgcn_mfma_f32_32x32x16_bf16(__builtin_bit_cast(bf16x8, av), pb[s2], O1, 0, 0, 0); }
                }
                if (st + 1 < nst) { LAS unsigned char* kb_ = F.lds + (cur ^ 16384); LAS unsigned char* vb_ = kb_ + 8192;
                    *(LAS v4u*)(kb_ + kdst) = kreg; *(LAS v2u*)(vb_ + vdst0) = (v2u){vreg.x, vreg.y}; *(LAS v2u*)(vb_ + vdst1) = (v2u){vreg.z, vreg.w}; }
                __syncthreads();
            }
            l += xor32f(l);
            LAS float* mg = (LAS float*)(F.lds + DS_MRG + rb * 8704);
            if (kh == 1) {
#pragma unroll
                for (int r = 0; r < 16; ++r) { mg[r * 64 + lane] = O0[r]; mg[(16 + r) * 64 + lane] = O1[r]; }
                if (h == 0) { mg[2048 + r32] = m; mg[2048 + 32 + r32] = l; }
            }
            __syncthreads();
            if (kh == 0) {
                const float m1 = mg[2048 + r32], l1 = mg[2048 + 32 + r32];
                const float mf = fmaxf(m, m1); const float a0 = __builtin_amdgcn_exp2f(m - mf), a1 = __builtin_amdgcn_exp2f(m1 - mf);
                const float inv = 1.0f / (l * a0 + l1 * a1);
                bf16* orow = MIX + (size_t)(t0 + tk) * D + 512 + (r32 & 7) * 64;
#pragma unroll
                for (int g4 = 0; g4 < 4; ++g4) {
                    float o0[4], o1[4];
#pragma unroll
                    for (int k = 0; k < 4; ++k) { const int r = 4 * g4 + k; o0[k] = (O0[r] * a0 + mg[r * 64 + lane] * a1) * inv; o1[k] = (O1[r] * a0 + mg[(16 + r) * 64 + lane] * a1) * inv; }
                    v2u s0; s0.x = pk2(o0[0], o0[1]); s0.y = pk2(o0[2], o0[3]); *(v2u*)(orow + 8 * g4 + 4 * h) = s0;
                    v2u s1; s1.x = pk2(o1[0], o1[1]); s1.y = pk2(o1[2], o1[3]); *(v2u*)(orow + 32 + 8 * g4 + 4 * h) = s1;
                }
            }
            __syncthreads();
        }
    }
}

constexpr int LDS_RT = 131072;
__device__ __forceinline__ void phase_router(Frame& F, ArgsP AR, int l) {
    const float* X = F.out; const float* gamma = FIN(6) + (size_t)l * D; const int m = 2 * l + 1;
    const float* MOD = (const float*)(F.ws + WS_MOD); const float* RW = FIN(25) + (size_t)l * D * 64; const float* RB = FIN(26) + (size_t)l * 64;
    bf16* Hout = (bf16*)(F.ws + WS_H); unsigned* ctl = (unsigned*)(F.ws + WS_CTL);
    int* EIDX = (int*)(F.ws + WS_EIDX); int* SLOT = (int*)(F.ws + WS_SLOT); int* ELT = (int*)(F.ws + WS_ELT); float* ELW = (float*)(F.ws + WS_ELW);
    LAS float* hrow = (LAS float*)(F.lds + F.wave * 16384);
    LAS int* lcnt = (LAS int*)(F.lds + LDS_RT); LAS int* lbase = lcnt + 64;
    const int lane = F.lane;
    const float rb = RB[lane];
    if (F.tid < 64) lcnt[F.tid] = 0;
    __syncthreads();
    const int nround = (T + F.NGW * 4 - 1) / (F.NGW * 4);
#pragma unroll 1
    for (int rd = 0; rd < nround; ++rd) {
        const int base = rd * F.NGW * 4 + F.gw * 4;
        const bool live = base < T;
        float gwt[4]; int rk[4], lp[4];
        if (live) {
            const int b = base >> 12;
            const float* shift = MOD + (size_t)(m * 4 + b) * 3072; const float* scale = shift + 1024;
#pragma unroll
            for (int q = 0; q < 4; ++q) {
                const int row = base + q;
                const f32x4* xr = (const f32x4*)(X + (size_t)row * D) + lane;
                f32x4 v[4]; float ss = 0.f;
#pragma unroll
                for (int j = 0; j < 4; ++j) { v[j] = xr[64 * j]; ss += v[j].x * v[j].x + v[j].y * v[j].y + v[j].z * v[j].z + v[j].w * v[j].w; }
                const float rstd = rsqrtf(wave_sum(ss) * (1.0f / D) + 1e-6f);
#pragma unroll
                for (int j = 0; j < 4; ++j) {
                    const int c0 = 4 * lane + 256 * j;
                    const f32x4 gg = *(const f32x4*)(gamma + c0), sc = *(const f32x4*)(scale + c0), sh = *(const f32x4*)(shift + c0);
                    f32x4 h; h.x = v[j].x * rstd * gg.x * (1.f + sc.x) + sh.x; h.y = v[j].y * rstd * gg.y * (1.f + sc.y) + sh.y;
                    h.z = v[j].z * rstd * gg.z * (1.f + sc.z) + sh.z; h.w = v[j].w * rstd * gg.w * (1.f + sc.w) + sh.w;
                    v2u o; o.x = pk2(h.x, h.y); o.y = pk2(h.z, h.w); *(v2u*)(Hout + (size_t)row * D + c0) = o;
                    *(LAS f32x4*)(hrow + q * 1024 + c0) = h;
                }
            }
            LDS_WAIT();
            float acc[4] = {0.f, 0.f, 0.f, 0.f};
#pragma unroll 4
            for (int k = 0; k < 1024; k += 4) {
                const float w0 = RW[(size_t)k * 64 + lane], w1 = RW[(size_t)(k + 1) * 64 + lane], w2 = RW[(size_t)(k + 2) * 64 + lane], w3 = RW[(size_t)(k + 3) * 64 + lane];
#pragma unroll
                for (int q = 0; q < 4; ++q) { const f32x4 hv = *(const LAS f32x4*)(hrow + q * 1024 + k); acc[q] += (hv.x * w0 + hv.y * w1) + (hv.z * w2 + hv.w * w3); }
            }
#pragma unroll
            for (int q = 0; q < 4; ++q) {
                const float score = sigmoidf_(acc[q]);
                const float sel = score + rb;
                float m1 = sel; m1 = fmaxf(m1, __shfl_xor(m1, 1)); m1 = fmaxf(m1, __shfl_xor(m1, 2)); m1 = fmaxf(m1, __shfl_xor(m1, 4));
                const unsigned long long bm = __ballot(sel == m1);
                const int g = lane >> 3; const unsigned gm = (unsigned)((bm >> (8 * g)) & 0xffull); const int first = 8 * g + __builtin_ctz(gm);
                float m2 = (lane == first) ? -INFINITY : sel; m2 = fmaxf(m2, __shfl_xor(m2, 1)); m2 = fmaxf(m2, __shfl_xor(m2, 2)); m2 = fmaxf(m2, __shfl_xor(m2, 4));
                const float gs = m1 + m2;
                int grank = 0;
#pragma unroll
                for (int gg = 0; gg < 8; ++gg) { const float o = __shfl(gs, gg * 8); grank += (o > gs || (o == gs && gg < g)) ? 1 : 0; }
                const float masked = (grank < 4) ? sel : -INFINITY;
                int rank = 0;
#pragma unroll 8
                for (int e = 0; e < 64; ++e) { const float o = __shfl(masked, e); rank += (o > masked || (o == masked && e < lane)) ? 1 : 0; }
                const bool chosen = rank < 8;
                const float wsum = wave_sum(chosen ? score : 0.f);
                gwt[q] = score / wsum * 2.5f; rk[q] = chosen ? rank : -1; lp[q] = 0;
                if (chosen) lp[q] = __hip_atomic_fetch_add(&lcnt[lane], 1, __ATOMIC_RELAXED, __HIP_MEMORY_SCOPE_WORKGROUP);
            }
        } else {
#pragma unroll
            for (int q = 0; q < 4; ++q) { gwt[q] = 0.f; rk[q] = -1; lp[q] = 0; }
        }
        __syncthreads();
        if (F.tid < 64) { const int c = lcnt[F.tid]; int gb = 0; if (c > 0) gb = (int)atomicAdd(&ctl[CW_CNT + (l * 64 + F.tid) * 64], (unsigned)c); lbase[F.tid] = gb; lcnt[F.tid] = 0; }
        __syncthreads();
        if (live) {
            const int gb = lbase[lane];
#pragma unroll
            for (int q = 0; q < 4; ++q) if (rk[q] >= 0) {
                const int row = base + q, pos = gb + lp[q];
                ELT[(size_t)lane * ECAP + pos] = row; ELW[(size_t)lane * ECAP + pos] = gwt[q];
                EIDX[(size_t)row * 8 + rk[q]] = lane; SLOT[(size_t)row * 8 + rk[q]] = pos;
            }
        }
        __syncthreads();
    }
}
__device__ __forceinline__ void phase_pool(Frame& F) {
    const float* Hf = (const float*)(F.ws + BG_H2F); bf16* P = (bf16*)(F.ws + WS_H);
    for (int row = F.gw; row < T; row += F.NGW) {
        const int tp = row & 4095;
#pragma unroll
        for (int j = 0; j < 4; ++j) {
            const int win = 2 << j, c0 = 4 * F.lane + 256 * j;
            const int lo = (tp - win + 1) > 0 ? (tp - win + 1) : 0; const int cnt = tp - lo + 1;
            f32x4 s = (f32x4){0.f, 0.f, 0.f, 0.f};
            for (int q = 0; q < cnt; ++q) s = s + *(const f32x4*)(Hf + (size_t)(row - q) * D + c0);
            const f32x4 h = *(const f32x4*)(Hf + (size_t)row * D + c0);
            const float inv = 1.0f / (float)cnt;
            v2u o; o.x = pk2(s.x * inv - h.x, s.y * inv - h.y); o.y = pk2(s.z * inv - h.z, s.w * inv - h.w);
            *(v2u*)(P + (size_t)row * D + c0) = o;
        }
    }
}

constexpr int NPHASE = 29;
__global__ void __launch_bounds__(512, 2) mega(Args args_formal) {
    ArgsP const ap0 = (ArgsP)__builtin_amdgcn_kernarg_segment_ptr();
    extern __shared__ __attribute__((aligned(16))) unsigned char lds_raw[];
    Frame F;
    F.lds = (LAS unsigned char*)lds_raw;
    F.tid = threadIdx.x; F.lane = F.tid & 63; F.wave = __builtin_amdgcn_readfirstlane(F.tid >> 6);
    F.bid = blockIdx.x; F.G = gridDim.x; F.gw = F.bid * 8 + F.wave; F.NGW = F.G * 8;
    F.out = ap0->out; F.ws = ap0->ws;
    unsigned* ctl = (unsigned*)(F.ws + WS_CTL);
    const int lo = ap0->ph_lo, hi = ap0->ph_hi;
    volatile LAS unsigned* bst = (volatile LAS unsigned*)(F.lds + LDS_BYTES - 16);
    XcdBarrier bar; bar.bar = ctl + CW_BAR; bar.x = 0; bar.st = bst;
    const bool multi = (hi - lo) > 1;
    if (multi) { if (F.tid == 0) { bst[0] = 0u; bst[1] = 0u; } __syncthreads(); bar = xcd_barrier_post(ctl + CW_BAR, bst); }
#ifndef PROBE_PHASE
#define PROBE_PHASE -1
#endif
#ifndef PROBE_AMP
#define PROBE_AMP 8
#endif
    unsigned long long probe_t0 = 0ull, probe_dt = 0ull;
#ifndef PROBE_EXTRA_BAR
#define PROBE_EXTRA_BAR 0
#endif
#ifndef PROBE_DUP
#define PROBE_DUP 0ull
#endif
#ifndef PHMASK
#define PHMASK 0xFFFFFFFFull
#endif
#define IN(k) ((((PHMASK) >> ((k) >= 20 ? (k) - 10 : (k))) & 1ull) && lo <= (k) && (k) < hi)
#define SEAM(k) do { if ((k) + 1 < hi) xcd_barrier(bar); } while (0)
#define PH_BEGIN(k) if ((k) == PROBE_PHASE) probe_t0 = __builtin_amdgcn_s_memrealtime(); if (IN(k)) { { int t_ = threadIdx.x; asm volatile("" : "+v"(t_)); F.tid = t_; F.lane = t_ & 63; F.wave = __builtin_amdgcn_readfirstlane(t_ >> 6); F.gw = F.bid * 8 + F.wave; } ArgsP args = launder_args(ap0); ArgsP AR = args; (void)AR; F.out = args->out; F.ws = args->ws; ctl = (unsigned*)(F.ws + WS_CTL); const float* MOD = (const float*)(F.ws + WS_MOD); (void)MOD; _Pragma("unroll 1") for (int rep_ = 0; rep_ < ((((PROBE_DUP) >> ((k) >= 20 ? (k) - 10 : (k))) & 1ull) ? 2 : 1); ++rep_) { if (rep_) __syncthreads();
#define PH_END(k) } } if (multi && lo <= (k) && (k) < hi && (k) + 1 < hi) { xcd_barrier(bar); if ((k) == 0) { for (int xb_ = 0; xb_ < PROBE_EXTRA_BAR; ++xb_) xcd_barrier(bar); } } if ((k) == PROBE_PHASE) probe_dt = __builtin_amdgcn_s_memrealtime() - probe_t0;
    PH_BEGIN(0) phase_mod(F, args); __syncthreads(); phase_convert_static(F, args); phase_tables(F, args); phase_convert_experts(F, args, 0); PH_END(0)
    PH_BEGIN(1) phase_norm_mod(F, FIN(0), FIN(3), 0, (bf16*)(F.ws + WS_H), nullptr); phase_s5mats(F, args); PH_END(1)
    PH_BEGIN(3) DenseOrder S; S.init(F.ws + WS_H, F.ws + WS_WIN, 2048u, 2048u, T, INP, F.G, F.bid); EpiF32Store E{(float*)(F.ws + BG_PROJ), INP};
        pg8::gemm_phase<EpiF32Store, DenseOrder, false>(F.lds, F.tid, 1024, 2048u, 2048u, S, E); PH_END(3)
    PH_BEGIN(4) phase_postproj(F, args); PH_END(4)
    PH_BEGIN(5) S5AOrder S{F.ws, F.bid, F.G}; EpiS5A E{(float*)(F.ws + BG_SL2)}; pg8::gemm_phase<EpiS5A, S5AOrder, false>(F.lds, F.tid, 512, 1280u, 1024u, S, E); PH_END(5)
    PH_BEGIN(6) phase_s5carry(F); phase_dsa2(F, args); PH_END(6)
    PH_BEGIN(7) S5BOrder S{F.ws, F.bid, F.G}; EpiS5B E{F.ws, FIN(18), FIN(19), FIN(20), (bf16*)(F.ws + BG_MIX)}; pg8::gemm_phase<EpiS5B, S5BOrder, false>(F.lds, F.tid, 640, 1280u, 1280u, S, E); PH_END(7)
    PH_BEGIN(9) DenseOrder S; S.init(F.ws + BG_MIX, F.ws + WS_WOUT, 2048u, 2048u, T, D, F.G, F.bid); EpiResidual E{FIN(0), F.out, MOD + 2048, nullptr, 0};
        pg8::gemm_phase<EpiResidual, DenseOrder, false>(F.lds, F.tid, 1024, 2048u, 2048u, S, E); PH_END(9)
#define MOE_PHASES(pb, l) \
    PH_BEGIN(pb) phase_router(F, args, l); PH_END(pb) \
    PH_BEGIN(pb + 1) moe_tables(F, l); typedef MoeOrder<2, true> O; O S; S.init(F.lds, F.ws, false, true, F.G, F.bid); EpiGateUp<O> E{&S, F.ws}; \
        pg8::gemm_phase<EpiGateUp<O>, O, true>(F.lds, F.tid, 1024, 2048u, 2048u, S, E); PH_END(pb + 1) \
    PH_BEGIN(pb + 2) moe_tables(F, l); typedef MoeOrder<4, false> O; O S; S.init(F.lds, F.ws, false, false, F.G, F.bid); EpiDown<O, false> E{&S, F.ws, F.out, MOD + (size_t)((2 * l + 1) * 4) * 3072 + 2048}; \
        pg8::gemm_phase<EpiDown<O, false>, O, false>(F.lds, F.tid, 256, 512u, 512u, S, E); PH_END(pb + 2) \
    PH_BEGIN(pb + 3) moe_tables(F, l); typedef MoeOrder<4, false> O; O S; S.init(F.lds, F.ws, true, true, F.G, F.bid); EpiDown<O, true> E{&S, F.ws, F.out, MOD + (size_t)((2 * l + 1) * 4) * 3072 + 2048}; \
        pg8::gemm_phase<EpiDown<O, true>, O, false>(F.lds, F.tid, 256, 512u, 512u, S, E); PH_END(pb + 3)
    MOE_PHASES(10, 0)
    PH_BEGIN(17) phase_norm_mod(F, F.out, FIN(3) + D, 2, nullptr, (float*)(F.ws + BG_H2F)); phase_convert_experts(F, args, 1); PH_END(17)
    PH_BEGIN(18) phase_pool(F); PH_END(18)
    PH_BEGIN(19) PoolOrder S; S.init(F.ws + WS_H, F.ws + WS_WPOOL, F.G, F.bid); EpiResidual E{F.out, F.out, MOD + (size_t)(2 * 4) * 3072 + 2048, FIN(24), 1};
        pg8::gemm_phase<EpiResidual, PoolOrder, false>(F.lds, F.tid, 256, 2048u, 512u, S, E); PH_END(19)
    MOE_PHASES(20, 1)
    if (PROBE_PHASE >= 0 && F.bid == 0 && F.wave == 0) { const unsigned long long te = __builtin_amdgcn_s_memrealtime() + (unsigned long long)PROBE_AMP * probe_dt; while (__builtin_amdgcn_s_memrealtime() < te) __builtin_amdgcn_s_sleep(16); }
}

extern "C" void kernel_launch(void* const* d_in, const int* in_sizes, int n_in, void* d_out, int out_size, void* d_ws, size_t ws_size, hipStream_t stream) {
    static int grid = 0;
    if (grid == 0) {
        int dev = 0, cus = 0;
        if (n_in != 33 || ws_size < WS_END) { fprintf(stderr, "kernel_launch: unexpected n_in %d or ws_size %zu (need %zu)\n", n_in, ws_size, (size_t)WS_END); grid = -1; return; }
        if (hipGetDevice(&dev) != hipSuccess || hipDeviceGetAttribute(&cus, hipDeviceAttributeMultiprocessorCount, dev) != hipSuccess) { grid = -1; return; }
        if (hipFuncSetAttribute((const void*)mega, hipFuncAttributeMaxDynamicSharedMemorySize, LDS_BYTES) != hipSuccess) { fprintf(stderr, "kernel_launch: hipFuncSetAttribute failed\n"); grid = -1; return; }
        (void)hipGetLastError();
        grid = cus - (cus % 8); if (grid <= 0) grid = cus;
    }
    if (grid < 0) return;
    (void)hipMemsetAsync((char*)d_ws + WS_CTL, 0, CTL_ZERO_BYTES, stream);
    Args a{};
    for (int i = 0; i < 33; ++i) a.in[i] = (const float*)d_in[i];
    a.out = (float*)d_out; a.ws = (unsigned char*)d_ws;
    const int last = 24;
#if MK_LAUNCH_PER_PHASE
    for (int p = 0; p < last; ++p) { a.ph_lo = p; a.ph_hi = p + 1; hipLaunchKernelGGL(mega, dim3(grid), dim3(512), LDS_BYTES, stream, a); }
#else
    a.ph_lo = 0; a.ph_hi = last; hipLaunchKernelGGL(mega, dim3(grid), dim3(512), LDS_BYTES, stream, a);
#endif
}
```

```cpp
#include <hip/hip_runtime.h>
#include <cstdio>
#include <cstdint>

#ifndef PROBE_PHASE
#define PROBE_PHASE -1
#endif
#ifndef PROBE_AMP
#define PROBE_AMP 8
#endif
#ifndef MK_LAUNCH_PER_PHASE
#define MK_LAUNCH_PER_PHASE 0
#endif

#define GAS __attribute__((address_space(1)))
#define LAS __attribute__((address_space(3)))
typedef unsigned short bf16;
typedef unsigned v4u __attribute__((ext_vector_type(4)));
typedef unsigned v2u __attribute__((ext_vector_type(2)));
typedef float f32x4 __attribute__((ext_vector_type(4)));
typedef short bf16x8 __attribute__((ext_vector_type(8)));
#define LDS_WAIT() asm volatile("s_waitcnt lgkmcnt(0)" ::: "memory")
#define VM_WAIT() asm volatile("s_waitcnt vmcnt(0)" ::: "memory")

constexpr int NB = 4, SEQ = 4096, T = NB * SEQ, D = 1024;
constexpr int INW = 1736, INP = 1792;
constexpr int NEXP = 64, EDIM = 256;
constexpr int NASSIGN = T * 8;
constexpr int ECAP = T;

constexpr size_t MiB = 1u << 20;
constexpr size_t WS_CTL = 0;
constexpr size_t CTL_ZERO_BYTES = 1 * MiB;
constexpr size_t WS_MOD = 1 * MiB;
constexpr size_t WS_ROPE = WS_MOD + 256 * 1024;
constexpr size_t WS_S5T = WS_ROPE + 1 * MiB;
constexpr size_t WS_WIN = 4 * MiB;
constexpr size_t WS_WOUT = WS_WIN + (size_t)INP * D * 2;
constexpr size_t WS_WPOOL = WS_WOUT + (size_t)D * D * 2;
constexpr size_t WS_WGU = 10 * MiB;
constexpr size_t WS_WD = WS_WGU + (size_t)65 * 512 * 1024 * 2;
constexpr size_t WS_H = WS_WD + (size_t)65 * 1024 * 256 * 2;
constexpr size_t WS_EIDX = WS_H + (size_t)T * D * 2;
constexpr size_t WS_SLOT = WS_EIDX + (size_t)T * 8 * 4;
constexpr size_t WS_ELT = WS_SLOT + (size_t)T * 8 * 4;
constexpr size_t WS_ELW = WS_ELT + (size_t)NEXP * ECAP * 4;
constexpr size_t WS_BIG = WS_ELW + (size_t)NEXP * ECAP * 4;
constexpr size_t BG_PROJ = WS_BIG;
constexpr size_t BG_U = BG_PROJ + (size_t)T * INP * 4;
constexpr size_t BG_Q = BG_U + (size_t)T * 512 * 4;
constexpr size_t BG_QI = BG_Q + (size_t)T * 512 * 2;
constexpr size_t BG_K = BG_QI + (size_t)T * 512 * 2;
constexpr size_t BG_V = BG_K + (size_t)T * 64 * 2;
constexpr size_t BG_KI = BG_V + (size_t)T * 64 * 2;
constexpr size_t BG_WI = BG_KI + (size_t)T * 64 * 2;
constexpr size_t BG_SLOC = BG_WI + (size_t)T * 8 * 4;
constexpr size_t BG_SIN = BG_SLOC + (size_t)4 * 32 * 64 * 64 * 2 * 4;
constexpr size_t BG_MIX = BG_SIN + (size_t)4 * 32 * 64 * 64 * 2 * 4;
constexpr size_t BG_VT = BG_MIX + (size_t)T * D * 2;
constexpr size_t BG_POW = BG_VT + (size_t)T * 64 * 2;
constexpr size_t BG_S5MB = BG_POW + (size_t)32 * 64 * 33 * 16;
constexpr size_t BG_S5WE = BG_S5MB + (size_t)32 * 512 * 640 * 2;
constexpr size_t BG_AUG = BG_S5WE + (size_t)32 * 256 * 512 * 2;
constexpr size_t BG_SL2 = BG_AUG + (size_t)32 * 512 * 640 * 2;
constexpr size_t BG_MIXER_END = BG_SL2 + (size_t)32 * 512 * 128 * 4;
constexpr size_t BG_HB = WS_BIG;
constexpr size_t BG_HBSH = BG_HB + (size_t)(NASSIGN + 256) * 256 * 2;
constexpr size_t BG_Y = BG_HBSH + (size_t)T * 256 * 2;
constexpr size_t BG_MOE_END = BG_Y + (size_t)NASSIGN * D * 2;
constexpr size_t BG_H2F = WS_BIG;
constexpr size_t WS_END = (BG_MOE_END > BG_MIXER_END ? BG_MOE_END : BG_MIXER_END);
static_assert(WS_END <= 539993216ull, "workspace map exceeds the guaranteed d_ws size");

constexpr int S5_ABAR = 0;
constexpr int S5_A64 = S5_ABAR + 32 * 64 * 2;
constexpr int S5_BBR = S5_A64 + 32 * 64 * 2;
constexpr int S5_BBI = S5_BBR + 32 * 64 * 16;

constexpr int CW_BAR = 4096;
constexpr int CW_CNT = 16384;
constexpr int CW_EST = 16384 + 256;
constexpr int CW_NT = 16384 + 512;
constexpr int CW_TE = 16384 + 1024;
constexpr int CW_TJ = 16384 + 4096;
constexpr int LDS_BYTES = 163840;

__device__ __forceinline__ unsigned f2bf(float f) { unsigned u = __builtin_bit_cast(unsigned, f); return (u + 0x7fffu + ((u >> 16) & 1u)) >> 16; }
typedef float f32x2_t __attribute__((ext_vector_type(2))); typedef __bf16 bf16x2_t __attribute__((ext_vector_type(2)));
__device__ __forceinline__ unsigned pk2(float lo, float hi) { const f32x2_t v = {lo, hi}; const bf16x2_t b = __builtin_convertvector(v, bf16x2_t); return __builtin_bit_cast(unsigned, b); }
__device__ __forceinline__ float bf2f(unsigned b) { return __builtin_bit_cast(float, b << 16); }
__device__ __forceinline__ float bflo(unsigned w) { return __builtin_bit_cast(float, w << 16); }
__device__ __forceinline__ float bfhi(unsigned w) { return __builtin_bit_cast(float, w & 0xffff0000u); }
__device__ __forceinline__ float wave_sum(float v) {
#pragma unroll
    for (int o = 1; o < 64; o <<= 1) v += __shfl_xor(v, o);
    return v;
}
__device__ __forceinline__ float wave_max(float v) {
#pragma unroll
    for (int o = 1; o < 64; o <<= 1) v = fmaxf(v, __shfl_xor(v, o));
    return v;
}
__device__ __forceinline__ int wave_sum_i(int v) {
#pragma unroll
    for (int o = 1; o < 64; o <<= 1) v += __shfl_xor(v, o);
    return v;
}
__device__ __forceinline__ float sigmoidf_(float x) { return 1.0f / (1.0f + __expf(-x)); }

namespace pg8 {
typedef float f32x4 __attribute__((ext_vector_type(4)));
constexpr int BM = 256, BK = 64, HALF = 128, HTB = HALF * BK * 2, STAGE_BYTES = 8 * HTB;
__host__ __device__ __forceinline__ int lds_byte(int r, int c) { const int st = (r >> 4) * 2 + (c >> 5), rr = r & 15, cc = c & 31, ob = rr * 64 + cc * 2; return st * 1024 + (ob ^ (((ob >> 9) & 1) << 5)); }
__host__ __device__ __forceinline__ int perm32(int rho) { const int n = rho >> 4, i = rho & 15; return 8 * (i >> 2) + 4 * n + (i & 3); }
__host__ __device__ __forceinline__ void stage_rc(int b, int& R, int& C) { const int st = b / 1024, sb = b % 1024, swz = sb ^ (((sb >> 9) & 1) << 5); R = (st >> 1) * 16 + swz / 64; C = (st & 1) * 32 + (swz % 64) / 2; }
struct Unit { int pm, pn, e, rows; };
template <class Epi, class Sched, bool GATHER>
__device__ __forceinline__ void gemm_phase(LAS unsigned char* lds, const int tid, const int K, const unsigned lda_b, const unsigned ldb_b, const Sched& S, const Epi& E) {
    const int wid = __builtin_amdgcn_readfirstlane(tid >> 6), lane = tid & 63, wr = wid >> 2, wc = wid & 3, fr = lane & 15, fq = lane >> 4;
    const int nt = K / BK;
    unsigned voffA[2], voffB[2]; int RA[2], CA[2];
#pragma unroll
    for (int i = 0; i < 2; ++i) { int R, C; stage_rc(tid * 16 + i * 8192, R, C); RA[i] = R; CA[i] = C; const int Rb = Epi::PERM ? ((R & ~31) + perm32(R & 31)) : R; voffA[i] = (unsigned)R * lda_b + (unsigned)C * 2u; voffB[i] = (unsigned)Rb * ldb_b + (unsigned)C * 2u; }
    const size_t kstep = (size_t)(BK * 2);
    const size_t hstepA = (size_t)HALF * lda_b, hstepB = (size_t)HALF * ldb_b;
    const unsigned ldsw = (unsigned)wid * 1024u;
    const int aoff = lds_byte(wr * 64 + fr, fq * 8), boff = lds_byte(wc * 32 + fr, fq * 8);
#define PG8_SA(b, h) (((b) * 2 + (h)) * HTB)
#define PG8_SB(b, h) ((4 + (b) * 2 + (h)) * HTB)
#define PG8_STAGE(bufoff, gbase, voff) do { _Pragma("unroll") for (int _i = 0; _i < 2; ++_i) \
        __builtin_amdgcn_global_load_lds((const unsigned*)((const char*)(gbase) + (voff)[_i]), (LAS unsigned*)(lds + (bufoff) + ldsw + _i * 8192), 16, 0, 0); } while (0)
#define PG8_STAGE_A(bufoff, gbase, h, OS) do { if constexpr (GATHER) { PG8_STAGE(bufoff, gbase, g##OS##h); } else { PG8_STAGE(bufoff, (gbase) + (h) * hstepA, voffA); } } while (0)
#define PG8_LDA(dst, b, h) do { _Pragma("unroll") for (int m = 0; m < 4; ++m) _Pragma("unroll") for (int k = 0; k < 2; ++k) dst[m][k] = *(const LAS bf16x8*)(lds + PG8_SA(b, h) + aoff + m * 2048 + k * 1024); } while (0)
#define PG8_LDB(dst, b, h) do { _Pragma("unroll") for (int n = 0; n < 2; ++n) _Pragma("unroll") for (int k = 0; k < 2; ++k) dst[n][k] = *(const LAS bf16x8*)(lds + PG8_SB(b, h) + boff + n * 2048 + k * 1024); } while (0)
#define PG8_MMA(ai, bj, At, Bt) do { __builtin_amdgcn_s_setprio(1); _Pragma("unroll") for (int m = 0; m < 4; ++m) _Pragma("unroll") for (int n = 0; n < 2; ++n) _Pragma("unroll") for (int k = 0; k < 2; ++k) \
        acc[ai][bj][m][n] = __builtin_amdgcn_mfma_f32_16x16x32_bf16(Bt[n][k], At[m][k], acc[ai][bj][m][n], 0, 0, 0); __builtin_amdgcn_s_setprio(0); } while (0)
#define PG8_WAIT_V(n) asm volatile("s_waitcnt vmcnt(" #n ")" ::: "memory")
#define PG8_WAIT_L(n) asm volatile("s_waitcnt lgkmcnt(" #n ")" ::: "memory")
#define PG8_BAR __builtin_amdgcn_s_barrier()
#define PG8_SCHED __builtin_amdgcn_sched_barrier(0)
    Unit cur, nxt; int ui = 0;
    if (!S.next(0, cur)) return;
    f32x4 acc[2][2][4][2];
#pragma unroll
    for (int a = 0; a < 2; ++a)
#pragma unroll
        for (int b = 0; b < 2; ++b)
#pragma unroll
            for (int m = 0; m < 4; ++m)
#pragma unroll
                for (int n = 0; n < 2; ++n) acc[a][b][m][n] = (f32x4){0.f, 0.f, 0.f, 0.f};
    bf16x8 At[4][2], B0[2][2], B1[2][2];
    unsigned gc0[2] = {0u, 0u}, gc1[2] = {0u, 0u}, gn0[2] = {0u, 0u}, gn1[2] = {0u, 0u};
    const char* cA = S.a_base(cur); const char* cB = S.b_base(cur);
    if constexpr (GATHER) {
#pragma unroll
        for (int i = 0; i < 2; ++i) { gc0[i] = S.a_off(cur, RA[i]) + (unsigned)CA[i] * 2u; gc1[i] = S.a_off(cur, HALF + RA[i]) + (unsigned)CA[i] * 2u; }
    }
    PG8_STAGE(PG8_SB(0, 0), cB, voffB); PG8_STAGE(PG8_SB(0, 1), cB + hstepB, voffB); PG8_STAGE_A(PG8_SA(0, 0), cA, 0, c); PG8_STAGE_A(PG8_SA(0, 1), cA, 1, c);
    if (wr == 1) PG8_BAR;
    PG8_WAIT_V(2); PG8_BAR;
    PG8_STAGE(PG8_SB(1, 0), cB + kstep, voffB); PG8_STAGE_A(PG8_SA(1, 0), cA + kstep, 0, c); PG8_STAGE(PG8_SB(1, 1), cB + hstepB + kstep, voffB);
    PG8_WAIT_V(6); PG8_BAR;
#pragma unroll 1
    for (;;) {
        const bool has_next = S.next(ui + 1, nxt);
        const char* nA = has_next ? S.a_base(nxt) : cA; const char* nB = has_next ? S.b_base(nxt) : cB;
        if constexpr (GATHER) {
            if (has_next) {
#pragma unroll
                for (int i = 0; i < 2; ++i) { gn0[i] = S.a_off(nxt, RA[i]) + (unsigned)CA[i] * 2u; gn1[i] = S.a_off(nxt, HALF + RA[i]) + (unsigned)CA[i] * 2u; }
            } else {
#pragma unroll
                for (int i = 0; i < 2; ++i) { gn0[i] = gc0[i]; gn1[i] = gc1[i]; }
            }
        }
#pragma unroll 1
        for (int t = 0; t < nt; t += 2) {
            const bool last = (t == nt - 2);
            const char* a1 = cA + (size_t)(t + 1) * kstep;
            const char* a2 = last ? nA : cA + (size_t)(t + 2) * kstep; const char* b2 = last ? nB : cB + (size_t)(t + 2) * kstep;
            const char* a3 = a2 + kstep; const char* b3 = b2 + kstep;
            unsigned gx0[2], gx1[2];
#pragma unroll
            for (int i = 0; i < 2; ++i) { gx0[i] = last ? gn0[i] : gc0[i]; gx1[i] = last ? gn1[i] : gc1[i]; }
            (void)gx0; (void)gx1;
            PG8_LDB(B0, 0, 0); PG8_LDB(B1, 0, 1); PG8_SCHED; PG8_LDA(At, 0, 0); PG8_STAGE_A(PG8_SA(1, 1), a1, 1, c);
            PG8_WAIT_V(8); PG8_WAIT_L(0); PG8_BAR; PG8_MMA(0, 0, At, B0); PG8_MMA(0, 1, At, B1); PG8_BAR; PG8_SCHED;
            PG8_LDA(At, 0, 1); PG8_STAGE(PG8_SB(0, 0), b2, voffB); PG8_STAGE(PG8_SB(0, 1), b2 + hstepB, voffB); PG8_STAGE_A(PG8_SA(0, 0), a2, 0, x);
            PG8_WAIT_V(8); PG8_WAIT_L(0); PG8_BAR; PG8_MMA(1, 0, At, B0); PG8_MMA(1, 1, At, B1); PG8_BAR; PG8_SCHED;
            PG8_LDB(B0, 1, 0); PG8_LDB(B1, 1, 1); PG8_SCHED; PG8_LDA(At, 1, 0); PG8_STAGE_A(PG8_SA(0, 1), a2, 1, x);
            PG8_WAIT_V(8); PG8_WAIT_L(0); PG8_BAR; PG8_MMA(0, 0, At, B0); PG8_MMA(0, 1, At, B1); PG8_BAR; PG8_SCHED;
            PG8_LDA(At, 1, 1); PG8_STAGE(PG8_SB(1, 0), b3, voffB); PG8_STAGE(PG8_SB(1, 1), b3 + hstepB, voffB); PG8_STAGE_A(PG8_SA(1, 0), a3, 0, x);
            PG8_WAIT_V(8); PG8_WAIT_L(0); PG8_BAR; PG8_MMA(1, 0, At, B0); PG8_MMA(1, 1, At, B1); PG8_BAR; PG8_SCHED;
        }
        if (wr == 0) PG8_BAR;
        E(acc, cur, wr, wc, fr, fq);
        if (!has_next) break;
#pragma unroll
        for (int a = 0; a < 2; ++a)
#pragma unroll
            for (int b = 0; b < 2; ++b)
#pragma unroll
                for (int m = 0; m < 4; ++m)
#pragma unroll
                    for (int n = 0; n < 2; ++n) acc[a][b][m][n] = (f32x4){0.f, 0.f, 0.f, 0.f};
        cur = nxt; cA = nA; cB = nB; ++ui;
        if constexpr (GATHER) {
#pragma unroll
            for (int i = 0; i < 2; ++i) { gc0[i] = gn0[i]; gc1[i] = gn1[i]; }
        }
        if (wr == 1) PG8_BAR;
    }
    PG8_WAIT_V(0);
    PG8_BAR;
#undef PG8_SA
#undef PG8_SB
#undef PG8_STAGE
#undef PG8_STAGE_A
#undef PG8_LDA
#undef PG8_LDB
#undef PG8_MMA
#undef PG8_WAIT_V
#undef PG8_WAIT_L
#undef PG8_BAR
#undef PG8_SCHED
}
}

#define XB_TMO      128
#define XB_XCNT(j)  (256  + 64 * (j))
#define XB_XSUB(j)  (1280 + 64 * (j))
#define XB_XGEN(j)  (2304 + 64 * (j))
#define XB_TOP      3328
#define XB_TOPGEN   3392
#define XCD_BAR_WORDS 3456
#define XB_SPIN_CAP (1u << 22)
__device__ __forceinline__ unsigned xb_ld(unsigned* p)              { return __hip_atomic_load(p, __ATOMIC_RELAXED, __HIP_MEMORY_SCOPE_AGENT); }
__device__ __forceinline__ unsigned xb_add(unsigned* p, unsigned v) { return __hip_atomic_fetch_add(p, v, __ATOMIC_RELAXED, __HIP_MEMORY_SCOPE_AGENT); }
__device__ __forceinline__ unsigned xb_xcc_id() { return (unsigned)__builtin_amdgcn_s_getreg((3 << 11) | 20) & 0xFu; }
#define XB_SPIN(cond, bar) do { unsigned _sp = 0; while (cond) { __builtin_amdgcn_s_sleep(1); \
    if ((++_sp & 255u) == 0u) { if (xb_ld(&(bar)[XB_TMO])) break; if (_sp > XB_SPIN_CAP) { atomicAdd(&(bar)[XB_TMO], 1u); break; } } } } while (0)
struct XcdBarrier { unsigned* bar; unsigned x; volatile LAS unsigned* st; };
__device__ __forceinline__ XcdBarrier xcd_barrier_post(unsigned* bar, volatile LAS unsigned* st) {
    XcdBarrier b; b.bar = bar; b.x = xb_xcc_id(); b.st = st;
    if (threadIdx.x == 0) (void)xb_add(&bar[XB_XCNT(b.x)], 1u);
    return b;
}
__device__ __forceinline__ void xcd_barrier_complete(unsigned* bar, unsigned x, unsigned& nloc, unsigned& nx) {
    const unsigned G = gridDim.x * gridDim.y * gridDim.z;
    unsigned sum, cnt, mine, sp = 0u;
    for (;;) {
        sum = 0u; cnt = 0u; mine = 0u;
#pragma unroll
        for (unsigned j = 0; j < 16; ++j) { const unsigned c = xb_ld(&bar[XB_XCNT(j)]); sum += c; cnt += (c > 0u) ? 1u : 0u; mine = (j == x) ? c : mine; }
        if (sum == G) break;
        __builtin_amdgcn_s_sleep(1);
        if ((++sp & 255u) == 0u) { if (xb_ld(&bar[XB_TMO])) break; if (sp > XB_SPIN_CAP) { atomicAdd(&bar[XB_TMO], 1u); break; } }
    }
    nloc = mine > 0u ? mine : 1u; nx = cnt > 0u ? cnt : 1u;
}
__device__ __forceinline__ void xcd_barrier(const XcdBarrier& b) {
    asm volatile("s_waitcnt vmcnt(0)" ::: "memory");
    __syncthreads();
    if (threadIdx.x == 0) {
        unsigned* bar = b.bar;
        __builtin_amdgcn_s_waitcnt(0);
        unsigned nloc = b.st[0], nx = b.st[1];
        if (nloc == 0u) { xcd_barrier_complete(bar, b.x, nloc, nx); b.st[0] = nloc; b.st[1] = nx; }
        const unsigned old = xb_add(&bar[XB_XSUB(b.x)], 1u);
        const unsigned gen = old / nloc;
        if (old + 1u == (gen + 1u) * nloc) {
            __builtin_amdgcn_fence(__ATOMIC_RELEASE, "agent");
            asm volatile("s_waitcnt vmcnt(0)" ::: "memory");
            const unsigned og = xb_add(&bar[XB_TOP], 1u);
            const unsigned tg = og / nx;
            if (og + 1u == (tg + 1u) * nx) xb_add(&bar[XB_TOPGEN], 1u);
            else XB_SPIN(xb_ld(&bar[XB_TOPGEN]) == tg, bar);
            __builtin_amdgcn_fence(__ATOMIC_ACQUIRE, "agent");
            xb_add(&bar[XB_XGEN(b.x)], 1u);
            asm volatile("s_waitcnt vmcnt(0)" ::: "memory");
        } else {
            XB_SPIN(xb_ld(&bar[XB_XGEN(b.x)]) == gen, bar);
            __builtin_amdgcn_fence(__ATOMIC_ACQUIRE, "agent");
            asm volatile("s_waitcnt vmcnt(0)" ::: "memory");
        }
    }
    __syncthreads();
}

struct Frame {
    LAS unsigned char* lds;
    int tid, lane, wave, bid, G, gw, NGW;
    float* out; unsigned char* ws;
};
struct Args { const float* in[33]; float* out; unsigned char* ws; int ph_lo, ph_hi; };
#define FIN(i) (AR->in[i])
#define CAS __attribute__((address_space(4)))
typedef const CAS Args* ArgsP;
__device__ __forceinline__ ArgsP launder_args(ArgsP p) { asm volatile("" : "+s"(p)); return p; }

__device__ __forceinline__ void phase_mod(Frame& F, ArgsP AR) {
    LAS float* cs = (LAS float*)F.lds;
    LAS float* red = cs + 4096;
    const float* c = FIN(1);
    for (int i = F.tid; i < 4096; i += 512) { const float v = c[i]; cs[i] = v / (1.0f + __expf(-v)); }
    __syncthreads();
    float* MOD = (float*)(F.ws + WS_MOD);
    for (int it = F.bid; it < 192; it += F.G) {
        const int m = it / 48, n0 = (it % 48) * 64, l = m >> 1;
        const float* W = ((m & 1) ? FIN(7) : FIN(4)) + (size_t)l * 1024 * 3072;
        const float* bias = ((m & 1) ? FIN(8) : FIN(5)) + (size_t)l * 3072;
        float a0 = 0.f, a1 = 0.f, a2 = 0.f, a3 = 0.f;
        const int k0 = F.wave * 128;
#pragma unroll 32
        for (int k = k0; k < k0 + 128; ++k) {
            const float w = W[(size_t)k * 3072 + n0 + F.lane];
            a0 += cs[k] * w; a1 += cs[1024 + k] * w; a2 += cs[2048 + k] * w; a3 += cs[3072 + k] * w;
        }
        red[(F.wave * 4 + 0) * 64 + F.lane] = a0; red[(F.wave * 4 + 1) * 64 + F.lane] = a1; red[(F.wave * 4 + 2) * 64 + F.lane] = a2; red[(F.wave * 4 + 3) * 64 + F.lane] = a3;
        __syncthreads();
        if (F.tid < 256) { const int b = F.tid >> 6, n = F.tid & 63; float s = 0.f;
#pragma unroll
            for (int w = 0; w < 8; ++w) s += red[(w * 4 + b) * 64 + n];
            MOD[(size_t)(m * 4 + b) * 3072 + n0 + n] = s + bias[n0 + n]; }
        __syncthreads();
    }
}

__device__ __forceinline__ void transpose_item(const float* W, int ldw, int nvalid, int K, bf16* WT, int mode, LAS float* scr, int kb, int nb, int lane) {
    const int k0 = 64 * kb, n0 = 32 * nb;
    const int nn = n0 + (lane & 31);
#pragma unroll
    for (int i = 0; i < 32; ++i) { const int kk = 2 * i + (lane >> 5); scr[kk * 33 + (lane & 31)] = (nn < nvalid) ? W[(size_t)(k0 + kk) * ldw + nn] : 0.f; }
    LDS_WAIT();
    const int c = lane & 7;
#pragma unroll
    for (int j = 0; j < 4; ++j) { const int nl = (lane >> 3) + 8 * j; const LAS float* s = scr + (8 * c) * 33 + nl;
        v4u o; o.x = pk2(s[0 * 33], s[1 * 33]); o.y = pk2(s[2 * 33], s[3 * 33]); o.z = pk2(s[4 * 33], s[5 * 33]); o.w = pk2(s[6 * 33], s[7 * 33]);
        const int n = n0 + nl; const int row = (mode == 0) ? n : (256 * (n >> 7) + (n & 127) + (mode == 2 ? 128 : 0));
        *(v4u*)(WT + (size_t)row * K + k0 + 8 * c) = o; }
    LDS_WAIT();
}
__device__ __forceinline__ void phase_convert_static(Frame& F, ArgsP AR) {
    LAS float* scr = (LAS float*)(F.lds + F.wave * 16384);
    constexpr int I_IN = 16 * 56, I_OUT = 16 * 32, I_POOL = 4 * 4 * 8;
    for (int it = F.gw; it < I_IN + I_OUT + I_POOL; it += F.NGW) {
        int r = it;
        if (r < I_IN) { transpose_item(FIN(9), INW, INW, 1024, (bf16*)(F.ws + WS_WIN), 0, scr, r / 56, r % 56, F.lane); continue; } r -= I_IN;
        if (r < I_OUT) { transpose_item(FIN(10), 1024, 1024, 1024, (bf16*)(F.ws + WS_WOUT), 0, scr, r / 32, r % 32, F.lane); continue; } r -= I_OUT;
        const int g = r / 32, rr = r % 32;
        transpose_item(FIN(23) + (size_t)g * 65536, 256, 256, 256, (bf16*)(F.ws + WS_WPOOL) + (size_t)g * 65536, 0, scr, rr / 8, rr % 8, F.lane);
    }
}
__device__ __forceinline__ void phase_convert_experts(Frame& F, ArgsP AR, int l) {
    LAS float* scr = (LAS float*)(F.lds + F.wave * 16384);
    for (int it = F.gw; it < 65 * 384; it += F.NGW) {
        const int e = it / 384, r = it % 384, type = r >> 7, sub = r & 127;
        if (type < 2) {
            const float* W = (e < 64) ? (FIN(type == 0 ? 27 : 28) + (size_t)(l * 64 + e) * 1024 * 256) : (FIN(type == 0 ? 30 : 31) + (size_t)l * 1024 * 256);
            transpose_item(W, 256, 256, 1024, (bf16*)(F.ws + WS_WGU) + (size_t)e * 512 * 1024, 1 + type, scr, sub >> 3, sub & 7, F.lane);
        } else {
            const float* W = (e < 64) ? (FIN(29) + (size_t)(l * 64 + e) * 256 * 1024) : (FIN(32) + (size_t)l * 256 * 1024);
            transpose_item(W, 1024, 1024, 256, (bf16*)(F.ws + WS_WD) + (size_t)e * 1024 * 256, 0, scr, sub >> 5, sub & 31, F.lane);
        }
    }
}

__device__ __forceinline__ void phase_tables(Frame& F, ArgsP AR) {
    const int gid = F.bid * 512 + F.tid, NT_ = F.G * 512;
    float* ROPE = (float*)(F.ws + WS_ROPE);
    const int* pos = (const int*)FIN(2);
    for (int i = gid; i < T * 8; i += NT_) {
        const int t = i >> 3, j = i & 7;
        const float inv = (j == 0) ? 1.0f : (j == 1) ? 0.1939227432f : (j == 2) ? 0.03760603070f : (j == 3) ? 0.007292664610f : (j == 4) ? 0.001414213562f : (j == 5) ? 0.0002742481884f : (j == 6) ? 5.318295734e-05f : 1.031338525e-05f;
        const float ang = (float)pos[t] * inv;
        float sn, cs; sincosf(ang, &sn, &cs);
        ROPE[2 * i] = cs; ROPE[2 * i + 1] = sn;
    }
}

__device__ __forceinline__ void phase_norm_mod(Frame& F, const float* X, const float* gamma, int m, bf16* Hout, float* Hf) {
    const float* MOD = (const float*)(F.ws + WS_MOD);
    for (int row = F.gw; row < T; row += F.NGW) {
        const int b = row >> 12;
        const float* shift = MOD + (size_t)(m * 4 + b) * 3072; const float* scale = shift + 1024;
        const f32x4* xr = (const f32x4*)(X + (size_t)row * D) + F.lane;
        f32x4 v[4]; float ss = 0.f;
#pragma unroll
        for (int j = 0; j < 4; ++j) { v[j] = xr[64 * j]; ss += v[j].x * v[j].x + v[j].y * v[j].y + v[j].z * v[j].z + v[j].w * v[j].w; }
        const float rstd = rsqrtf(wave_sum(ss) * (1.0f / D) + 1e-6f);
#pragma unroll
        for (int j = 0; j < 4; ++j) {
            const int c0 = 4 * F.lane + 256 * j;
            const f32x4 gg = *(const f32x4*)(gamma + c0), sc = *(const f32x4*)(scale + c0), sh = *(const f32x4*)(shift + c0);
            f32x4 h; h.x = v[j].x * rstd * gg.x * (1.f + sc.x) + sh.x; h.y = v[j].y * rstd * gg.y * (1.f + sc.y) + sh.y;
            h.z = v[j].z * rstd * gg.z * (1.f + sc.z) + sh.z; h.w = v[j].w * rstd * gg.w * (1.f + sc.w) + sh.w;
            if (Hout) { v2u o; o.x = pk2(h.x, h.y); o.y = pk2(h.z, h.w); *(v2u*)(Hout + (size_t)row * D + c0) = o; }
            if (Hf) *(f32x4*)(Hf + (size_t)row * D + c0) = h;
        }
    }
}

struct DenseOrder {
    const char* A; const char* Bt; unsigned lda_b, ldb_b; int nM, nN, nU, chunk, x, q0, qs;
    __device__ __forceinline__ void init(const void* A_, const void* Bt_, unsigned lda, unsigned ldb, int M, int N, int G, int c) {
        A = (const char*)A_; Bt = (const char*)Bt_; lda_b = lda; ldb_b = ldb; nM = M / 256; nN = N / 256; nU = nM * nN; chunk = (nU + 7) / 8; x = c & 7; q0 = c >> 3; qs = G >> 3; }
    __device__ __forceinline__ bool next(int i, pg8::Unit& u) const {
        const int q = i * qs + q0; if (q >= chunk) return false; const int L = x * chunk + q; if (L >= nU) return false;
        u.pm = L / nN; u.pn = L % nN; u.e = 0; u.rows = 256; return true; }
    __device__ __forceinline__ const char* a_base(const pg8::Unit& u) const { return A + (size_t)u.pm * 256 * lda_b; }
    __device__ __forceinline__ const char* b_base(const pg8::Unit& u) const { return Bt + (size_t)u.pn * 256 * ldb_b; }
    __device__ __forceinline__ unsigned a_off(const pg8::Unit&, int) const { return 0u; }
};
struct PoolOrder {
    const char* A; const char* Bt; int nU, chunk, x, q0, qs;
    __device__ __forceinline__ void init(const void* A_, const void* Bt_, int G, int c) { A = (const char*)A_; Bt = (const char*)Bt_; nU = 64 * 4; chunk = (nU + 7) / 8; x = c & 7; q0 = c >> 3; qs = G >> 3; }
    __device__ __forceinline__ bool next(int i, pg8::Unit& u) const {
        const int q = i * qs + q0; if (q >= chunk) return false; const int L = x * chunk + q; if (L >= nU) return false;
        u.pm = L >> 2; u.pn = L & 3; u.e = L & 3; u.rows = 256; return true; }
    __device__ __forceinline__ const char* a_base(const pg8::Unit& u) const { return A + (size_t)u.pm * 256 * 2048 + (size_t)u.e * 512; }
    __device__ __forceinline__ const char* b_base(const pg8::Unit& u) const { return Bt + (size_t)u.e * 256 * 512; }
    __device__ __forceinline__ unsigned a_off(const pg8::Unit&, int) const { return 0u; }
};
constexpr int LDS_MOE = 131072;
__device__ __forceinline__ void moe_tables(Frame& F, int l) {
    LAS int* est = (LAS int*)(F.lds + LDS_MOE); LAS int* tst = est + 128;
    if (F.wave == 0) {
        const unsigned* ctl = (const unsigned*)(F.ws + WS_CTL);
        const int c = (int)__hip_atomic_load(&ctl[CW_CNT + (l * 64 + F.lane) * 64], __ATOMIC_RELAXED, __HIP_MEMORY_SCOPE_AGENT);
        const int nt = (c + 255) >> 8;
        int ic = c, it = nt;
#pragma unroll
        for (int o = 1; o < 64; o <<= 1) { const int a = __shfl_up(ic, o), b2 = __shfl_up(it, o); if (F.lane >= o) { ic += a; it += b2; } }
        est[F.lane] = ic - c; tst[F.lane] = it - nt;
        if (F.lane == 63) { est[64] = ic; tst[64] = it; }
    }
    __syncthreads();
}
template <int NPN, bool GATE_UP>
struct MoeOrder {
    const LAS int* est; const LAS int* tst; const unsigned char* ws; int ntr, ntiles, nU, chunk, x, q0, qs;
    __device__ __forceinline__ void init(LAS unsigned char* lds, const unsigned char* ws_, bool shared_only, bool with_sh, int G, int c) {
        est = (const LAS int*)(lds + LDS_MOE); tst = est + 128; ws = ws_;
        ntr = shared_only ? 0 : __builtin_amdgcn_readfirstlane(tst[64]); ntiles = ntr + (with_sh ? 64 : 0); nU = ntiles * NPN; chunk = (nU + 7) / 8; x = c & 7; q0 = c >> 3; qs = G >> 3; }
    __device__ __forceinline__ bool next(int i, pg8::Unit& u) const {
        const int q = i * qs + q0; if (q >= chunk) return false; const int L = x * chunk + q; if (L >= nU) return false;
        const int tile = L / NPN; u.pn = L % NPN;
        if (tile < ntr) { int e = 0;
#pragma unroll
            for (int s_ = 32; s_ >= 1; s_ >>= 1) { if (tst[e + s_] <= tile) e += s_; }
            e = __builtin_amdgcn_readfirstlane(e); u.e = e; u.pm = __builtin_amdgcn_readfirstlane(tile - tst[e]); const int rem = __builtin_amdgcn_readfirstlane(est[e + 1] - est[e]) - 256 * u.pm; u.rows = rem < 256 ? rem : 256; }
        else { u.e = 64; u.pm = tile - ntr; u.rows = 256; }
        return true; }
    __device__ __forceinline__ int row0(const pg8::Unit& u) const { return (u.e < 64) ? __builtin_amdgcn_readfirstlane(est[u.e]) + 256 * u.pm : 256 * u.pm; }
    __device__ __forceinline__ const char* a_base(const pg8::Unit& u) const {
        if (GATE_UP) return (const char*)(ws + WS_H);
        return (u.e < 64) ? (const char*)(ws + BG_HB) + (size_t)row0(u) * 512 : (const char*)(ws + BG_HBSH) + (size_t)row0(u) * 512; }
    __device__ __forceinline__ const char* b_base(const pg8::Unit& u) const {
        if (GATE_UP) return (const char*)(ws + WS_WGU) + (size_t)u.e * 512 * 2048 + (size_t)u.pn * 256 * 2048;
        return (const char*)(ws + WS_WD) + (size_t)u.e * 1024 * 512 + (size_t)u.pn * 256 * 512; }
    __device__ __forceinline__ unsigned a_off(const pg8::Unit& u, int r) const {
        int tok;
        if (u.e < 64) { const int* elt = (const int*)(ws + WS_ELT) + (size_t)u.e * ECAP + 256 * u.pm; tok = (r < u.rows) ? elt[r] : 0; }
        else tok = 256 * u.pm + r;
        return (unsigned)tok * 2048u; }
};

struct EpiBf16Store { static constexpr bool PERM = true; bf16* C; int ldc;
    __device__ __forceinline__ void operator()(const pg8::f32x4 (&acc)[2][2][4][2], const pg8::Unit& u, int wr, int wc, int fr, int fq) const {
#pragma unroll
        for (int ai = 0; ai < 2; ++ai)
#pragma unroll
            for (int m = 0; m < 4; ++m) { bf16* rowp = C + (size_t)(u.pm * 256 + ai * 128 + wr * 64 + m * 16 + fr) * ldc + u.pn * 256 + wc * 32 + 8 * fq;
#pragma unroll
                for (int bj = 0; bj < 2; ++bj) { const f32x4 a0 = acc[ai][bj][m][0], a1 = acc[ai][bj][m][1];
                    v4u o; o.x = pk2(a0.x, a0.y); o.y = pk2(a0.z, a0.w); o.z = pk2(a1.x, a1.y); o.w = pk2(a1.z, a1.w); *(v4u*)(rowp + bj * 128) = o; } }
    }
};
struct EpiF32Store { static constexpr bool PERM = false; float* C; int ldc;
    __device__ __forceinline__ void operator()(const pg8::f32x4 (&acc)[2][2][4][2], const pg8::Unit& u, int wr, int wc, int fr, int fq) const {
#pragma unroll
        for (int ai = 0; ai < 2; ++ai)
#pragma unroll
            for (int m = 0; m < 4; ++m) { float* rowp = C + (size_t)(u.pm * 256 + ai * 128 + wr * 64 + m * 16 + fr) * ldc + u.pn * 256 + wc * 32 + 4 * fq;
#pragma unroll
                for (int bj = 0; bj < 2; ++bj)
#pragma unroll
                    for (int n = 0; n < 2; ++n) *(f32x4*)(rowp + bj * 128 + n * 16) = acc[ai][bj][m][n]; }
    }
};
struct EpiResidual { static constexpr bool PERM = false; const float* Xin; float* X; const float* gate; const float* colscale; int col_from_e;
    __device__ __forceinline__ void operator()(const pg8::f32x4 (&acc)[2][2][4][2], const pg8::Unit& u, int wr, int wc, int fr, int fq) const {
        const int cbase = (col_from_e ? u.e * 256 : u.pn * 256) + wc * 32 + 4 * fq;
#pragma unroll
        for (int ai = 0; ai < 2; ++ai)
#pragma unroll
            for (int m = 0; m < 4; ++m) { const int row = u.pm * 256 + ai * 128 + wr * 64 + m * 16 + fr; const int b = row >> 12;
#pragma unroll
                for (int bj = 0; bj < 2; ++bj)
#pragma unroll
                    for (int n = 0; n < 2; ++n) { const int col = cbase + bj * 128 + n * 16; const size_t o = (size_t)row * D + col;
                        f32x4 g = *(const f32x4*)(gate + (size_t)b * 3072 + col); if (colscale) { const f32x4 cs = *(const f32x4*)(colscale + col); g = g * cs; }
                        const f32x4 xi = *(const f32x4*)(Xin + o); *(f32x4*)(X + o) = xi + g * acc[ai][bj][m][n]; } }
    }
};
template <class Order> struct EpiGateUp { static constexpr bool PERM = true; const Order* S; unsigned char* ws;
    __device__ __forceinline__ void operator()(const pg8::f32x4 (&acc)[2][2][4][2], const pg8::Unit& u, int wr, int wc, int fr, int fq) const {
        const int r0 = S->row0(u); bf16* HB = (bf16*)(ws + (u.e < 64 ? BG_HB : BG_HBSH));
        const float* elw = (const float*)(ws + WS_ELW) + (size_t)(u.e < 64 ? u.e : 0) * ECAP + 256 * u.pm;
#pragma unroll
        for (int ai = 0; ai < 2; ++ai)
#pragma unroll
            for (int m = 0; m < 4; ++m) { const int r = ai * 128 + wr * 64 + m * 16 + fr;
                if (r < u.rows) { const float w = (u.e < 64) ? elw[r] : 1.0f; bf16* rowp = HB + (size_t)(r0 + r) * 256 + u.pn * 128 + wc * 32 + 8 * fq;
                    v4u o;
#pragma unroll
                    for (int n = 0; n < 2; ++n) { const f32x4 g = acc[ai][0][m][n], up = acc[ai][1][m][n]; f32x4 h;
                        h.x = g.x * sigmoidf_(g.x) * up.x * w; h.y = g.y * sigmoidf_(g.y) * up.y * w; h.z = g.z * sigmoidf_(g.z) * up.z * w; h.w = g.w * sigmoidf_(g.w) * up.w * w;
                        if (n == 0) { o.x = pk2(h.x, h.y); o.y = pk2(h.z, h.w); } else { o.z = pk2(h.x, h.y); o.w = pk2(h.z, h.w); } }
                    *(v4u*)rowp = o; } }
    }
};
template <class Order, bool SHARED> struct EpiDown { static constexpr bool PERM = !SHARED; const Order* S; unsigned char* ws; float* X; const float* gate;
    __device__ __forceinline__ void operator()(const pg8::f32x4 (&acc)[2][2][4][2], const pg8::Unit& u, int wr, int wc, int fr, int fq) const {
        const int r0 = S->row0(u); bf16* Y = (bf16*)(ws + BG_Y);
#pragma unroll
        for (int ai = 0; ai < 2; ++ai)
#pragma unroll
            for (int m = 0; m < 4; ++m) { const int r = ai * 128 + wr * 64 + m * 16 + fr;
                if constexpr (!SHARED) {
                    if (r < u.rows) {
#pragma unroll
                        for (int bj = 0; bj < 2; ++bj) { const int col = u.pn * 256 + bj * 128 + wc * 32 + 8 * fq; const f32x4 a0 = acc[ai][bj][m][0], a1 = acc[ai][bj][m][1];
                                v4u o; o.x = pk2(a0.x, a0.y); o.y = pk2(a0.z, a0.w); o.z = pk2(a1.x, a1.y); o.w = pk2(a1.z, a1.w); *(v4u*)(Y + (size_t)(r0 + r) * D + col) = o; } }
                } else {
                    const int tok = r0 + r;
                    const int* ei = (const int*)(ws + WS_EIDX) + (size_t)tok * 8; const int* sl = (const int*)(ws + WS_SLOT) + (size_t)tok * 8;
                    const v4u e0 = *(const v4u*)ei, e1 = *(const v4u*)(ei + 4), p0 = *(const v4u*)sl, p1 = *(const v4u*)(sl + 4);
                    size_t yr[8];
                    yr[0] = (size_t)(S->est[e0.x] + (int)p0.x); yr[1] = (size_t)(S->est[e0.y] + (int)p0.y); yr[2] = (size_t)(S->est[e0.z] + (int)p0.z); yr[3] = (size_t)(S->est[e0.w] + (int)p0.w);
                    yr[4] = (size_t)(S->est[e1.x] + (int)p1.x); yr[5] = (size_t)(S->est[e1.y] + (int)p1.y); yr[6] = (size_t)(S->est[e1.z] + (int)p1.z); yr[7] = (size_t)(S->est[e1.w] + (int)p1.w);
#pragma unroll
                    for (int bj = 0; bj < 2; ++bj)
#pragma unroll
                        for (int n = 0; n < 2; ++n) { const int col = u.pn * 256 + bj * 128 + wc * 32 + n * 16 + 4 * fq; f32x4 a = acc[ai][bj][m][n];
#pragma unroll
                            for (int k = 0; k < 8; ++k) { const v2u yw = *(const v2u*)(Y + yr[k] * D + col); a.x += bflo(yw.x); a.y += bfhi(yw.x); a.z += bflo(yw.y); a.w += bfhi(yw.y); }
                            const size_t o = (size_t)tok * D + col; const f32x4 g = *(const f32x4*)(gate + (size_t)(tok >> 12) * 3072 + col);
                            const f32x4 xi = *(const f32x4*)(X + o); *(f32x4*)(X + o) = xi + g * a; }
                }
                asm volatile("" ::: "memory"); }
    }
};

__device__ __forceinline__ void phase_postproj(Frame& F, ArgsP AR) {
    const bf16* PROJ = (const bf16*)(F.ws + BG_PROJ); const float* ROPE = (const float*)(F.ws + WS_ROPE);
    float* U = (float*)(F.ws + BG_U); bf16* Q = (bf16*)(F.ws + BG_Q); bf16* QI = (bf16*)(F.ws + BG_QI); bf16* Kb = (bf16*)(F.ws + BG_K); bf16* Vb = (bf16*)(F.ws + BG_V); bf16* KIb = (bf16*)(F.ws + BG_KI); float* WI = (float*)(F.ws + BG_WI);
    const float qg = FIN(21)[F.lane], kg = FIN(22)[F.lane];
    const int lane = F.lane;
    for (int t = F.gw; t < T; t += F.NGW) {
        const bf16* p = PROJ + (size_t)t * INP;
        const float cs = ROPE[(size_t)t * 16 + 2 * (lane & 7)], sn = ROPE[(size_t)t * 16 + 2 * (lane & 7) + 1];
#pragma unroll
        for (int j = 0; j < 8; ++j) { const float uv = bf2f(p[j * 64 + lane]); U[(size_t)t * 512 + j * 64 + lane] = uv;
            const int col = j * 64 + lane; ((bf16*)(F.ws + BG_AUG))[((size_t)(col >> 4) * 512 + (t >> 5)) * 640 + (t & 31) * 16 + (col & 15)] = (bf16)f2bf(uv); }
        auto rope = [&](float y) -> float { const float yp = __shfl_xor(y, 8); float o = y; if (lane < 8) o = y * cs - yp * sn; else if (lane < 16) o = yp * sn + y * cs; return o; };
#pragma unroll
        for (int h = 0; h < 8; ++h) { const float x = bf2f(p[512 + h * 64 + lane]); const float rstd = rsqrtf(wave_sum(x * x) * (1.0f / 64.0f) + 1e-6f);
            Q[(size_t)t * 512 + h * 64 + lane] = (bf16)f2bf(rope(x * rstd * qg)); }
        { const float x = bf2f(p[1024 + lane]); const float rstd = rsqrtf(wave_sum(x * x) * (1.0f / 64.0f) + 1e-6f); Kb[(size_t)t * 64 + lane] = (bf16)f2bf(rope(x * rstd * kg)); }
        { const bf16 vv = (bf16)f2bf(bf2f(p[1088 + lane])); Vb[(size_t)t * 64 + lane] = vv; ((bf16*)(F.ws + BG_VT))[((size_t)(t >> 12) * 64 + lane) * 4096 + (t & 4095)] = vv; }
#pragma unroll
        for (int h = 0; h < 8; ++h) QI[(size_t)t * 512 + h * 64 + lane] = (bf16)f2bf(rope(bf2f(p[1152 + h * 64 + lane])));
        KIb[(size_t)t * 64 + lane] = (bf16)f2bf(rope(bf2f(p[1664 + lane])));
        if (lane < 8) WI[(size_t)t * 8 + lane] = bf2f(p[1728 + lane]) * 0.35355339059327373f;
    }
}

__device__ __forceinline__ void phase_s5a(Frame& F, ArgsP AR) {
    const float* S5 = (const float*)(F.ws + WS_S5T); const float* U = (const float*)(F.ws + BG_U); float* SLOC = (float*)(F.ws + BG_SLOC);
    const int p = F.lane;
    for (int it = F.gw; it < 4 * 32 * 64; it += F.NGW) {
        const int c = it & 63, g = (it >> 6) & 31, b = it >> 11;
        const float ar = S5[S5_ABAR + 2 * (g * 64 + p)], ai = S5[S5_ABAR + 2 * (g * 64 + p) + 1];
        float br[16], bi[16];
#pragma unroll
        for (int h = 0; h < 16; ++h) { br[h] = S5[S5_BBR + (g * 64 + p) * 16 + h]; bi[h] = S5[S5_BBI + (g * 64 + p) * 16 + h]; }
        float sr = 0.f, si = 0.f;
        const float* up = U + ((size_t)b * SEQ + c * 64) * 512 + g * 16;
        for (int tau = 0; tau < 64; ++tau) {
            float bur = 0.f, bui = 0.f;
#pragma unroll
            for (int h = 0; h < 16; ++h) { const float u = up[(size_t)tau * 512 + h]; bur += br[h] * u; bui += bi[h] * u; }
            const float nr = ar * sr - ai * si + bur, ni = ar * si + ai * sr + bui; sr = nr; si = ni;
        }
        SLOC[((size_t)it * 64 + p) * 2] = sr; SLOC[((size_t)it * 64 + p) * 2 + 1] = si;
    }
}
__device__ __forceinline__ void phase_s5b(Frame& F, ArgsP AR) {
    const float* S5 = (const float*)(F.ws + WS_S5T); const float* SLOC = (const float*)(F.ws + BG_SLOC); float* SIN = (float*)(F.ws + BG_SIN);
    const int gid = F.bid * 512 + F.tid;
    for (int i = gid; i < 4 * 32 * 64; i += F.G * 512) {
        const int p = i & 63, g = (i >> 6) & 31, b = i >> 11;
        const float ar = S5[S5_A64 + 2 * (g * 64 + p)], ai = S5[S5_A64 + 2 * (g * 64 + p) + 1];
        float sr = 0.f, si = 0.f;
        for (int c = 0; c < 64; ++c) {
            const size_t o = ((((size_t)b * 32 + g) * 64 + c) * 64 + p) * 2;
            SIN[o] = sr; SIN[o + 1] = si;
            const float lr = SLOC[o], li = SLOC[o + 1];
            const float nr = ar * sr - ai * si + lr, ni = ar * si + ai * sr + li; sr = nr; si = ni;
        }
    }
}
__device__ __forceinline__ void phase_s5c(Frame& F, ArgsP AR) {
    const float* S5 = (const float*)(F.ws + WS_S5T); const float* U = (const float*)(F.ws + BG_U); const float* SIN = (const float*)(F.ws + BG_SIN); bf16* MIX = (bf16*)(F.ws + BG_MIX);
    const float* cre = FIN(16); const float* cim = FIN(17); const float* dsk = FIN(18); const float* gluw = FIN(19); const float* glub = FIN(20);
    LAS float* st = (LAS float*)(F.lds + F.wave * 10240);
    LAS float* yg = st + 2048;
    const int p = F.lane, h = F.lane & 15, tq = F.lane >> 4;
    for (int it = F.gw; it < 4 * 32 * 64; it += F.NGW) {
        const int c = it & 63, g = (it >> 6) & 31, b = it >> 11;
        const float ar = S5[S5_ABAR + 2 * (g * 64 + p)], ai = S5[S5_ABAR + 2 * (g * 64 + p) + 1];
        float br[16], bi[16];
#pragma unroll
        for (int hh = 0; hh < 16; ++hh) { br[hh] = S5[S5_BBR + (g * 64 + p) * 16 + hh]; bi[hh] = S5[S5_BBI + (g * 64 + p) * 16 + hh]; }
        float sr = SIN[((size_t)it * 64 + p) * 2], si = SIN[((size_t)it * 64 + p) * 2 + 1];
        const size_t trow0 = (size_t)b * SEQ + c * 64;
        const float dd = dsk[g * 16 + h], gb = glub[g * 16 + h];
        for (int sub = 0; sub < 4; ++sub) {
            const float* up = U + (trow0 + sub * 16) * 512 + g * 16;
            for (int tau = 0; tau < 16; ++tau) {
                float bur = 0.f, bui = 0.f;
#pragma unroll
                for (int hh = 0; hh < 16; ++hh) { const float u = up[(size_t)tau * 512 + hh]; bur += br[hh] * u; bui += bi[hh] * u; }
                const float nr = ar * sr - ai * si + bur, ni = ar * si + ai * sr + bui; sr = nr; si = ni;
                st[(tau * 64 + p) * 2] = sr; st[(tau * 64 + p) * 2 + 1] = si;
            }
            LDS_WAIT();
            float y[4];
#pragma unroll
            for (int j = 0; j < 4; ++j) { const int tau = tq + 4 * j; float a = 0.f;
                for (int pp = 0; pp < 64; ++pp) a += cre[(g * 16 + h) * 64 + pp] * st[(tau * 64 + pp) * 2] - cim[(g * 16 + h) * 64 + pp] * st[(tau * 64 + pp) * 2 + 1];
                a += dd * up[(size_t)tau * 512 + h];
                const float ge = 0.5f * a * (1.0f + tanhf(0.7978845608028654f * (a + 0.044715f * a * a * a)));
                y[j] = ge; yg[tau * 16 + h] = ge; }
            LDS_WAIT();
#pragma unroll
            for (int j = 0; j < 4; ++j) { const int tau = tq + 4 * j; float z = gb;
#pragma unroll
                for (int hh = 0; hh < 16; ++hh) z += yg[tau * 16 + hh] * gluw[(g * 16 + hh) * 16 + h];
                MIX[(trow0 + sub * 16 + tau) * D + g * 16 + h] = (bf16)f2bf(y[j] * sigmoidf_(z)); }
            LDS_WAIT();
        }
    }
}


__device__ __forceinline__ void phase_s5mats(Frame& F, ArgsP AR) {
    const float* cre = FIN(16); const float* cim = FIN(17);
    bf16* MB = (bf16*)(F.ws + BG_S5MB); bf16* WE = (bf16*)(F.ws + BG_S5WE);
    LAS double* pw = (LAS double*)F.lds;
    LAS float* bbr = (LAS float*)(F.lds + 34816);
    LAS float* bbi = bbr + 1024;
    const int tid = F.tid;
#pragma unroll 1
    for (int unit = F.bid; unit < 256; unit += F.G) {
        const int g = unit >> 3, part = unit & 7;
        __syncthreads();
        const double dt = exp((double)FIN(13)[g]);
        for (int i = tid; i < 64 * 33; i += 512) { const int p = i / 33, dl = i % 33; const double lr = FIN(11)[g * 64 + p], li = FIN(12)[g * 64 + p];
            const double mag = exp(lr * dt * dl), ang = li * dt * dl; pw[2 * i] = mag * cos(ang); pw[2 * i + 1] = mag * sin(ang); }
        if (tid < 64) { const int p = tid; const double lr = FIN(11)[g * 64 + p], li = FIN(12)[g * 64 + p];
            const double mag = exp(lr * dt), ar = mag * cos(li * dt), ai = mag * sin(li * dt);
            const double nr = ar - 1.0, ni = ai, den = lr * lr + li * li; const double cr = (nr * lr + ni * li) / den, ci = (ni * lr - nr * li) / den;
            for (int h = 0; h < 16; ++h) { const double br = FIN(14)[(g * 64 + p) * 16 + h], bi = FIN(15)[(g * 64 + p) * 16 + h]; bbr[p * 16 + h] = (float)(cr * br - ci * bi); bbi[p * 16 + h] = (float)(cr * bi + ci * br); } }
        __syncthreads();
        if (part == 0 && tid < 64) { double* POW = (double*)(F.ws + BG_POW); const int gi = (g * 64 + tid) * 33 + 32; POW[2 * gi] = pw[2 * (tid * 33 + 32)]; POW[2 * gi + 1] = pw[2 * (tid * 33 + 32) + 1]; }
        for (int i = tid; i < 4 * 256; i += 512) {
            const int h2 = i & 15, h = (i >> 4) & 15, dl = 4 * part + (i >> 8);
            double acc = 0.0;
#pragma unroll 8
            for (int p = 0; p < 64; ++p) {
                const double pr = pw[2 * (p * 33 + dl)], pi = pw[2 * (p * 33 + dl) + 1];
                const double br = bbr[p * 16 + h2], bi = bbi[p * 16 + h2];
                acc += (double)cre[(g * 16 + h) * 64 + p] * (pr * br - pi * bi) - (double)cim[(g * 16 + h) * 64 + p] * (pr * bi + pi * br);
            }
            const bf16 kv = (bf16)f2bf((float)acc);
            bf16* Mg = MB + (size_t)g * 512 * 640;
            for (int t2 = 0; t2 + dl < 32; ++t2) {
                Mg[(size_t)((t2 + dl) * 16 + h) * 640 + t2 * 16 + h2] = kv;
                if (dl > 0) Mg[(size_t)(t2 * 16 + h) * 640 + (t2 + dl) * 16 + h2] = (bf16)0;
            }
        }
        for (int i = tid; i < 4 * 16 * 64; i += 512) {
            const int p = i & 63, h = (i >> 6) & 15, tau = 4 * part + (i >> 10);
            const double pr = pw[2 * (p * 33 + tau + 1)], pi = pw[2 * (p * 33 + tau + 1) + 1];
            const double cr = cre[(g * 16 + h) * 64 + p], ci = cim[(g * 16 + h) * 64 + p];
            bf16* row = MB + ((size_t)g * 512 + tau * 16 + h) * 640 + 512 + 2 * p;
            *(unsigned*)row = pk2((float)(cr * pr - ci * pi), (float)(-(cr * pi + ci * pr)));
        }
        for (int i = tid; i < 8 * 512; i += 512) {
            const int k = i & 511, p = 8 * part + (i >> 9);
            const int tau = k >> 4, h2 = k & 15;
            const double pr = pw[2 * (p * 33 + 31 - tau)], pi = pw[2 * (p * 33 + 31 - tau) + 1];
            const double br = bbr[p * 16 + h2], bi = bbi[p * 16 + h2];
            bf16* Wg = WE + (size_t)g * 256 * 512;
            Wg[(size_t)(2 * p) * 512 + k] = (bf16)f2bf((float)(pr * br - pi * bi));
            Wg[(size_t)(2 * p + 1) * 512 + k] = (bf16)f2bf((float)(pr * bi + pi * br));
            Wg[(size_t)(128 + 2 * p) * 512 + k] = (bf16)0; Wg[(size_t)(128 + 2 * p + 1) * 512 + k] = (bf16)0;
        }
    }
    __syncthreads();
}
struct S5AOrder {
    const unsigned char* ws; int c, G;
    __device__ __forceinline__ bool next(int i, pg8::Unit& u) const { const int L = i * G + c; if (L >= 64) return false; u.e = L >> 1; u.pm = L & 1; u.pn = 0; u.rows = 256; return true; }
    __device__ __forceinline__ const char* a_base(const pg8::Unit& u) const { return (const char*)(ws + BG_AUG) + ((size_t)u.e * 512 + u.pm * 256) * 1280; }
    __device__ __forceinline__ const char* b_base(const pg8::Unit& u) const { return (const char*)(ws + BG_S5WE) + (size_t)u.e * 256 * 1024; }
    __device__ __forceinline__ unsigned a_off(const pg8::Unit&, int) const { return 0u; }
};
struct EpiS5A { static constexpr bool PERM = false; float* SL;
    __device__ __forceinline__ void operator()(const pg8::f32x4 (&acc)[2][2][4][2], const pg8::Unit& u, int wr, int wc, int fr, int fq) const {
#pragma unroll
        for (int ai = 0; ai < 2; ++ai)
#pragma unroll
            for (int m = 0; m < 4; ++m) { float* rowp = SL + ((size_t)u.e * 512 + u.pm * 256 + ai * 128 + wr * 64 + m * 16 + fr) * 128 + wc * 32 + 4 * fq;
#pragma unroll
                for (int n = 0; n < 2; ++n) *(f32x4*)(rowp + n * 16) = acc[ai][0][m][n]; }
    }
};
struct S5BOrder {
    const unsigned char* ws; int c, G;
    __device__ __forceinline__ bool next(int i, pg8::Unit& u) const { const int L = i * G + c; if (L >= 128) return false; u.e = L >> 2; u.pm = (L >> 1) & 1; u.pn = L & 1; u.rows = 256; return true; }
    __device__ __forceinline__ const char* a_base(const pg8::Unit& u) const { return (const char*)(ws + BG_AUG) + ((size_t)u.e * 512 + u.pm * 256) * 1280; }
    __device__ __forceinline__ const char* b_base(const pg8::Unit& u) const { return (const char*)(ws + BG_S5MB) + ((size_t)u.e * 512 + u.pn * 256) * 1280; }
    __device__ __forceinline__ unsigned a_off(const pg8::Unit&, int) const { return 0u; }
};
struct EpiS5B { static constexpr bool PERM = false; const unsigned char* ws; const float* dsk; const float* gluw; const float* glub; bf16* MIX;
    __device__ __forceinline__ void operator()(const pg8::f32x4 (&acc)[2][2][4][2], const pg8::Unit& u, int wr, int wc, int fr, int fq) const {
        const int g = u.e; const bf16* AUG = (const bf16*)(ws + BG_AUG);
        const f32x4 d4 = *(const f32x4*)(dsk + g * 16 + 4 * fq), b4 = *(const f32x4*)(glub + g * 16 + 4 * fq);
#pragma unroll
        for (int ai = 0; ai < 2; ++ai)
#pragma unroll
            for (int m = 0; m < 4; ++m) { const int nidx = u.pm * 256 + ai * 128 + wr * 64 + m * 16 + fr;
#pragma unroll
                for (int bj = 0; bj < 2; ++bj)
#pragma unroll
                    for (int n = 0; n < 2; ++n) {
                        const int tau = 16 * u.pn + 8 * bj + 2 * wc + n;
                        const v2u uw = *(const v2u*)(AUG + ((size_t)g * 512 + nidx) * 640 + tau * 16 + 4 * fq);
                        const f32x4 a = acc[ai][bj][m][n];
                        float y[4] = {a.x + d4.x * bflo(uw.x), a.y + d4.y * bfhi(uw.x), a.z + d4.z * bflo(uw.y), a.w + d4.w * bfhi(uw.y)};
#pragma unroll
                        for (int k = 0; k < 4; ++k) { const float v = y[k]; y[k] = 0.5f * v * (1.0f + tanhf(0.7978845608028654f * (v + 0.044715f * v * v * v))); }
                        float z[4] = {b4.x, b4.y, b4.z, b4.w};
#pragma unroll
                        for (int x = 0; x < 4; ++x) {
                            float o[4];
#pragma unroll
                            for (int k = 0; k < 4; ++k) o[k] = (x == 0) ? y[k] : __shfl_xor(y[k], 16 * x);
                            const int hb = 4 * (fq ^ x);
#pragma unroll
                            for (int k = 0; k < 4; ++k) { const f32x4 wv = *(const f32x4*)(gluw + (g * 16 + hb + k) * 16 + 4 * fq);
                                z[0] += o[k] * wv.x; z[1] += o[k] * wv.y; z[2] += o[k] * wv.z; z[3] += o[k] * wv.w; }
                        }
                        const size_t t = (size_t)nidx * 32 + tau;
                        v2u ov; ov.x = pk2(y[0] * sigmoidf_(z[0]), y[1] * sigmoidf_(z[1])); ov.y = pk2(y[2] * sigmoidf_(z[2]), y[3] * sigmoidf_(z[3]));
                        *(v2u*)(MIX + t * D + g * 16 + 4 * fq) = ov;
                        asm volatile("" ::: "memory");
                    } }
    }
};
__device__ __forceinline__ void phase_s5carry(Frame& F) {
    const double* POW = (const double*)(F.ws + BG_POW); const float* SL = (const float*)(F.ws + BG_SL2); bf16* AUG = (bf16*)(F.ws + BG_AUG);
    const int gid = F.bid * 512 + F.tid;
    for (int i = gid; i < 4 * 32 * 64; i += F.G * 512) {
        const int p = i & 63, g = (i >> 6) & 31, b = i >> 11;
        const float ar = (float)POW[2 * ((g * 64 + p) * 33 + 32)], ai = (float)POW[2 * ((g * 64 + p) * 33 + 32) + 1];
        float sr = 0.f, si = 0.f;
#pragma unroll 8
        for (int c = 0; c < 128; ++c) {
            const size_t n = (size_t)g * 512 + b * 128 + c;
            *(unsigned*)(AUG + n * 640 + 512 + 2 * p) = pk2(sr, si);
            const float lr = SL[n * 128 + 2 * p], li = SL[n * 128 + 2 * p + 1];
            const float nr = ar * sr - ai * si + lr, ni = ar * si + ai * sr + li; sr = nr; si = ni;
        }
    }
}

__device__ __forceinline__ unsigned fkey(float f) { const unsigned u = __builtin_bit_cast(unsigned, f); return (u & 0x80000000u) ? ~u : (u | 0x80000000u); }
__device__ __forceinline__ void phase_dsa(Frame& F, ArgsP AR) {
    const bf16* Q = (const bf16*)(F.ws + BG_Q); const bf16* QI = (const bf16*)(F.ws + BG_QI); const bf16* Kb = (const bf16*)(F.ws + BG_K); const bf16* Vb = (const bf16*)(F.ws + BG_V);
    const bf16* KIb = (const bf16*)(F.ws + BG_KI); const float* WI = (const float*)(F.ws + BG_WI); bf16* MIX = (bf16*)(F.ws + BG_MIX);
    LAS unsigned char* wl = F.lds + F.wave * 19456;
    LAS float* sc = (LAS float*)wl;
    LAS float* qf = (LAS float*)(wl + 16384);
    LAS int* list = (LAS int*)(wl + 16384 + 2048);
    const int lane = F.lane;
#pragma unroll 1
    for (int it = F.bid; it < T / 8; it += F.G) {
        const int t = (T / 8 - 1 - it) * 8 + F.wave;
        const int b = t >> 12, tp = t & 4095, n = tp + 1;
        const size_t kb0 = (size_t)b * SEQ;
#pragma unroll
        for (int j = 0; j < 8; ++j) qf[j * 64 + lane] = bf2f(QI[(size_t)t * 512 + j * 64 + lane]);
        float wv[8];
#pragma unroll
        for (int h = 0; h < 8; ++h) wv[h] = WI[(size_t)t * 8 + h];
        LDS_WAIT();
#pragma unroll 1
        for (int s0 = 0; s0 < n; s0 += 64) {
            asm volatile("" ::: "memory");
            const int s = s0 + lane;
            float score = -INFINITY;
            if (s < n) {
                const v4u* kp = (const v4u*)(KIb + (kb0 + s) * 64);
                float dh[8];
#pragma unroll
                for (int h = 0; h < 8; ++h) dh[h] = 0.f;
#pragma unroll 1
                for (int half = 0; half < 2; ++half) {
                    asm volatile("" ::: "memory");
                    float kf[32];
#pragma unroll
                    for (int i = 0; i < 4; ++i) { const v4u w = kp[half * 4 + i]; kf[8 * i] = bflo(w.x); kf[8 * i + 1] = bfhi(w.x); kf[8 * i + 2] = bflo(w.y); kf[8 * i + 3] = bfhi(w.y); kf[8 * i + 4] = bflo(w.z); kf[8 * i + 5] = bfhi(w.z); kf[8 * i + 6] = bflo(w.w); kf[8 * i + 7] = bfhi(w.w); }
#pragma unroll
                    for (int h = 0; h < 8; ++h) { float d = 0.f;
#pragma unroll
                        for (int i = 0; i < 8; ++i) { const f32x4 qv = *(const LAS f32x4*)(qf + h * 64 + half * 32 + 4 * i); d += qv.x * kf[4 * i] + qv.y * kf[4 * i + 1] + qv.z * kf[4 * i + 2] + qv.w * kf[4 * i + 3]; }
                        dh[h] += d; __builtin_amdgcn_sched_barrier(0); }
                }
                float a = 0.f;
#pragma unroll
                for (int h = 0; h < 8; ++h) a += wv[h] * fmaxf(dh[h] * 0.125f, 0.f);
                score = a;
            }
            sc[s] = score;
        }
        LDS_WAIT();
        int nsel;
        if (n <= 256) { for (int i = lane; i < n; i += 64) list[i] = i; nsel = n; }
        else {
            const int nch = (n + 63) >> 6;
            unsigned thr = 0u;
#pragma unroll 1
            for (int bit = 31; bit >= 0; --bit) {
                const unsigned cand = thr | (1u << bit); int cnt = 0;
#pragma unroll 1
                for (int j = 0; j < nch; ++j) { const int s = j * 64 + lane; if (s < n) cnt += (fkey(sc[s]) >= cand) ? 1 : 0; }
                cnt = wave_sum_i(cnt);
                if (cnt >= 256) thr = cand;
            }
            int cgt = 0;
            for (int j = 0; j < nch; ++j) { const int s = j * 64 + lane; if (s < n) cgt += (fkey(sc[s]) > thr) ? 1 : 0; }
            cgt = wave_sum_i(cgt);
            const int need_eq = 256 - cgt;
            int run = 0, eqrun = 0;
            const unsigned long long lt = (lane == 0) ? 0ull : (~0ull >> (64 - lane));
            for (int j = 0; j < nch; ++j) {
                const int s = j * 64 + lane; const bool in = s < n; const unsigned k = in ? fkey(sc[s]) : 0u;
                const bool gt = in && k > thr, eq = in && k == thr;
                const unsigned long long beq = __ballot(eq);
                const int myeq = eqrun + __popcll(beq & lt);
                const bool sel = gt || (eq && myeq < need_eq);
                const unsigned long long bs = __ballot(sel);
                if (sel) list[run + __popcll(bs & lt)] = s;
                run += __popcll(bs); eqrun += __popcll(beq);
            }
            nsel = run;
        }
        LDS_WAIT();
#pragma unroll
        for (int j = 0; j < 8; ++j) qf[j * 64 + lane] = bf2f(Q[(size_t)t * 512 + j * 64 + lane]);
        LDS_WAIT();
        float mx[8];
#pragma unroll
        for (int h = 0; h < 8; ++h) mx[h] = -INFINITY;
#pragma unroll 1
        for (int i0 = 0; i0 < nsel; i0 += 64) {
            asm volatile("" ::: "memory");
            const int i = i0 + lane;
            if (i < nsel) {
                const int s = list[i];
                const v4u* kp = (const v4u*)(Kb + (kb0 + s) * 64);
                float dh[8];
#pragma unroll
                for (int h = 0; h < 8; ++h) dh[h] = 0.f;
#pragma unroll 1
                for (int half = 0; half < 2; ++half) {
                    asm volatile("" ::: "memory");
                    float kf[32];
#pragma unroll
                    for (int q = 0; q < 4; ++q) { const v4u w = kp[half * 4 + q]; kf[8 * q] = bflo(w.x); kf[8 * q + 1] = bfhi(w.x); kf[8 * q + 2] = bflo(w.y); kf[8 * q + 3] = bfhi(w.y); kf[8 * q + 4] = bflo(w.z); kf[8 * q + 5] = bfhi(w.z); kf[8 * q + 6] = bflo(w.w); kf[8 * q + 7] = bfhi(w.w); }
#pragma unroll
                    for (int h = 0; h < 8; ++h) { float d = 0.f;
#pragma unroll
                        for (int q = 0; q < 8; ++q) { const f32x4 qv = *(const LAS f32x4*)(qf + h * 64 + half * 32 + 4 * q); d += qv.x * kf[4 * q] + qv.y * kf[4 * q + 1] + qv.z * kf[4 * q + 2] + qv.w * kf[4 * q + 3]; }
                        dh[h] += d; __builtin_amdgcn_sched_barrier(0); }
                }
#pragma unroll
                for (int h = 0; h < 8; ++h) { const float d = dh[h] * 0.125f; sc[i * 8 + h] = d; mx[h] = fmaxf(mx[h], d); }
            }
        }
        float lsum[8];
#pragma unroll
        for (int h = 0; h < 8; ++h) { mx[h] = wave_max(mx[h]); lsum[h] = 0.f; }
        LDS_WAIT();
        for (int i0 = 0; i0 < nsel; i0 += 64) {
            const int i = i0 + lane;
            if (i < nsel) {
#pragma unroll
                for (int h = 0; h < 8; ++h) { const float pv = __expf(sc[i * 8 + h] - mx[h]); sc[i * 8 + h] = pv; lsum[h] += pv; }
            }
        }
#pragma unroll
        for (int h = 0; h < 8; ++h) lsum[h] = wave_sum(lsum[h]);
        LDS_WAIT();
        float o[8];
#pragma unroll
        for (int h = 0; h < 8; ++h) o[h] = 0.f;
#pragma unroll 2
        for (int i = 0; i < nsel; ++i) {
            const int s = list[i];
            const float v = bf2f(Vb[(kb0 + s) * 64 + lane]);
            const f32x4 p0 = *(const LAS f32x4*)(sc + i * 8), p1 = *(const LAS f32x4*)(sc + i * 8 + 4);
            o[0] += p0.x * v; o[1] += p0.y * v; o[2] += p0.z * v; o[3] += p0.w * v; o[4] += p1.x * v; o[5] += p1.y * v; o[6] += p1.z * v; o[7] += p1.w * v;
        }
#pragma unroll
        for (int h = 0; h < 8; ++h) MIX[(size_t)t * D + 512 + h * 64 + lane] = (bf16)f2bf(o[h] / lsum[h]);
        LDS_WAIT();
    }
}


typedef float f32x16 __attribute__((ext_vector_type(16)));
constexpr int DS_SC = 0;
constexpr int DS_BM = 131072;
constexpr int DS_WT = DS_BM + 8192;
constexpr int DS_MRG = 32768;
__device__ __forceinline__ void swap32(float v, float& lo, float& hi) { float a = v, b = v; asm volatile("s_nop 1\n\tv_permlane32_swap_b32 %0, %1\n\ts_nop 1" : "+v"(a), "+v"(b)); lo = a; hi = b; }
__device__ __forceinline__ float swap32_sum(float v) { float a, b; swap32(v, a, b); return a + b; }
__device__ __forceinline__ float swap32_max(float v) { float a, b; swap32(v, a, b); return fmaxf(a, b); }
__device__ __forceinline__ int wave_sum_dpp(int v) {
    v += __builtin_amdgcn_update_dpp(0, v, 0xB1, 0xF, 0xF, false);
    v += __builtin_amdgcn_update_dpp(0, v, 0x4E, 0xF, 0xF, false);
    v += __builtin_amdgcn_update_dpp(0, v, 0x141, 0xF, 0xF, false);
    v += __builtin_amdgcn_update_dpp(0, v, 0x140, 0xF, 0xF, false);
    return __builtin_amdgcn_readlane(v, 0) + __builtin_amdgcn_readlane(v, 16) + __builtin_amdgcn_readlane(v, 32) + __builtin_amdgcn_readlane(v, 48);
}
__device__ __forceinline__ void phase_dsa2(Frame& F, ArgsP AR, unsigned long long* probe_acc) {
    unsigned long long ps0_ = (PROBE_PHASE >= 300 && PROBE_PHASE < 400) ? __builtin_amdgcn_s_memrealtime() : 0ull;
#define PSECD(id) do { if (PROBE_PHASE >= 300 && PROBE_PHASE < 400) { const unsigned long long n_ = __builtin_amdgcn_s_memrealtime(); if (PROBE_PHASE == 300 + (id)) *probe_acc += n_ - ps0_; ps0_ = n_; } } while (0)
    const bf16* Q = (const bf16*)(F.ws + BG_Q); const bf16* QI = (const bf16*)(F.ws + BG_QI); const bf16* Kb = (const bf16*)(F.ws + BG_K); const bf16* VT = (const bf16*)(F.ws + BG_VT);
    const bf16* KIb = (const bf16*)(F.ws + BG_KI); const float* WI = (const float*)(F.ws + BG_WI); bf16* MIX = (bf16*)(F.ws + BG_MIX);
    LAS unsigned short* SC = (LAS unsigned short*)(F.lds + DS_SC);
    LAS unsigned char* BM = F.lds + DS_BM;
    LAS float* WT = (LAS float*)(F.lds + DS_WT);
    const int lane = F.lane, w = F.wave, tid = F.tid;
    const int r32 = lane & 31, h = lane >> 5;
    const int nunits = T / 16;
#pragma unroll 1
    for (int i = 0; ; ++i) {
        int j = i * F.G + ((i & 1) ? (F.G - 1 - F.bid) : F.bid);
        if (i * F.G >= nunits) break;
        if (j >= nunits) continue;
        const int b = j & 3, qt = j >> 2;
        const int tp0 = qt * 16, t0 = b * SEQ + tp0;
        const int n_keys = tp0 + 16;
        const int nkt = (n_keys + 31) >> 5, n_comp = nkt * 32, nst = (n_keys + 63) >> 6;
        const size_t kb0 = (size_t)b * SEQ;
        PSECD(3);
        if (tid < 128) WT[tid] = WI[(size_t)t0 * 8 + tid] * 0.125f;
        {
            const int ptl = ((r32 >> 2) & 1) * 2 + (r32 >> 4), phd = ((r32 >> 3) & 1) * 4 + (r32 & 3);
            bf16x8 af[4][4];
#pragma unroll
            for (int rb = 0; rb < 4; ++rb)
#pragma unroll
                for (int ks = 0; ks < 4; ++ks) af[rb][ks] = *(const bf16x8*)(QI + ((size_t)(t0 + 4 * rb + ptl) * 8 + phd) * 64 + ks * 16 + h * 8);
            __syncthreads();
            bf16x8 bfr[4], bnx[4];
            if (w < nkt) {
                const bf16* kp = KIb + (kb0 + w * 32 + r32) * 64 + h * 8;
#pragma unroll
                for (int ks = 0; ks < 4; ++ks) bfr[ks] = *(const bf16x8*)(kp + ks * 16);
            }
#pragma unroll 1
            for (int kt = w; kt < nkt; kt += 8) {
                {
                    const int ktn = (kt + 8 < nkt) ? kt + 8 : kt;
                    const bf16* kp = KIb + (kb0 + ktn * 32 + r32) * 64 + h * 8;
#pragma unroll
                    for (int ks = 0; ks < 4; ++ks) bnx[ks] = *(const bf16x8*)(kp + ks * 16);
                }
                const int s = kt * 32 + r32;
#pragma unroll
                for (int rb = 0; rb < 4; ++rb) {
                    f32x16 acc = {0.f, 0.f, 0.f, 0.f, 0.f, 0.f, 0.f, 0.f, 0.f, 0.f, 0.f, 0.f, 0.f, 0.f, 0.f, 0.f};
#pragma unroll
                    for (int ks = 0; ks < 4; ++ks) acc = __builtin_amdgcn_mfma_f32_32x32x16_bf16(af[rb][ks], bfr[ks], acc, 0, 0, 0);
#pragma unroll
                    for (int j = 0; j < 2; ++j) {
                        const int tk = 4 * rb + 2 * h + j;
                        const f32x4 w0 = *(const LAS f32x4*)(WT + tk * 8), w1 = *(const LAS f32x4*)(WT + tk * 8 + 4);
                        const float part = (w0.x * fmaxf(acc[8 * j], 0.f) + w0.y * fmaxf(acc[8 * j + 1], 0.f)) + (w0.z * fmaxf(acc[8 * j + 2], 0.f) + w0.w * fmaxf(acc[8 * j + 3], 0.f))
                                         + (w1.x * fmaxf(acc[8 * j + 4], 0.f) + w1.y * fmaxf(acc[8 * j + 5], 0.f)) + (w1.z * fmaxf(acc[8 * j + 6], 0.f) + w1.w * fmaxf(acc[8 * j + 7], 0.f));
                        const _Float16 hf = (_Float16)part; const unsigned hb = (unsigned)__builtin_bit_cast(unsigned short, hf);
                        const unsigned key = (hb & 0x8000u) ? (~hb & 0xffffu) : (hb | 0x8000u);
                        SC[tk * 4096 + s] = (unsigned short)((s <= tp0 + tk) ? key : 0u);
                    }
                }
#pragma unroll
                for (int ks = 0; ks < 4; ++ks) bfr[ks] = bnx[ks];
            }
        }
        __syncthreads(); PSECD(0);
        {
            typedef unsigned short u16x2 __attribute__((ext_vector_type(2)));
            const int nch = (n_comp + 511) >> 9;
            const int tkA = 2 * w, tkB = 2 * w + 1;
            const LAS v4u* rowA = (const LAS v4u*)(SC + tkA * 4096); const LAS v4u* rowB = (const LAS v4u*)(SC + tkB * 4096);
            const int total = nch * 512;
            auto count_lt = [&](unsigned candA, unsigned candB, int& cA, int& cB) {
                const u16x2 ca = {(unsigned short)candA, (unsigned short)candA}, cb = {(unsigned short)candB, (unsigned short)candB}; const u16x2 one = {1, 1};
                u16x2 accA = {0, 0}, accB = {0, 0};
#pragma unroll 2
                for (int ch = 0; ch < nch; ++ch) {
                    v4u xa = (v4u){0u, 0u, 0u, 0u}, xb = xa; if (ch * 512 + lane * 8 < n_comp) { xa = rowA[ch * 64 + lane]; xb = rowB[ch * 64 + lane]; }
                    const unsigned wa[4] = {xa.x, xa.y, xa.z, xa.w}, wb[4] = {xb.x, xb.y, xb.z, xb.w};
#pragma unroll
                    for (int d = 0; d < 4; ++d) {
                        accA += __builtin_elementwise_min(__builtin_elementwise_sub_sat(ca, __builtin_bit_cast(u16x2, wa[d])), one);
                        accB += __builtin_elementwise_min(__builtin_elementwise_sub_sat(cb, __builtin_bit_cast(u16x2, wb[d])), one);
                    }
                }
                cA = wave_sum_dpp((int)accA.x + (int)accA.y); cB = wave_sum_dpp((int)accB.x + (int)accB.y);
            };
            const int nA = tp0 + tkA + 1, nB = tp0 + tkB + 1;
            unsigned thrA = 0u, thrB = 0u; int geA = total, geB = total;
            if (nB > 256) {
#pragma unroll 1
                for (int bit = 15; bit >= 0; --bit) {
                    const unsigned cA_ = thrA | (1u << bit), cB_ = thrB | (1u << bit); int ltA, ltB;
                    count_lt(cA_, cB_, ltA, ltB);
                    if (total - ltA >= 256) { thrA = cA_; geA = total - ltA; }
                    if (total - ltB >= 256) { thrB = cB_; geB = total - ltB; }
                }
                if (nA <= 256) { thrA = 0u; geA = total; }
            }
            int gtA = 0, gtB = 0;
            { int ltA, ltB; count_lt(thrA + 1u, thrB + 1u, ltA, ltB); gtA = total - ltA; gtB = total - ltB; }
            const int needA = (thrA == 0u) ? 0 : 256 - gtA, needB = (thrB == 0u) ? 0 : 256 - gtB;
            const int eqA = geA - gtA, eqB = geB - gtB;
#pragma unroll 1
            for (int q = 0; q < 2; ++q) {
                const int tk = q ? tkB : tkA; const unsigned thr = q ? thrB : thrA; const int need = q ? needB : needA; const bool all_eq = q ? (eqB == needB) : (eqA == needA);
                const LAS v4u* row = q ? rowB : rowA;
                int run = 0;
#pragma unroll 1
                for (int ch = 0; ch < nch; ++ch) {
                    v4u x = (v4u){0u, 0u, 0u, 0u}; if (ch * 512 + lane * 8 < n_comp) x = row[ch * 64 + lane];
                    const unsigned e[8] = {x.x & 0xffffu, x.x >> 16, x.y & 0xffffu, x.y >> 16, x.z & 0xffffu, x.z >> 16, x.w & 0xffffu, x.w >> 16};
                    unsigned gtb = 0u, eqb = 0u;
#pragma unroll
                    for (int k = 0; k < 8; ++k) { gtb |= (e[k] > thr) ? (1u << k) : 0u; eqb |= (e[k] == thr) ? (1u << k) : 0u; }
                    unsigned selb = gtb;
                    if (need > 0) {
                        if (all_eq) selb |= eqb;
                        else {
                            const int c = __popc(eqb); int inc = c;
#pragma unroll
                            for (int o = 1; o < 64; o <<= 1) { const int up = __shfl_up(inc, o); if (lane >= o) inc += up; }
                            const int before = run + inc - c;
                            int take = need - before; take = take < 0 ? 0 : (take > c ? c : take);
                            unsigned eb = eqb, tb = 0u;
#pragma unroll
                            for (int k = 0; k < 8; ++k) { if (take > 0 && eb) { const unsigned lowb = eb & (0u - eb); tb |= lowb; eb ^= lowb; --take; } }
                            selb |= tb;
                            run += __shfl(inc, 63);
                        }
                    }
                    BM[tk * 512 + ch * 64 + lane] = (unsigned char)selb;
                }
            }
        }
        __syncthreads(); PSECD(1);
        {
            const int rb = w & 3, kh = w >> 2;
            const int tk = 4 * rb + (r32 >> 3);
            bf16x8 qf[4];
#pragma unroll
            for (int ks = 0; ks < 4; ++ks) qf[ks] = *(const bf16x8*)(Q + ((size_t)t0 * 8 + rb * 32 + r32) * 64 + ks * 16 + h * 8);
            f32x16 O0 = {0.f, 0.f, 0.f, 0.f, 0.f, 0.f, 0.f, 0.f, 0.f, 0.f, 0.f, 0.f, 0.f, 0.f, 0.f, 0.f}, O1 = O0;
            float m = -1e30f, l = 0.f;
            const int skey = tid >> 3, sch = tid & 7;
            const bf16* ksrc = Kb + (kb0 + skey) * 64 + sch * 8;
            const bf16* vsrc = VT + ((size_t)b * 64 + skey) * 4096 + sch * 8;
            const int kdst = skey * 128 + ((sch ^ ((skey >> 1) & 7)) << 4);
            const int vf = (skey >> 1) & 15;
            const int vdst0 = skey * 128 + (((2 * sch) ^ vf) << 3), vdst1 = skey * 128 + (((2 * sch + 1) ^ vf) << 3);
            v4u kreg = *(const v4u*)(ksrc), vreg = *(const v4u*)(vsrc);
            { LAS unsigned char* kb_ = F.lds; LAS unsigned char* vb_ = F.lds + 8192;
              *(LAS v4u*)(kb_ + kdst) = kreg; *(LAS v2u*)(vb_ + vdst0) = (v2u){vreg.x, vreg.y}; *(LAS v2u*)(vb_ + vdst1) = (v2u){vreg.z, vreg.w}; }
            __syncthreads();
            const int krow = kh * 32 + r32;
            const int kswz = (krow >> 1) & 7;
            const int vfl0 = ((r32) >> 1) & 15, vfl1 = ((32 + r32) >> 1) & 15;
            constexpr float C2 = 0.125f * 1.4426950408889634f;
#pragma unroll 1
            for (int st = 0; st < nst; ++st) {
                const int cur = (st & 1) * 16384;
                { const int stn = (st + 1 < nst) ? st + 1 : st; kreg = *(const v4u*)(ksrc + (size_t)stn * 64 * 64); vreg = *(const v4u*)(vsrc + stn * 64); }
                const LAS unsigned char* kt_ = F.lds + cur; const LAS unsigned char* vt_ = F.lds + cur + 8192;
                f32x16 sv = {0.f, 0.f, 0.f, 0.f, 0.f, 0.f, 0.f, 0.f, 0.f, 0.f, 0.f, 0.f, 0.f, 0.f, 0.f, 0.f};
#pragma unroll
                for (int ks = 0; ks < 4; ++ks) { const bf16x8 ka = *(const LAS bf16x8*)(kt_ + krow * 128 + (((2 * ks + h) ^ kswz) << 4)); sv = __builtin_amdgcn_mfma_f32_32x32x16_bf16(ka, qf[ks], sv, 0, 0, 0); }
                const unsigned mw = *(const LAS unsigned*)(BM + tk * 512 + (2 * st + kh) * 4) >> (4 * h);
                float mt = fmaxf(fmaxf(sv[0], sv[1]), fmaxf(sv[2], sv[3]));
#pragma unroll
                for (int r = 4; r < 16; r += 4) mt = fmaxf(mt, fmaxf(fmaxf(sv[r], sv[r + 1]), fmaxf(sv[r + 2], sv[r + 3])));
                mt = swap32_max(mt) * C2;
                if (__builtin_amdgcn_ballot_w64(mt > m) != 0ull) {
                    const float mn = fmaxf(m, mt); const float alpha = __builtin_amdgcn_exp2f(m - mn); m = mn;
                    l *= alpha;
#pragma unroll
                    for (int r = 0; r < 16; ++r) { O0[r] *= alpha; O1[r] *= alpha; }
                }
                const float nm = -m;
                float ls = 0.f;
#pragma unroll
                for (int r = 0; r < 16; ++r) { const int kl = (r & 3) + 8 * (r >> 2);
                    const float pe = __builtin_amdgcn_exp2f(__builtin_fmaf(sv[r], C2, nm));
                    const int keep = __builtin_amdgcn_sbfe((int)mw, kl, 1);
                    sv[r] = __builtin_bit_cast(float, __builtin_bit_cast(int, pe) & keep); ls += sv[r]; }
                l += ls;
                bf16x8 pb[2];
#pragma unroll
                for (int s2 = 0; s2 < 2; ++s2) { v4u pk; pk.x = pk2(sv[8 * s2], sv[8 * s2 + 1]); pk.y = pk2(sv[8 * s2 + 2], sv[8 * s2 + 3]); pk.z = pk2(sv[8 * s2 + 4], sv[8 * s2 + 5]); pk.w = pk2(sv[8 * s2 + 6], sv[8 * s2 + 7]); pb[s2] = __builtin_bit_cast(bf16x8, pk); }
#pragma unroll
                for (int s2 = 0; s2 < 2; ++s2) {
                    const int c8 = 8 * kh + 4 * s2 + h;
                    { const v2u a0 = *(const LAS v2u*)(vt_ + r32 * 128 + ((c8 ^ vfl0) << 3)), a1 = *(const LAS v2u*)(vt_ + r32 * 128 + (((c8 + 2) ^ vfl0) << 3));
                      const v4u av = (v4u){a0.x, a0.y, a1.x, a1.y}; O0 = __builtin_amdgcn_mfma_f32_32x32x16_bf16(__builtin_bit_cast(bf16x8, av), pb[s2], O0, 0, 0, 0); }
                    { const v2u a0 = *(const LAS v2u*)(vt_ + (32 + r32) * 128 + ((c8 ^ vfl1) << 3)), a1 = *(const LAS v2u*)(vt_ + (32 + r32) * 128 + (((c8 + 2) ^ vfl1) << 3));
                      const v4u av = (v4u){a0.x, a0.y, a1.x, a1.y}; O1 = __builtin_amdgcn_mfma_f32_32x32x16_bf16(__builtin_bit_cast(bf16x8, av), pb[s2], O1, 0, 0, 0); }
                }
                { LAS unsigned char* kb_ = F.lds + (cur ^ 16384); LAS unsigned char* vb_ = kb_ + 8192;
                    *(LAS v4u*)(kb_ + kdst) = kreg; *(LAS v2u*)(vb_ + vdst0) = (v2u){vreg.x, vreg.y}; *(LAS v2u*)(vb_ + vdst1) = (v2u){vreg.z, vreg.w}; }
                __syncthreads();
            }
            l = swap32_sum(l);
            LAS float* mg = (LAS float*)(F.lds + DS_MRG + rb * 8704);
            if (kh == 1) {
#pragma unroll
                for (int r = 0; r < 16; ++r) { mg[r * 64 + lane] = O0[r]; mg[(16 + r) * 64 + lane] = O1[r]; }
                if (h == 0) { mg[2048 + r32] = m; mg[2048 + 32 + r32] = l; }
            }
            __syncthreads();
            if (kh == 0) {
                const float m1 = mg[2048 + r32], l1 = mg[2048 + 32 + r32];
                const float mf = fmaxf(m, m1); const float a0 = __builtin_amdgcn_exp2f(m - mf), a1 = __builtin_amdgcn_exp2f(m1 - mf);
                const float inv = 1.0f / (l * a0 + l1 * a1);
                bf16* orow = MIX + (size_t)(t0 + tk) * D + 512 + (r32 & 7) * 64;
#pragma unroll
                for (int g4 = 0; g4 < 4; ++g4) {
                    float o0[4], o1[4];
#pragma unroll
                    for (int k = 0; k < 4; ++k) { const int r = 4 * g4 + k; o0[k] = (O0[r] * a0 + mg[r * 64 + lane] * a1) * inv; o1[k] = (O1[r] * a0 + mg[(16 + r) * 64 + lane] * a1) * inv; }
                    v2u s0; s0.x = pk2(o0[0], o0[1]); s0.y = pk2(o0[2], o0[3]); *(v2u*)(orow + 8 * g4 + 4 * h) = s0;
                    v2u s1; s1.x = pk2(o1[0], o1[1]); s1.y = pk2(o1[2], o1[3]); *(v2u*)(orow + 32 + 8 * g4 + 4 * h) = s1;
                }
            }
            __syncthreads(); PSECD(2);
        }
    }
}

constexpr int LDS_RT = 131072;
__device__ __forceinline__ void phase_router(Frame& F, ArgsP AR, int l) {
    const float* X = F.out; const float* gamma = FIN(6) + (size_t)l * D; const int m = 2 * l + 1;
    const float* MOD = (const float*)(F.ws + WS_MOD); const float* RW = FIN(25) + (size_t)l * D * 64; const float* RB = FIN(26) + (size_t)l * 64;
    bf16* Hout = (bf16*)(F.ws + WS_H); unsigned* ctl = (unsigned*)(F.ws + WS_CTL);
    int* EIDX = (int*)(F.ws + WS_EIDX); int* SLOT = (int*)(F.ws + WS_SLOT); int* ELT = (int*)(F.ws + WS_ELT); float* ELW = (float*)(F.ws + WS_ELW);
    constexpr int HS = 1028;
    LAS float* hbuf = (LAS float*)F.lds;
    LAS float* part = (LAS float*)(F.lds + 69632);
    LAS int* lcnt = (LAS int*)(F.lds + LDS_RT); LAS int* lbase = lcnt + 64;
    const int lane = F.lane, w = F.wave;
    const float rb = RB[lane];
    if (F.tid < 64) lcnt[F.tid] = 0;
    const int nround = (T / 16 + F.G - 1) / F.G;
#pragma unroll 1
    for (int rd = 0; rd < nround; ++rd) {
        const int blk = rd * F.G + F.bid;
        const bool live = blk < T / 16;
        const int base = blk * 16;
        __syncthreads();
        if (live) {
            const int b = base >> 12;
            const float* shift = MOD + (size_t)(m * 4 + b) * 3072; const float* scale = shift + 1024;
#pragma unroll
            for (int q = 0; q < 2; ++q) {
                const int tl = 2 * w + q, row = base + tl;
                const f32x4* xr = (const f32x4*)(X + (size_t)row * D) + lane;
                f32x4 v[4]; float ss = 0.f;
#pragma unroll
                for (int j = 0; j < 4; ++j) { v[j] = xr[64 * j]; ss += v[j].x * v[j].x + v[j].y * v[j].y + v[j].z * v[j].z + v[j].w * v[j].w; }
                const float rstd = rsqrtf(wave_sum(ss) * (1.0f / D) + 1e-6f);
#pragma unroll
                for (int j = 0; j < 4; ++j) {
                    const int c0 = 4 * lane + 256 * j;
                    const f32x4 gg = *(const f32x4*)(gamma + c0), sc = *(const f32x4*)(scale + c0), sh = *(const f32x4*)(shift + c0);
                    f32x4 h; h.x = v[j].x * rstd * gg.x * (1.f + sc.x) + sh.x; h.y = v[j].y * rstd * gg.y * (1.f + sc.y) + sh.y;
                    h.z = v[j].z * rstd * gg.z * (1.f + sc.z) + sh.z; h.w = v[j].w * rstd * gg.w * (1.f + sc.w) + sh.w;
                    v2u o; o.x = pk2(h.x, h.y); o.y = pk2(h.z, h.w); *(v2u*)(Hout + (size_t)row * D + c0) = o;
                    *(LAS f32x4*)(hbuf + tl * HS + c0) = h;
                }
            }
        }
        __syncthreads();
        if (live) {
            f32x4 c4[4];
#pragma unroll
            for (int j = 0; j < 4; ++j) c4[j] = (f32x4){0.f, 0.f, 0.f, 0.f};
            const LAS float* ap = hbuf + (lane & 15) * HS + 128 * w + (lane >> 4);
            const float* rw = RW + (size_t)(128 * w + (lane >> 4)) * 64 + (lane & 15);
#pragma unroll 1
            for (int half = 0; half < 2; ++half) {
                float bw[16][4];
#pragma unroll
                for (int ks = 0; ks < 16; ++ks)
#pragma unroll
                    for (int j = 0; j < 4; ++j) bw[ks][j] = rw[(size_t)(16 * half + ks) * 256 + 16 * j];
#pragma unroll
                for (int ks = 0; ks < 16; ++ks) { const float a = ap[4 * (16 * half + ks)];
#pragma unroll
                    for (int j = 0; j < 4; ++j) c4[j] = __builtin_amdgcn_mfma_f32_16x16x4f32(a, bw[ks][j], c4[j], 0, 0, 0); }
            }
#pragma unroll
            for (int j = 0; j < 4; ++j)
#pragma unroll
                for (int r = 0; r < 4; ++r) part[(w * 16 + 4 * (lane >> 4) + r) * 64 + 16 * j + (lane & 15)] = c4[j][r];
        }
        __syncthreads();
        float gwt[2]; int rk[2], lp[2];
#pragma unroll
        for (int q = 0; q < 2; ++q) { gwt[q] = 0.f; rk[q] = -1; lp[q] = 0; }
        if (live) {
#pragma unroll
            for (int q = 0; q < 2; ++q) {
                const int tl = 2 * w + q;
                float lg = 0.f;
#pragma unroll
                for (int ww = 0; ww < 8; ++ww) lg += part[(ww * 16 + tl) * 64 + lane];
                const float score = sigmoidf_(lg);
                const float sel = score + rb;
                float m1 = sel; m1 = fmaxf(m1, __shfl_xor(m1, 1)); m1 = fmaxf(m1, __shfl_xor(m1, 2)); m1 = fmaxf(m1, __shfl_xor(m1, 4));
                const unsigned long long bm = __ballot(sel == m1);
                const int g = lane >> 3; const unsigned gm = (unsigned)((bm >> (8 * g)) & 0xffull); const int first = 8 * g + __builtin_ctz(gm);
                float m2 = (lane == first) ? -INFINITY : sel; m2 = fmaxf(m2, __shfl_xor(m2, 1)); m2 = fmaxf(m2, __shfl_xor(m2, 2)); m2 = fmaxf(m2, __shfl_xor(m2, 4));
                const float gs = m1 + m2;
                int grank = 0;
#pragma unroll
                for (int gg = 0; gg < 8; ++gg) { const float o = __builtin_bit_cast(float, __builtin_amdgcn_readlane(__builtin_bit_cast(int, gs), gg * 8)); grank += (o > gs || (o == gs && gg < g)) ? 1 : 0; }
                const float masked = (grank < 4) ? sel : -INFINITY;
                int rank = 0;
#pragma unroll 8
                for (int e = 0; e < 64; ++e) { const float o = __builtin_bit_cast(float, __builtin_amdgcn_readlane(__builtin_bit_cast(int, masked), e)); rank += (o > masked || (o == masked && e < lane)) ? 1 : 0; }
                const bool chosen = rank < 8;
                const float wsum = wave_sum(chosen ? score : 0.f);
                gwt[q] = score / wsum * 2.5f; rk[q] = chosen ? rank : -1;
                if (chosen) lp[q] = __hip_atomic_fetch_add(&lcnt[lane], 1, __ATOMIC_RELAXED, __HIP_MEMORY_SCOPE_WORKGROUP);
            }
        }
        __syncthreads();
        if (F.tid < 64) { const int c = lcnt[F.tid]; int gb = 0; if (c > 0) gb = (int)atomicAdd(&ctl[CW_CNT + (l * 64 + F.tid) * 64], (unsigned)c); lbase[F.tid] = gb; lcnt[F.tid] = 0; }
        __syncthreads();
        if (live) {
            const int gb = lbase[lane];
#pragma unroll
            for (int q = 0; q < 2; ++q) if (rk[q] >= 0) {
                const int row = base + 2 * w + q, pos = gb + lp[q];
                ELT[(size_t)lane * ECAP + pos] = row; ELW[(size_t)lane * ECAP + pos] = gwt[q];
                EIDX[(size_t)row * 8 + rk[q]] = lane; SLOT[(size_t)row * 8 + rk[q]] = pos;
            }
        }
    }
    __syncthreads();
}
__device__ __forceinline__ void phase_pool(Frame& F) {
    const float* Hf = (const float*)(F.ws + BG_H2F); bf16* P = (bf16*)(F.ws + WS_H);
    for (int row = F.gw; row < T; row += F.NGW) {
        const int tp = row & 4095;
#pragma unroll
        for (int j = 0; j < 4; ++j) {
            const int win = 2 << j, c0 = 4 * F.lane + 256 * j;
            const int lo = (tp - win + 1) > 0 ? (tp - win + 1) : 0; const int cnt = tp - lo + 1;
            f32x4 s = (f32x4){0.f, 0.f, 0.f, 0.f};
            for (int q = 0; q < cnt; ++q) s = s + *(const f32x4*)(Hf + (size_t)(row - q) * D + c0);
            const f32x4 h = *(const f32x4*)(Hf + (size_t)row * D + c0);
            const float inv = 1.0f / (float)cnt;
            v2u o; o.x = pk2(s.x * inv - h.x, s.y * inv - h.y); o.y = pk2(s.z * inv - h.z, s.w * inv - h.w);
            *(v2u*)(P + (size_t)row * D + c0) = o;
        }
    }
}

constexpr int NPHASE = 29;
__global__ void __launch_bounds__(512, 2) mega(Args args_formal) {
    ArgsP const ap0 = (ArgsP)__builtin_amdgcn_kernarg_segment_ptr();
    extern __shared__ __attribute__((aligned(16))) unsigned char lds_raw[];
    Frame F;
    F.lds = (LAS unsigned char*)lds_raw;
    F.tid = threadIdx.x; F.lane = F.tid & 63; F.wave = __builtin_amdgcn_readfirstlane(F.tid >> 6);
    F.bid = blockIdx.x; F.G = gridDim.x; F.gw = F.bid * 8 + F.wave; F.NGW = F.G * 8;
    F.out = ap0->out; F.ws = ap0->ws;
    unsigned* ctl = (unsigned*)(F.ws + WS_CTL);
    const int lo = ap0->ph_lo, hi = ap0->ph_hi;
    volatile LAS unsigned* bst = (volatile LAS unsigned*)(F.lds + LDS_BYTES - 16);
    XcdBarrier bar; bar.bar = ctl + CW_BAR; bar.x = 0; bar.st = bst;
    const bool multi = (hi - lo) > 1;
    if (multi) { if (F.tid == 0) { bst[0] = 0u; bst[1] = 0u; } __syncthreads(); bar = xcd_barrier_post(ctl + CW_BAR, bst); }
    unsigned long long probe_t0 = 0ull, probe_dt = 0ull, probe_sec = 0ull;
#ifndef PROBE_EXTRA_BAR
#define PROBE_EXTRA_BAR 0
#endif
#ifndef PROBE_DUP
#define PROBE_DUP 0ull
#endif
#ifndef PHMASK
#define PHMASK 0xFFFFFFFFull
#endif
#define IN(k) ((((PHMASK) >> ((k) >= 20 ? (k) - 10 : (k))) & 1ull) && lo <= (k) && (k) < hi)
#define SEAM(k) do { if ((k) + 1 < hi) xcd_barrier(bar); } while (0)
#define PH_BEGIN(k) if ((k) == PROBE_PHASE) probe_t0 = __builtin_amdgcn_s_memrealtime(); if (IN(k)) { { int t_ = threadIdx.x; asm volatile("" : "+v"(t_)); F.tid = t_; F.lane = t_ & 63; F.wave = __builtin_amdgcn_readfirstlane(t_ >> 6); F.gw = F.bid * 8 + F.wave; } ArgsP args = launder_args(ap0); ArgsP AR = args; (void)AR; F.out = args->out; F.ws = args->ws; ctl = (unsigned*)(F.ws + WS_CTL); const float* MOD = (const float*)(F.ws + WS_MOD); (void)MOD; _Pragma("unroll 1") for (int rep_ = 0; rep_ < ((((PROBE_DUP) >> ((k) >= 20 ? (k) - 10 : (k))) & 1ull) ? 2 : 1); ++rep_) { if (rep_) __syncthreads();
#define PH_END(k) } } if (multi && lo <= (k) && (k) < hi && (k) + 1 < hi) { xcd_barrier(bar); if ((k) == 0) { for (int xb_ = 0; xb_ < PROBE_EXTRA_BAR; ++xb_) xcd_barrier(bar); } } if ((k) == PROBE_PHASE) probe_dt = __builtin_amdgcn_s_memrealtime() - probe_t0;
    PH_BEGIN(0) phase_mod(F, args); __syncthreads(); phase_s5mats(F, args); phase_convert_static(F, args); phase_tables(F, args); phase_convert_experts(F, args, 0); PH_END(0)
    PH_BEGIN(1) phase_norm_mod(F, FIN(0), FIN(3), 0, (bf16*)(F.ws + WS_H), nullptr); PH_END(1)
    PH_BEGIN(3) DenseOrder S; S.init(F.ws + WS_H, F.ws + WS_WIN, 2048u, 2048u, T, INP, F.G, F.bid); EpiBf16Store E{(bf16*)(F.ws + BG_PROJ), INP};
        pg8::gemm_phase<EpiBf16Store, DenseOrder, false>(F.lds, F.tid, 1024, 2048u, 2048u, S, E); PH_END(3)
    PH_BEGIN(4) phase_postproj(F, args); PH_END(4)
    PH_BEGIN(5) S5AOrder S{F.ws, F.bid, F.G}; EpiS5A E{(float*)(F.ws + BG_SL2)}; pg8::gemm_phase<EpiS5A, S5AOrder, false>(F.lds, F.tid, 512, 1280u, 1024u, S, E); PH_END(5)
    PH_BEGIN(6) phase_s5carry(F); phase_dsa2(F, args, &probe_sec); PH_END(6)
    PH_BEGIN(7) S5BOrder S{F.ws, F.bid, F.G}; EpiS5B E{F.ws, FIN(18), FIN(19), FIN(20), (bf16*)(F.ws + BG_MIX)}; pg8::gemm_phase<EpiS5B, S5BOrder, false>(F.lds, F.tid, 640, 1280u, 1280u, S, E); PH_END(7)
    PH_BEGIN(9) DenseOrder S; S.init(F.ws + BG_MIX, F.ws + WS_WOUT, 2048u, 2048u, T, D, F.G, F.bid); EpiResidual E{FIN(0), F.out, MOD + 2048, nullptr, 0};
        pg8::gemm_phase<EpiResidual, DenseOrder, false>(F.lds, F.tid, 1024, 2048u, 2048u, S, E); PH_END(9)
#define MOE_PHASES(pb, l) \
    PH_BEGIN(pb) phase_router(F, args, l); PH_END(pb) \
    PH_BEGIN(pb + 1) moe_tables(F, l); typedef MoeOrder<2, true> O; O S; S.init(F.lds, F.ws, false, true, F.G, F.bid); EpiGateUp<O> E{&S, F.ws}; \
        pg8::gemm_phase<EpiGateUp<O>, O, true>(F.lds, F.tid, 1024, 2048u, 2048u, S, E); PH_END(pb + 1) \
    PH_BEGIN(pb + 2) moe_tables(F, l); typedef MoeOrder<4, false> O; O S; S.init(F.lds, F.ws, false, false, F.G, F.bid); EpiDown<O, false> E{&S, F.ws, F.out, MOD + (size_t)((2 * l + 1) * 4) * 3072 + 2048}; \
        pg8::gemm_phase<EpiDown<O, false>, O, false>(F.lds, F.tid, 256, 512u, 512u, S, E); PH_END(pb + 2) \
    PH_BEGIN(pb + 3) moe_tables(F, l); typedef MoeOrder<4, false> O; O S; S.init(F.lds, F.ws, true, true, F.G, F.bid); EpiDown<O, true> E{&S, F.ws, F.out, MOD + (size_t)((2 * l + 1) * 4) * 3072 + 2048}; \
        pg8::gemm_phase<EpiDown<O, true>, O, false>(F.lds, F.tid, 256, 512u, 512u, S, E); PH_END(pb + 3)
    MOE_PHASES(10, 0)
    PH_BEGIN(17) phase_norm_mod(F, F.out, FIN(3) + D, 2, nullptr, (float*)(F.ws + BG_H2F)); phase_convert_experts(F, args, 1); PH_END(17)
    PH_BEGIN(18) phase_pool(F); PH_END(18)
    PH_BEGIN(19) PoolOrder S; S.init(F.ws + WS_H, F.ws + WS_WPOOL, F.G, F.bid); EpiResidual E{F.out, F.out, MOD + (size_t)(2 * 4) * 3072 + 2048, FIN(24), 1};
        pg8::gemm_phase<EpiResidual, PoolOrder, false>(F.lds, F.tid, 256, 2048u, 512u, S, E); PH_END(19)
    MOE_PHASES(20, 1)
    if (PROBE_PHASE >= 0 && F.bid == 0 && F.wave == 0) { const unsigned long long te = __builtin_amdgcn_s_memrealtime() + (unsigned long long)PROBE_AMP * (PROBE_PHASE >= 100 ? probe_sec : probe_dt); while (__builtin_amdgcn_s_memrealtime() < te) __builtin_amdgcn_s_sleep(16); }
}

extern "C" void kernel_launch(void* const* d_in, const int* in_sizes, int n_in, void* d_out, int out_size, void* d_ws, size_t ws_size, hipStream_t stream) {
    static int grid = 0;
    if (grid == 0) {
        int dev = 0, cus = 0;
        if (n_in != 33 || ws_size < WS_END) { fprintf(stderr, "kernel_launch: unexpected n_in %d or ws_size %zu (need %zu)\n", n_in, ws_size, (size_t)WS_END); grid = -1; return; }
        if (hipGetDevice(&dev) != hipSuccess || hipDeviceGetAttribute(&cus, hipDeviceAttributeMultiprocessorCount, dev) != hipSuccess) { grid = -1; return; }
        if (hipFuncSetAttribute((const void*)mega, hipFuncAttributeMaxDynamicSharedMemorySize, LDS_BYTES) != hipSuccess) { fprintf(stderr, "kernel_launch: hipFuncSetAttribute failed\n"); grid = -1; return; }
        (void)hipGetLastError();
        grid = cus - (cus % 8); if (grid <= 0) grid = cus;
    }
    if (grid < 0) return;
    (void)hipMemsetAsync((char*)d_ws + WS_CTL, 0, CTL_ZERO_BYTES, stream);
    Args a{};
    for (int i = 0; i < 33; ++i) a.in[i] = (const float*)d_in[i];
    a.out = (float*)d_out; a.ws = (unsigned char*)d_ws;
    const int last = 24;
#if MK_LAUNCH_PER_PHASE
    for (int p = 0; p < last; ++p) { a.ph_lo = p; a.ph_hi = p + 1; hipLaunchKernelGGL(mega, dim3(grid), dim3(512), LDS_BYTES, stream, a); }
#else
    a.ph_lo = 0; a.ph_hi = last; hipLaunchKernelGGL(mega, dim3(grid), dim3(512), LDS_BYTES, stream, a);
#endif
}
```

```cpp
#include <hip/hip_runtime.h>
#include <cstdio>
#include <cstdint>

#ifndef PROBE_PHASE
#define PROBE_PHASE -1
#endif
#ifndef PROBE_AMP
#define PROBE_AMP 8
#endif
#ifndef MK_LAUNCH_PER_PHASE
#define MK_LAUNCH_PER_PHASE 0
#endif

#define GAS __attribute__((address_space(1)))
#define LAS __attribute__((address_space(3)))
typedef unsigned short bf16;
typedef unsigned v4u __attribute__((ext_vector_type(4)));
typedef unsigned v2u __attribute__((ext_vector_type(2)));
typedef float f32x4 __attribute__((ext_vector_type(4)));
typedef short bf16x8 __attribute__((ext_vector_type(8)));
#define LDS_WAIT() asm volatile("s_waitcnt lgkmcnt(0)" ::: "memory")
#define VM_WAIT() asm volatile("s_waitcnt vmcnt(0)" ::: "memory")

constexpr int NB = 4, SEQ = 4096, T = NB * SEQ, D = 1024;
constexpr int INW = 1736, INP = 1792;
constexpr int NEXP = 64, EDIM = 256;
constexpr int NASSIGN = T * 8;
constexpr int ECAP = T;

constexpr size_t MiB = 1u << 20;
constexpr size_t WS_CTL = 0;
constexpr size_t CTL_ZERO_BYTES = 1 * MiB;
constexpr size_t WS_MOD = 1 * MiB;
constexpr size_t WS_ROPE = WS_MOD + 256 * 1024;
constexpr size_t WS_S5T = WS_ROPE + 1 * MiB;
constexpr size_t WS_WIN = 4 * MiB;
constexpr size_t WS_WOUT = WS_WIN + (size_t)INP * D * 2;
constexpr size_t WS_WPOOL = WS_WOUT + (size_t)D * D * 2;
constexpr size_t WS_WGU = 10 * MiB;
constexpr size_t WS_WD = WS_WGU + (size_t)65 * 512 * 1024 * 2;
constexpr size_t WS_H = WS_WD + (size_t)65 * 1024 * 256 * 2;
constexpr size_t WS_EIDX = WS_H + (size_t)T * D * 2;
constexpr size_t WS_SLOT = WS_EIDX + (size_t)T * 8 * 4;
constexpr size_t WS_ELT = WS_SLOT + (size_t)T * 8 * 4;
constexpr size_t WS_ELW = WS_ELT + (size_t)NEXP * ECAP * 4;
constexpr size_t WS_BIG = WS_ELW + (size_t)NEXP * ECAP * 4;
constexpr size_t BG_PROJ = WS_BIG;
constexpr size_t BG_U = BG_PROJ + (size_t)T * INP * 4;
constexpr size_t BG_Q = BG_U + (size_t)T * 512 * 4;
constexpr size_t BG_QI = BG_Q + (size_t)T * 512 * 2;
constexpr size_t BG_K = BG_QI + (size_t)T * 512 * 2;
constexpr size_t BG_V = BG_K + (size_t)T * 64 * 2;
constexpr size_t BG_KI = BG_V + (size_t)T * 64 * 2;
constexpr size_t BG_WI = BG_KI + (size_t)T * 64 * 2;
constexpr size_t BG_SLOC = BG_WI + (size_t)T * 8 * 4;
constexpr size_t BG_SIN = BG_SLOC + (size_t)4 * 32 * 64 * 64 * 2 * 4;
constexpr size_t BG_MIX = BG_SIN + (size_t)4 * 32 * 64 * 64 * 2 * 4;
constexpr size_t BG_VT = BG_MIX + (size_t)T * D * 2;
constexpr size_t BG_POW = BG_VT + (size_t)T * 64 * 2;
constexpr size_t BG_S5MB = BG_POW + (size_t)32 * 64 * 33 * 16;
constexpr size_t BG_S5WE = BG_S5MB + (size_t)32 * 512 * 640 * 2;
constexpr size_t BG_AUG = BG_S5WE + (size_t)32 * 256 * 512 * 2;
constexpr size_t BG_SL2 = BG_AUG + (size_t)32 * 512 * 640 * 2;
constexpr size_t BG_MIXER_END = BG_SL2 + (size_t)32 * 512 * 128 * 4;
constexpr size_t BG_HB = WS_BIG;
constexpr size_t BG_HBSH = BG_HB + (size_t)(NASSIGN + 256) * 256 * 2;
constexpr size_t BG_Y = BG_HBSH + (size_t)T * 256 * 2;
constexpr size_t BG_YSH = BG_Y + (size_t)NASSIGN * D;
constexpr size_t BG_MOE_END = BG_YSH + (size_t)T * D;
constexpr size_t BG_H2F = WS_BIG;
constexpr size_t WS_END = (BG_MOE_END > BG_MIXER_END ? BG_MOE_END : BG_MIXER_END);
static_assert(BG_H2F + (size_t)T * D * 4 <= BG_HBSH, "H2F must stay inside the dead HB region");
static_assert(WS_END <= 539993216ull, "workspace map exceeds the guaranteed d_ws size");

constexpr int S5_ABAR = 0;
constexpr int S5_A64 = S5_ABAR + 32 * 64 * 2;
constexpr int S5_BBR = S5_A64 + 32 * 64 * 2;
constexpr int S5_BBI = S5_BBR + 32 * 64 * 16;

constexpr int CW_BAR = 4096;
constexpr int CW_CNT = 16384;
constexpr int CW_EST = 16384 + 256;
constexpr int CW_NT = 16384 + 512;
constexpr int CW_TE = 16384 + 1024;
constexpr int CW_TJ = 16384 + 4096;
constexpr int LDS_BYTES = 163840;

__device__ __forceinline__ unsigned f2bf(float f) { unsigned u = __builtin_bit_cast(unsigned, f); return (u + 0x7fffu + ((u >> 16) & 1u)) >> 16; }
typedef float f32x2_t __attribute__((ext_vector_type(2))); typedef __bf16 bf16x2_t __attribute__((ext_vector_type(2)));
__device__ __forceinline__ unsigned pk2(float lo, float hi) { const f32x2_t v = {lo, hi}; const bf16x2_t b = __builtin_convertvector(v, bf16x2_t); return __builtin_bit_cast(unsigned, b); }
__device__ __forceinline__ float bf2f(unsigned b) { return __builtin_bit_cast(float, b << 16); }
__device__ __forceinline__ float bflo(unsigned w) { return __builtin_bit_cast(float, w << 16); }
__device__ __forceinline__ float bfhi(unsigned w) { return __builtin_bit_cast(float, w & 0xffff0000u); }
__device__ __forceinline__ float wave_sum(float v) {
#pragma unroll
    for (int o = 1; o < 64; o <<= 1) v += __shfl_xor(v, o);
    return v;
}
__device__ __forceinline__ float wave_max(float v) {
#pragma unroll
    for (int o = 1; o < 64; o <<= 1) v = fmaxf(v, __shfl_xor(v, o));
    return v;
}
__device__ __forceinline__ int wave_sum_i(int v) {
#pragma unroll
    for (int o = 1; o < 64; o <<= 1) v += __shfl_xor(v, o);
    return v;
}
__device__ __forceinline__ float sigmoidf_(float x) { return 1.0f / (1.0f + __expf(-x)); }

namespace pg8 {
typedef float f32x4 __attribute__((ext_vector_type(4)));
constexpr int BM = 256, BK = 64, HALF = 128, HTB = HALF * BK * 2, STAGE_BYTES = 8 * HTB;
__host__ __device__ __forceinline__ int lds_byte(int r, int c) { const int st = (r >> 4) * 2 + (c >> 5), rr = r & 15, cc = c & 31, ob = rr * 64 + cc * 2; return st * 1024 + (ob ^ (((ob >> 9) & 1) << 5)); }
__host__ __device__ __forceinline__ int perm32(int rho) { const int n = rho >> 4, i = rho & 15; return 8 * (i >> 2) + 4 * n + (i & 3); }
__host__ __device__ __forceinline__ void stage_rc(int b, int& R, int& C) { const int st = b / 1024, sb = b % 1024, swz = sb ^ (((sb >> 9) & 1) << 5); R = (st >> 1) * 16 + swz / 64; C = (st & 1) * 32 + (swz % 64) / 2; }
struct Unit { int pm, pn, e, rows; };
template <class Epi, class Sched, bool GATHER>
__device__ __forceinline__ void gemm_phase(LAS unsigned char* lds, const int tid, const int K, const unsigned lda_b, const unsigned ldb_b, const Sched& S, const Epi& E) {
    const int wid = __builtin_amdgcn_readfirstlane(tid >> 6), lane = tid & 63, wr = wid >> 2, wc = wid & 3, fr = lane & 15, fq = lane >> 4;
    const int nt = K / BK;
    unsigned voffA[2], voffB[2]; int RA[2], CA[2];
#pragma unroll
    for (int i = 0; i < 2; ++i) { int R, C; stage_rc(tid * 16 + i * 8192, R, C); RA[i] = R; CA[i] = C; const int Rb = Epi::PERM ? ((R & ~31) + perm32(R & 31)) : R; voffA[i] = (unsigned)R * lda_b + (unsigned)C * 2u; voffB[i] = (unsigned)Rb * ldb_b + (unsigned)C * 2u; }
    const size_t kstep = (size_t)(BK * 2);
    const size_t hstepA = (size_t)HALF * lda_b, hstepB = (size_t)HALF * ldb_b;
    const unsigned ldsw = (unsigned)wid * 1024u;
    const int aoff = lds_byte(wr * 64 + fr, fq * 8), boff = lds_byte(wc * 32 + fr, fq * 8);
#define PG8_SA(b, h) (((b) * 2 + (h)) * HTB)
#define PG8_SB(b, h) ((4 + (b) * 2 + (h)) * HTB)
#define PG8_STAGE(bufoff, gbase, voff) do { _Pragma("unroll") for (int _i = 0; _i < 2; ++_i) \
        __builtin_amdgcn_global_load_lds((const unsigned*)((const char*)(gbase) + (voff)[_i]), (LAS unsigned*)(lds + (bufoff) + ldsw + _i * 8192), 16, 0, 0); } while (0)
#define PG8_STAGE_A(bufoff, gbase, h, OS) do { if constexpr (GATHER) { PG8_STAGE(bufoff, gbase, g##OS##h); } else { PG8_STAGE(bufoff, (gbase) + (h) * hstepA, voffA); } } while (0)
#define PG8_LDA(dst, b, h) do { _Pragma("unroll") for (int m = 0; m < 4; ++m) _Pragma("unroll") for (int k = 0; k < 2; ++k) dst[m][k] = *(const LAS bf16x8*)(lds + PG8_SA(b, h) + aoff + m * 2048 + k * 1024); } while (0)
#define PG8_LDB(dst, b, h) do { _Pragma("unroll") for (int n = 0; n < 2; ++n) _Pragma("unroll") for (int k = 0; k < 2; ++k) dst[n][k] = *(const LAS bf16x8*)(lds + PG8_SB(b, h) + boff + n * 2048 + k * 1024); } while (0)
#define PG8_MMA(ai, bj, At, Bt) do { __builtin_amdgcn_s_setprio(1); _Pragma("unroll") for (int m = 0; m < 4; ++m) _Pragma("unroll") for (int n = 0; n < 2; ++n) _Pragma("unroll") for (int k = 0; k < 2; ++k) \
        acc[ai][bj][m][n] = __builtin_amdgcn_mfma_f32_16x16x32_bf16(Bt[n][k], At[m][k], acc[ai][bj][m][n], 0, 0, 0); __builtin_amdgcn_s_setprio(0); } while (0)
#define PG8_WAIT_V(n) asm volatile("s_waitcnt vmcnt(" #n ")" ::: "memory")
#define PG8_WAIT_L(n) asm volatile("s_waitcnt lgkmcnt(" #n ")" ::: "memory")
#define PG8_BAR __builtin_amdgcn_s_barrier()
#define PG8_SCHED __builtin_amdgcn_sched_barrier(0)
    Unit cur, nxt; int ui = 0;
    if (!S.next(0, cur)) return;
    f32x4 acc[2][2][4][2];
#pragma unroll
    for (int a = 0; a < 2; ++a)
#pragma unroll
        for (int b = 0; b < 2; ++b)
#pragma unroll
            for (int m = 0; m < 4; ++m)
#pragma unroll
                for (int n = 0; n < 2; ++n) acc[a][b][m][n] = (f32x4){0.f, 0.f, 0.f, 0.f};
    bf16x8 At[4][2], B0[2][2], B1[2][2];
    unsigned gc0[2] = {0u, 0u}, gc1[2] = {0u, 0u}, gn0[2] = {0u, 0u}, gn1[2] = {0u, 0u};
    const char* cA = S.a_base(cur); const char* cB = S.b_base(cur);
    if constexpr (GATHER) {
#pragma unroll
        for (int i = 0; i < 2; ++i) { gc0[i] = S.a_off(cur, RA[i]) + (unsigned)CA[i] * 2u; gc1[i] = S.a_off(cur, HALF + RA[i]) + (unsigned)CA[i] * 2u; }
    }
    PG8_STAGE(PG8_SB(0, 0), cB, voffB); PG8_STAGE(PG8_SB(0, 1), cB + hstepB, voffB); PG8_STAGE_A(PG8_SA(0, 0), cA, 0, c); PG8_STAGE_A(PG8_SA(0, 1), cA, 1, c);
    if (wr == 1) PG8_BAR;
    PG8_WAIT_V(2); PG8_BAR;
    PG8_STAGE(PG8_SB(1, 0), cB + kstep, voffB); PG8_STAGE_A(PG8_SA(1, 0), cA + kstep, 0, c); PG8_STAGE(PG8_SB(1, 1), cB + hstepB + kstep, voffB);
    PG8_WAIT_V(6); PG8_BAR;
#pragma unroll 1
    for (;;) {
        const bool has_next = S.next(ui + 1, nxt);
        const char* nA = has_next ? S.a_base(nxt) : cA; const char* nB = has_next ? S.b_base(nxt) : cB;
        if constexpr (GATHER) {
            if (has_next) {
#pragma unroll
                for (int i = 0; i < 2; ++i) { gn0[i] = S.a_off(nxt, RA[i]) + (unsigned)CA[i] * 2u; gn1[i] = S.a_off(nxt, HALF + RA[i]) + (unsigned)CA[i] * 2u; }
            } else {
#pragma unroll
                for (int i = 0; i < 2; ++i) { gn0[i] = gc0[i]; gn1[i] = gc1[i]; }
            }
        }
#pragma unroll 1
        for (int t = 0; t < nt; t += 2) {
            const bool last = (t == nt - 2);
            const char* a1 = cA + (size_t)(t + 1) * kstep;
            const char* a2 = last ? nA : cA + (size_t)(t + 2) * kstep; const char* b2 = last ? nB : cB + (size_t)(t + 2) * kstep;
            const char* a3 = a2 + kstep; const char* b3 = b2 + kstep;
            unsigned gx0[2], gx1[2];
#pragma unroll
            for (int i = 0; i < 2; ++i) { gx0[i] = last ? gn0[i] : gc0[i]; gx1[i] = last ? gn1[i] : gc1[i]; }
            (void)gx0; (void)gx1;
            PG8_LDB(B0, 0, 0); PG8_LDB(B1, 0, 1); PG8_SCHED; PG8_LDA(At, 0, 0); PG8_STAGE_A(PG8_SA(1, 1), a1, 1, c);
            PG8_WAIT_V(8); PG8_WAIT_L(0); PG8_BAR; PG8_MMA(0, 0, At, B0); PG8_MMA(0, 1, At, B1); PG8_BAR; PG8_SCHED;
            PG8_LDA(At, 0, 1); PG8_STAGE(PG8_SB(0, 0), b2, voffB); PG8_STAGE(PG8_SB(0, 1), b2 + hstepB, voffB); PG8_STAGE_A(PG8_SA(0, 0), a2, 0, x);
            PG8_WAIT_V(8); PG8_WAIT_L(0); PG8_BAR; PG8_MMA(1, 0, At, B0); PG8_MMA(1, 1, At, B1); PG8_BAR; PG8_SCHED;
            PG8_LDB(B0, 1, 0); PG8_LDB(B1, 1, 1); PG8_SCHED; PG8_LDA(At, 1, 0); PG8_STAGE_A(PG8_SA(0, 1), a2, 1, x);
            PG8_WAIT_V(8); PG8_WAIT_L(0); PG8_BAR; PG8_MMA(0, 0, At, B0); PG8_MMA(0, 1, At, B1); PG8_BAR; PG8_SCHED;
            PG8_LDA(At, 1, 1); PG8_STAGE(PG8_SB(1, 0), b3, voffB); PG8_STAGE(PG8_SB(1, 1), b3 + hstepB, voffB); PG8_STAGE_A(PG8_SA(1, 0), a3, 0, x);
            PG8_WAIT_V(8); PG8_WAIT_L(0); PG8_BAR; PG8_MMA(1, 0, At, B0); PG8_MMA(1, 1, At, B1); PG8_BAR; PG8_SCHED;
        }
        if (wr == 0) PG8_BAR;
        E(acc, cur, wr, wc, fr, fq);
        if (!has_next) break;
#pragma unroll
        for (int a = 0; a < 2; ++a)
#pragma unroll
            for (int b = 0; b < 2; ++b)
#pragma unroll
                for (int m = 0; m < 4; ++m)
#pragma unroll
                    for (int n = 0; n < 2; ++n) acc[a][b][m][n] = (f32x4){0.f, 0.f, 0.f, 0.f};
        cur = nxt; cA = nA; cB = nB; ++ui;
        if constexpr (GATHER) {
#pragma unroll
            for (int i = 0; i < 2; ++i) { gc0[i] = gn0[i]; gc1[i] = gn1[i]; }
        }
        if (wr == 1) PG8_BAR;
    }
    PG8_WAIT_V(0);
    PG8_BAR;
#undef PG8_SA
#undef PG8_SB
#undef PG8_STAGE
#undef PG8_STAGE_A
#undef PG8_LDA
#undef PG8_LDB
#undef PG8_MMA
#undef PG8_WAIT_V
#undef PG8_WAIT_L
#undef PG8_BAR
#undef PG8_SCHED
}
}

#define XB_TMO      128
#define XB_XCNT(j)  (256  + 64 * (j))
#define XB_XSUB(j)  (1280 + 64 * (j))
#define XB_XGEN(j)  (2304 + 64 * (j))
#define XB_TOP      3328
#define XB_TOPGEN   3392
#define XCD_BAR_WORDS 3456
#define XB_SPIN_CAP (1u << 22)
__device__ __forceinline__ unsigned xb_ld(unsigned* p)              { return __hip_atomic_load(p, __ATOMIC_RELAXED, __HIP_MEMORY_SCOPE_AGENT); }
__device__ __forceinline__ unsigned xb_add(unsigned* p, unsigned v) { return __hip_atomic_fetch_add(p, v, __ATOMIC_RELAXED, __HIP_MEMORY_SCOPE_AGENT); }
__device__ __forceinline__ unsigned xb_xcc_id() { return (unsigned)__builtin_amdgcn_s_getreg((3 << 11) | 20) & 0xFu; }
#define XB_SPIN(cond, bar) do { unsigned _sp = 0; while (cond) { __builtin_amdgcn_s_sleep(1); \
    if ((++_sp & 255u) == 0u) { if (xb_ld(&(bar)[XB_TMO])) break; if (_sp > XB_SPIN_CAP) { atomicAdd(&(bar)[XB_TMO], 1u); break; } } } } while (0)
struct XcdBarrier { unsigned* bar; unsigned x; volatile LAS unsigned* st; };
__device__ __forceinline__ XcdBarrier xcd_barrier_post(unsigned* bar, volatile LAS unsigned* st) {
    XcdBarrier b; b.bar = bar; b.x = xb_xcc_id(); b.st = st;
    if (threadIdx.x == 0) (void)xb_add(&bar[XB_XCNT(b.x)], 1u);
    return b;
}
__device__ __forceinline__ void xcd_barrier_complete(unsigned* bar, unsigned x, unsigned& nloc, unsigned& nx) {
    const unsigned G = gridDim.x * gridDim.y * gridDim.z;
    unsigned sum, cnt, mine, sp = 0u;
    for (;;) {
        sum = 0u; cnt = 0u; mine = 0u;
#pragma unroll
        for (unsigned j = 0; j < 16; ++j) { const unsigned c = xb_ld(&bar[XB_XCNT(j)]); sum += c; cnt += (c > 0u) ? 1u : 0u; mine = (j == x) ? c : mine; }
        if (sum == G) break;
        __builtin_amdgcn_s_sleep(1);
        if ((++sp & 255u) == 0u) { if (xb_ld(&bar[XB_TMO])) break; if (sp > XB_SPIN_CAP) { atomicAdd(&bar[XB_TMO], 1u); break; } }
    }
    nloc = mine > 0u ? mine : 1u; nx = cnt > 0u ? cnt : 1u;
}
__device__ __forceinline__ void xcd_barrier(const XcdBarrier& b) {
    asm volatile("s_waitcnt vmcnt(0)" ::: "memory");
    __syncthreads();
    if (threadIdx.x == 0) {
        unsigned* bar = b.bar;
        __builtin_amdgcn_s_waitcnt(0);
        unsigned nloc = b.st[0], nx = b.st[1];
        if (nloc == 0u) { xcd_barrier_complete(bar, b.x, nloc, nx); b.st[0] = nloc; b.st[1] = nx; }
        const unsigned old = xb_add(&bar[XB_XSUB(b.x)], 1u);
        const unsigned gen = old / nloc;
        if (old + 1u == (gen + 1u) * nloc) {
            __builtin_amdgcn_fence(__ATOMIC_RELEASE, "agent");
            asm volatile("s_waitcnt vmcnt(0)" ::: "memory");
            const unsigned og = xb_add(&bar[XB_TOP], 1u);
            const unsigned tg = og / nx;
            if (og + 1u == (tg + 1u) * nx) xb_add(&bar[XB_TOPGEN], 1u);
            else XB_SPIN(xb_ld(&bar[XB_TOPGEN]) == tg, bar);
            __builtin_amdgcn_fence(__ATOMIC_ACQUIRE, "agent");
            xb_add(&bar[XB_XGEN(b.x)], 1u);
            asm volatile("s_waitcnt vmcnt(0)" ::: "memory");
        } else {
            XB_SPIN(xb_ld(&bar[XB_XGEN(b.x)]) == gen, bar);
            __builtin_amdgcn_fence(__ATOMIC_ACQUIRE, "agent");
            asm volatile("s_waitcnt vmcnt(0)" ::: "memory");
        }
    }
    __syncthreads();
}

struct Frame {
    LAS unsigned char* lds;
    int tid, lane, wave, bid, G, gw, NGW;
    float* out; unsigned char* ws;
};
struct Args { const float* in[33]; float* out; unsigned char* ws; int ph_lo, ph_hi; };
#define FIN(i) (AR->in[i])
#define CAS __attribute__((address_space(4)))
typedef const CAS Args* ArgsP;
__device__ __forceinline__ ArgsP launder_args(ArgsP p) { asm volatile("" : "+s"(p)); return p; }

__device__ __forceinline__ void phase_mod(Frame& F, ArgsP AR) {
    LAS float* cs = (LAS float*)F.lds;
    LAS float* red = cs + 4096;
    const float* c = FIN(1);
    for (int i = F.tid; i < 4096; i += 512) { const float v = c[i]; cs[i] = v / (1.0f + __expf(-v)); }
    __syncthreads();
    float* MOD = (float*)(F.ws + WS_MOD);
    for (int it = F.bid; it < 192; it += F.G) {
        const int m = it / 48, n0 = (it % 48) * 64, l = m >> 1;
        const float* W = ((m & 1) ? FIN(7) : FIN(4)) + (size_t)l * 1024 * 3072;
        const float* bias = ((m & 1) ? FIN(8) : FIN(5)) + (size_t)l * 3072;
        float a0 = 0.f, a1 = 0.f, a2 = 0.f, a3 = 0.f;
        const int k0 = F.wave * 128;
#pragma unroll 32
        for (int k = k0; k < k0 + 128; ++k) {
            const float w = W[(size_t)k * 3072 + n0 + F.lane];
            a0 += cs[k] * w; a1 += cs[1024 + k] * w; a2 += cs[2048 + k] * w; a3 += cs[3072 + k] * w;
        }
        red[(F.wave * 4 + 0) * 64 + F.lane] = a0; red[(F.wave * 4 + 1) * 64 + F.lane] = a1; red[(F.wave * 4 + 2) * 64 + F.lane] = a2; red[(F.wave * 4 + 3) * 64 + F.lane] = a3;
        __syncthreads();
        if (F.tid < 256) { const int b = F.tid >> 6, n = F.tid & 63; float s = 0.f;
#pragma unroll
            for (int w = 0; w < 8; ++w) s += red[(w * 4 + b) * 64 + n];
            MOD[(size_t)(m * 4 + b) * 3072 + n0 + n] = s + bias[n0 + n]; }
        __syncthreads();
    }
}

__device__ __forceinline__ void transpose_item(const float* W, int ldw, int nvalid, int K, bf16* WT, int mode, LAS float* scr, int kb, int nb, int lane) {
    const int k0 = 64 * kb, n0 = 32 * nb;
    const int nn = n0 + (lane & 31);
#pragma unroll
    for (int i = 0; i < 32; ++i) { const int kk = 2 * i + (lane >> 5); scr[kk * 33 + (lane & 31)] = (nn < nvalid) ? W[(size_t)(k0 + kk) * ldw + nn] : 0.f; }
    LDS_WAIT();
    const int c = lane & 7;
#pragma unroll
    for (int j = 0; j < 4; ++j) { const int nl = (lane >> 3) + 8 * j; const LAS float* s = scr + (8 * c) * 33 + nl;
        v4u o; o.x = pk2(s[0 * 33], s[1 * 33]); o.y = pk2(s[2 * 33], s[3 * 33]); o.z = pk2(s[4 * 33], s[5 * 33]); o.w = pk2(s[6 * 33], s[7 * 33]);
        const int n = n0 + nl; const int row = (mode == 0) ? n : (256 * (n >> 7) + (n & 127) + (mode == 2 ? 128 : 0));
        *(v4u*)(WT + (size_t)row * K + k0 + 8 * c) = o; }
    LDS_WAIT();
}
__device__ __forceinline__ void phase_convert_static(Frame& F, ArgsP AR) {
    LAS float* scr = (LAS float*)(F.lds + F.wave * 16384);
    constexpr int I_IN = 16 * 56, I_OUT = 16 * 32, I_POOL = 4 * 4 * 8;
    for (int it = F.gw; it < I_IN + I_OUT + I_POOL; it += F.NGW) {
        int r = it;
        if (r < I_IN) { transpose_item(FIN(9), INW, INW, 1024, (bf16*)(F.ws + WS_WIN), 0, scr, r / 56, r % 56, F.lane); continue; } r -= I_IN;
        if (r < I_OUT) { transpose_item(FIN(10), 1024, 1024, 1024, (bf16*)(F.ws + WS_WOUT), 0, scr, r / 32, r % 32, F.lane); continue; } r -= I_OUT;
        const int g = r / 32, rr = r % 32;
        transpose_item(FIN(23) + (size_t)g * 65536, 256, 256, 256, (bf16*)(F.ws + WS_WPOOL) + (size_t)g * 65536, 0, scr, rr / 8, rr % 8, F.lane);
    }
}
__device__ __forceinline__ void phase_convert_experts(Frame& F, ArgsP AR, int l) {
    LAS float* scr = (LAS float*)(F.lds + F.wave * 16384);
    for (int it = F.gw; it < 65 * 384; it += F.NGW) {
        const int e = it / 384, r = it % 384, type = r >> 7, sub = r & 127;
        if (type < 2) {
            const float* W = (e < 64) ? (FIN(type == 0 ? 27 : 28) + (size_t)(l * 64 + e) * 1024 * 256) : (FIN(type == 0 ? 30 : 31) + (size_t)l * 1024 * 256);
            transpose_item(W, 256, 256, 1024, (bf16*)(F.ws + WS_WGU) + (size_t)e * 512 * 1024, 1 + type, scr, sub >> 3, sub & 7, F.lane);
        } else {
            const float* W = (e < 64) ? (FIN(29) + (size_t)(l * 64 + e) * 256 * 1024) : (FIN(32) + (size_t)l * 256 * 1024);
            transpose_item(W, 1024, 1024, 256, (bf16*)(F.ws + WS_WD) + (size_t)e * 1024 * 256, 0, scr, sub >> 5, sub & 31, F.lane);
        }
    }
}

__device__ __forceinline__ void phase_tables(Frame& F, ArgsP AR) {
    const int gid = F.bid * 512 + F.tid, NT_ = F.G * 512;
    float* ROPE = (float*)(F.ws + WS_ROPE);
    const int* pos = (const int*)FIN(2);
    for (int i = gid; i < T * 8; i += NT_) {
        const int t = i >> 3, j = i & 7;
        const float inv = (j == 0) ? 1.0f : (j == 1) ? 0.1939227432f : (j == 2) ? 0.03760603070f : (j == 3) ? 0.007292664610f : (j == 4) ? 0.001414213562f : (j == 5) ? 0.0002742481884f : (j == 6) ? 5.318295734e-05f : 1.031338525e-05f;
        const float ang = (float)pos[t] * inv;
        float sn, cs; sincosf(ang, &sn, &cs);
        ROPE[2 * i] = cs; ROPE[2 * i + 1] = sn;
    }
}

__device__ __forceinline__ void phase_norm_mod(Frame& F, const float* X, const float* gamma, int m, bf16* Hout, float* Hf) {
    const float* MOD = (const float*)(F.ws + WS_MOD);
    for (int row = F.gw; row < T; row += F.NGW) {
        const int b = row >> 12;
        const float* shift = MOD + (size_t)(m * 4 + b) * 3072; const float* scale = shift + 1024;
        const f32x4* xr = (const f32x4*)(X + (size_t)row * D) + F.lane;
        f32x4 v[4]; float ss = 0.f;
#pragma unroll
        for (int j = 0; j < 4; ++j) { v[j] = xr[64 * j]; ss += v[j].x * v[j].x + v[j].y * v[j].y + v[j].z * v[j].z + v[j].w * v[j].w; }
        const float rstd = rsqrtf(wave_sum(ss) * (1.0f / D) + 1e-6f);
#pragma unroll
        for (int j = 0; j < 4; ++j) {
            const int c0 = 4 * F.lane + 256 * j;
            const f32x4 gg = *(const f32x4*)(gamma + c0), sc = *(const f32x4*)(scale + c0), sh = *(const f32x4*)(shift + c0);
            f32x4 h; h.x = v[j].x * rstd * gg.x * (1.f + sc.x) + sh.x; h.y = v[j].y * rstd * gg.y * (1.f + sc.y) + sh.y;
            h.z = v[j].z * rstd * gg.z * (1.f + sc.z) + sh.z; h.w = v[j].w * rstd * gg.w * (1.f + sc.w) + sh.w;
            if (Hout) { v2u o; o.x = pk2(h.x, h.y); o.y = pk2(h.z, h.w); *(v2u*)(Hout + (size_t)row * D + c0) = o; }
            if (Hf) *(f32x4*)(Hf + (size_t)row * D + c0) = h;
        }
    }
}

struct DenseOrder {
    const char* A; const char* Bt; unsigned lda_b, ldb_b; int nM, nN, nU, chunk, x, q0, qs;
    __device__ __forceinline__ void init(const void* A_, const void* Bt_, unsigned lda, unsigned ldb, int M, int N, int G, int c) {
        A = (const char*)A_; Bt = (const char*)Bt_; lda_b = lda; ldb_b = ldb; nM = M / 256; nN = N / 256; nU = nM * nN; chunk = (nU + 7) / 8; x = c & 7; q0 = c >> 3; qs = G >> 3; }
    __device__ __forceinline__ bool next(int i, pg8::Unit& u) const {
        const int q = i * qs + q0; if (q >= chunk) return false; const int L = x * chunk + q; if (L >= nU) return false;
        u.pm = L / nN; u.pn = L % nN; u.e = 0; u.rows = 256; return true; }
    __device__ __forceinline__ const char* a_base(const pg8::Unit& u) const { return A + (size_t)u.pm * 256 * lda_b; }
    __device__ __forceinline__ const char* b_base(const pg8::Unit& u) const { return Bt + (size_t)u.pn * 256 * ldb_b; }
    __device__ __forceinline__ unsigned a_off(const pg8::Unit&, int) const { return 0u; }
};
struct PoolOrder {
    const char* A; const char* Bt; int nU, chunk, x, q0, qs;
    __device__ __forceinline__ void init(const void* A_, const void* Bt_, int G, int c) { A = (const char*)A_; Bt = (const char*)Bt_; nU = 64 * 4; chunk = (nU + 7) / 8; x = c & 7; q0 = c >> 3; qs = G >> 3; }
    __device__ __forceinline__ bool next(int i, pg8::Unit& u) const {
        const int q = i * qs + q0; if (q >= chunk) return false; const int L = x * chunk + q; if (L >= nU) return false;
        u.pm = L >> 2; u.pn = L & 3; u.e = L & 3; u.rows = 256; return true; }
    __device__ __forceinline__ const char* a_base(const pg8::Unit& u) const { return A + (size_t)u.pm * 256 * 2048 + (size_t)u.e * 512; }
    __device__ __forceinline__ const char* b_base(const pg8::Unit& u) const { return Bt + (size_t)u.e * 256 * 512; }
    __device__ __forceinline__ unsigned a_off(const pg8::Unit&, int) const { return 0u; }
};
constexpr int LDS_MOE = 131072;
__device__ __forceinline__ void moe_tables(Frame& F, int l) {
    LAS int* est = (LAS int*)(F.lds + LDS_MOE); LAS int* tst = est + 128;
    if (F.wave == 0) {
        const unsigned* ctl = (const unsigned*)(F.ws + WS_CTL);
        const int c = (int)__hip_atomic_load(&ctl[CW_CNT + (l * 64 + F.lane) * 64], __ATOMIC_RELAXED, __HIP_MEMORY_SCOPE_AGENT);
        const int nt = (c + 255) >> 8;
        int ic = c, it = nt;
#pragma unroll
        for (int o = 1; o < 64; o <<= 1) { const int a = __shfl_up(ic, o), b2 = __shfl_up(it, o); if (F.lane >= o) { ic += a; it += b2; } }
        est[F.lane] = ic - c; tst[F.lane] = it - nt;
        if (F.lane == 63) { est[64] = ic; tst[64] = it; }
    }
    __syncthreads();
}
template <int NPN, bool GATE_UP>
struct MoeOrder {
    const LAS int* est; const LAS int* tst; const unsigned char* ws; int ntr, ntiles, nU, chunk, x, q0, qs;
    __device__ __forceinline__ void init(LAS unsigned char* lds, const unsigned char* ws_, bool shared_only, bool with_sh, int G, int c) {
        est = (const LAS int*)(lds + LDS_MOE); tst = est + 128; ws = ws_;
        ntr = shared_only ? 0 : __builtin_amdgcn_readfirstlane(tst[64]); ntiles = ntr + (with_sh ? 64 : 0); nU = ntiles * NPN; chunk = (nU + 7) / 8; x = c & 7; q0 = c >> 3; qs = G >> 3; }
    __device__ __forceinline__ bool next(int i, pg8::Unit& u) const {
        const int q = i * qs + q0; if (q >= chunk) return false; const int L = x * chunk + q; if (L >= nU) return false;
        const int tile = L / NPN; u.pn = L % NPN;
        if (tile < ntr) { int e = 0;
#pragma unroll
            for (int s_ = 32; s_ >= 1; s_ >>= 1) { if (tst[e + s_] <= tile) e += s_; }
            e = __builtin_amdgcn_readfirstlane(e); u.e = e; u.pm = __builtin_amdgcn_readfirstlane(tile - tst[e]); const int rem = __builtin_amdgcn_readfirstlane(est[e + 1] - est[e]) - 256 * u.pm; u.rows = rem < 256 ? rem : 256; }
        else { u.e = 64; u.pm = tile - ntr; u.rows = 256; }
        return true; }
    __device__ __forceinline__ int row0(const pg8::Unit& u) const { return (u.e < 64) ? __builtin_amdgcn_readfirstlane(est[u.e]) + 256 * u.pm : 256 * u.pm; }
    __device__ __forceinline__ const char* a_base(const pg8::Unit& u) const {
        if (GATE_UP) return (const char*)(ws + WS_H);
        return (u.e < 64) ? (const char*)(ws + BG_HB) + (size_t)row0(u) * 512 : (const char*)(ws + BG_HBSH) + (size_t)row0(u) * 512; }
    __device__ __forceinline__ const char* b_base(const pg8::Unit& u) const {
        if (GATE_UP) return (const char*)(ws + WS_WGU) + (size_t)u.e * 512 * 2048 + (size_t)u.pn * 256 * 2048;
        return (const char*)(ws + WS_WD) + (size_t)u.e * 1024 * 512 + (size_t)u.pn * 256 * 512; }
    __device__ __forceinline__ unsigned a_off(const pg8::Unit& u, int r) const {
        int tok;
        if (u.e < 64) { const int* elt = (const int*)(ws + WS_ELT) + (size_t)u.e * ECAP + 256 * u.pm; tok = (r < u.rows) ? elt[r] : 0; }
        else tok = 256 * u.pm + r;
        return (unsigned)tok * 2048u; }
};

struct EpiBf16Store { static constexpr bool PERM = true; bf16* C; int ldc;
    __device__ __forceinline__ void operator()(const pg8::f32x4 (&acc)[2][2][4][2], const pg8::Unit& u, int wr, int wc, int fr, int fq) const {
#pragma unroll
        for (int ai = 0; ai < 2; ++ai)
#pragma unroll
            for (int m = 0; m < 4; ++m) { bf16* rowp = C + (size_t)(u.pm * 256 + ai * 128 + wr * 64 + m * 16 + fr) * ldc + u.pn * 256 + wc * 32 + 8 * fq;
#pragma unroll
                for (int bj = 0; bj < 2; ++bj) { const f32x4 a0 = acc[ai][bj][m][0], a1 = acc[ai][bj][m][1];
                    v4u o; o.x = pk2(a0.x, a0.y); o.y = pk2(a0.z, a0.w); o.z = pk2(a1.x, a1.y); o.w = pk2(a1.z, a1.w); *(v4u*)(rowp + bj * 128) = o; } }
    }
};
struct EpiF32Store { static constexpr bool PERM = false; float* C; int ldc;
    __device__ __forceinline__ void operator()(const pg8::f32x4 (&acc)[2][2][4][2], const pg8::Unit& u, int wr, int wc, int fr, int fq) const {
#pragma unroll
        for (int ai = 0; ai < 2; ++ai)
#pragma unroll
            for (int m = 0; m < 4; ++m) { float* rowp = C + (size_t)(u.pm * 256 + ai * 128 + wr * 64 + m * 16 + fr) * ldc + u.pn * 256 + wc * 32 + 4 * fq;
#pragma unroll
                for (int bj = 0; bj < 2; ++bj)
#pragma unroll
                    for (int n = 0; n < 2; ++n) *(f32x4*)(rowp + bj * 128 + n * 16) = acc[ai][bj][m][n]; }
    }
};
struct EpiResidual { static constexpr bool PERM = false; const float* Xin; float* X; const float* gate; const float* colscale; int col_from_e;
    __device__ __forceinline__ void operator()(const pg8::f32x4 (&acc)[2][2][4][2], const pg8::Unit& u, int wr, int wc, int fr, int fq) const {
        const int cbase = (col_from_e ? u.e * 256 : u.pn * 256) + wc * 32 + 4 * fq;
#pragma unroll
        for (int ai = 0; ai < 2; ++ai)
#pragma unroll
            for (int m = 0; m < 4; ++m) { const int row = u.pm * 256 + ai * 128 + wr * 64 + m * 16 + fr; const int b = row >> 12;
#pragma unroll
                for (int bj = 0; bj < 2; ++bj)
#pragma unroll
                    for (int n = 0; n < 2; ++n) { const int col = cbase + bj * 128 + n * 16; const size_t o = (size_t)row * D + col;
                        f32x4 g = *(const f32x4*)(gate + (size_t)b * 3072 + col); if (colscale) { const f32x4 cs = *(const f32x4*)(colscale + col); g = g * cs; }
                        const f32x4 xi = *(const f32x4*)(Xin + o); *(f32x4*)(X + o) = xi + g * acc[ai][bj][m][n]; } }
    }
};
template <class Order> struct EpiGateUp { static constexpr bool PERM = true; const Order* S; unsigned char* ws;
    __device__ __forceinline__ void operator()(const pg8::f32x4 (&acc)[2][2][4][2], const pg8::Unit& u, int wr, int wc, int fr, int fq) const {
        const int r0 = S->row0(u); bf16* HB = (bf16*)(ws + (u.e < 64 ? BG_HB : BG_HBSH));
        const float* elw = (const float*)(ws + WS_ELW) + (size_t)(u.e < 64 ? u.e : 0) * ECAP + 256 * u.pm;
#pragma unroll
        for (int ai = 0; ai < 2; ++ai)
#pragma unroll
            for (int m = 0; m < 4; ++m) { const int r = ai * 128 + wr * 64 + m * 16 + fr;
                if (r < u.rows) { const float w = (u.e < 64) ? elw[r] : 1.0f; bf16* rowp = HB + (size_t)(r0 + r) * 256 + u.pn * 128 + wc * 32 + 8 * fq;
                    v4u o;
#pragma unroll
                    for (int n = 0; n < 2; ++n) { const f32x4 g = acc[ai][0][m][n], up = acc[ai][1][m][n]; f32x4 h;
                        h.x = g.x * sigmoidf_(g.x) * up.x * w; h.y = g.y * sigmoidf_(g.y) * up.y * w; h.z = g.z * sigmoidf_(g.z) * up.z * w; h.w = g.w * sigmoidf_(g.w) * up.w * w;
                        if (n == 0) { o.x = pk2(h.x, h.y); o.y = pk2(h.z, h.w); } else { o.z = pk2(h.x, h.y); o.w = pk2(h.z, h.w); } }
                    *(v4u*)rowp = o; } }
    }
};
constexpr float Y8_SCALE = 32.0f, Y8_INV = 1.0f / 32.0f;
template <class Order> struct EpiDown { static constexpr bool PERM = true; const Order* S; unsigned char* ws;
    __device__ __forceinline__ void operator()(const pg8::f32x4 (&acc)[2][2][4][2], const pg8::Unit& u, int wr, int wc, int fr, int fq) const {
        const int r0 = S->row0(u); unsigned char* Y = ws + (u.e < 64 ? BG_Y : BG_YSH);
#pragma unroll
        for (int ai = 0; ai < 2; ++ai)
#pragma unroll
            for (int m = 0; m < 4; ++m) { const int r = ai * 128 + wr * 64 + m * 16 + fr;
                if (r < u.rows) {
#pragma unroll
                    for (int bj = 0; bj < 2; ++bj) { const int col = u.pn * 256 + bj * 128 + wc * 32 + 8 * fq; const f32x4 a0 = acc[ai][bj][m][0] * Y8_SCALE, a1 = acc[ai][bj][m][1] * Y8_SCALE;
                        int w0 = 0, w1 = 0;
                        w0 = __builtin_amdgcn_cvt_pk_fp8_f32(a0.x, a0.y, w0, false); w0 = __builtin_amdgcn_cvt_pk_fp8_f32(a0.z, a0.w, w0, true);
                        w1 = __builtin_amdgcn_cvt_pk_fp8_f32(a1.x, a1.y, w1, false); w1 = __builtin_amdgcn_cvt_pk_fp8_f32(a1.z, a1.w, w1, true);
                        *(v2u*)(Y + (size_t)(r0 + r) * D + col) = (v2u){(unsigned)w0, (unsigned)w1}; } }
                asm volatile("" ::: "memory"); }
    }
};

__device__ __forceinline__ void phase_postproj(Frame& F, ArgsP AR) {
    const bf16* PROJ = (const bf16*)(F.ws + BG_PROJ); const float* ROPE = (const float*)(F.ws + WS_ROPE);
    float* U = (float*)(F.ws + BG_U); bf16* Q = (bf16*)(F.ws + BG_Q); bf16* QI = (bf16*)(F.ws + BG_QI); bf16* Kb = (bf16*)(F.ws + BG_K); bf16* Vb = (bf16*)(F.ws + BG_V); bf16* KIb = (bf16*)(F.ws + BG_KI); float* WI = (float*)(F.ws + BG_WI);
    const float qg = FIN(21)[F.lane], kg = FIN(22)[F.lane];
    const int lane = F.lane;
    for (int t = F.gw; t < T; t += F.NGW) {
        const bf16* p = PROJ + (size_t)t * INP;
        const float cs = ROPE[(size_t)t * 16 + 2 * (lane & 7)], sn = ROPE[(size_t)t * 16 + 2 * (lane & 7) + 1];
#pragma unroll
        for (int j = 0; j < 8; ++j) { const float uv = bf2f(p[j * 64 + lane]); U[(size_t)t * 512 + j * 64 + lane] = uv;
            const int col = j * 64 + lane; ((bf16*)(F.ws + BG_AUG))[((size_t)(col >> 4) * 512 + (t >> 5)) * 640 + (t & 31) * 16 + (col & 15)] = (bf16)f2bf(uv); }
        auto rope = [&](float y) -> float { const float yp = __shfl_xor(y, 8); float o = y; if (lane < 8) o = y * cs - yp * sn; else if (lane < 16) o = yp * sn + y * cs; return o; };
#pragma unroll
        for (int h = 0; h < 8; ++h) { const float x = bf2f(p[512 + h * 64 + lane]); const float rstd = rsqrtf(wave_sum(x * x) * (1.0f / 64.0f) + 1e-6f);
            Q[(size_t)t * 512 + h * 64 + lane] = (bf16)f2bf(rope(x * rstd * qg)); }
        { const float x = bf2f(p[1024 + lane]); const float rstd = rsqrtf(wave_sum(x * x) * (1.0f / 64.0f) + 1e-6f); Kb[(size_t)t * 64 + lane] = (bf16)f2bf(rope(x * rstd * kg)); }
        { const bf16 vv = (bf16)f2bf(bf2f(p[1088 + lane])); Vb[(size_t)t * 64 + lane] = vv; ((bf16*)(F.ws + BG_VT))[((size_t)(t >> 12) * 64 + lane) * 4096 + (t & 4095)] = vv; }
#pragma unroll
        for (int h = 0; h < 8; ++h) QI[(size_t)t * 512 + h * 64 + lane] = (bf16)f2bf(rope(bf2f(p[1152 + h * 64 + lane])));
        KIb[(size_t)t * 64 + lane] = (bf16)f2bf(rope(bf2f(p[1664 + lane])));
        if (lane < 8) WI[(size_t)t * 8 + lane] = bf2f(p[1728 + lane]) * 0.35355339059327373f;
    }
}

__device__ __forceinline__ void phase_s5a(Frame& F, ArgsP AR) {
    const float* S5 = (const float*)(F.ws + WS_S5T); const float* U = (const float*)(F.ws + BG_U); float* SLOC = (float*)(F.ws + BG_SLOC);
    const int p = F.lane;
    for (int it = F.gw; it < 4 * 32 * 64; it += F.NGW) {
        const int c = it & 63, g = (it >> 6) & 31, b = it >> 11;
        const float ar = S5[S5_ABAR + 2 * (g * 64 + p)], ai = S5[S5_ABAR + 2 * (g * 64 + p) + 1];
        float br[16], bi[16];
#pragma unroll
        for (int h = 0; h < 16; ++h) { br[h] = S5[S5_BBR + (g * 64 + p) * 16 + h]; bi[h] = S5[S5_BBI + (g * 64 + p) * 16 + h]; }
        float sr = 0.f, si = 0.f;
        const float* up = U + ((size_t)b * SEQ + c * 64) * 512 + g * 16;
        for (int tau = 0; tau < 64; ++tau) {
            float bur = 0.f, bui = 0.f;
#pragma unroll
            for (int h = 0; h < 16; ++h) { const float u = up[(size_t)tau * 512 + h]; bur += br[h] * u; bui += bi[h] * u; }
            const float nr = ar * sr - ai * si + bur, ni = ar * si + ai * sr + bui; sr = nr; si = ni;
        }
        SLOC[((size_t)it * 64 + p) * 2] = sr; SLOC[((size_t)it * 64 + p) * 2 + 1] = si;
    }
}
__device__ __forceinline__ void phase_s5b(Frame& F, ArgsP AR) {
    const float* S5 = (const float*)(F.ws + WS_S5T); const float* SLOC = (const float*)(F.ws + BG_SLOC); float* SIN = (float*)(F.ws + BG_SIN);
    const int gid = F.bid * 512 + F.tid;
    for (int i = gid; i < 4 * 32 * 64; i += F.G * 512) {
        const int p = i & 63, g = (i >> 6) & 31, b = i >> 11;
        const float ar = S5[S5_A64 + 2 * (g * 64 + p)], ai = S5[S5_A64 + 2 * (g * 64 + p) + 1];
        float sr = 0.f, si = 0.f;
        for (int c = 0; c < 64; ++c) {
            const size_t o = ((((size_t)b * 32 + g) * 64 + c) * 64 + p) * 2;
            SIN[o] = sr; SIN[o + 1] = si;
            const float lr = SLOC[o], li = SLOC[o + 1];
            const float nr = ar * sr - ai * si + lr, ni = ar * si + ai * sr + li; sr = nr; si = ni;
        }
    }
}
__device__ __forceinline__ void phase_s5c(Frame& F, ArgsP AR) {
    const float* S5 = (const float*)(F.ws + WS_S5T); const float* U = (const float*)(F.ws + BG_U); const float* SIN = (const float*)(F.ws + BG_SIN); bf16* MIX = (bf16*)(F.ws + BG_MIX);
    const float* cre = FIN(16); const float* cim = FIN(17); const float* dsk = FIN(18); const float* gluw = FIN(19); const float* glub = FIN(20);
    LAS float* st = (LAS float*)(F.lds + F.wave * 10240);
    LAS float* yg = st + 2048;
    const int p = F.lane, h = F.lane & 15, tq = F.lane >> 4;
    for (int it = F.gw; it < 4 * 32 * 64; it += F.NGW) {
        const int c = it & 63, g = (it >> 6) & 31, b = it >> 11;
        const float ar = S5[S5_ABAR + 2 * (g * 64 + p)], ai = S5[S5_ABAR + 2 * (g * 64 + p) + 1];
        float br[16], bi[16];
#pragma unroll
        for (int hh = 0; hh < 16; ++hh) { br[hh] = S5[S5_BBR + (g * 64 + p) * 16 + hh]; bi[hh] = S5[S5_BBI + (g * 64 + p) * 16 + hh]; }
        float sr = SIN[((size_t)it * 64 + p) * 2], si = SIN[((size_t)it * 64 + p) * 2 + 1];
        const size_t trow0 = (size_t)b * SEQ + c * 64;
        const float dd = dsk[g * 16 + h], gb = glub[g * 16 + h];
        for (int sub = 0; sub < 4; ++sub) {
            const float* up = U + (trow0 + sub * 16) * 512 + g * 16;
            for (int tau = 0; tau < 16; ++tau) {
                float bur = 0.f, bui = 0.f;
#pragma unroll
                for (int hh = 0; hh < 16; ++hh) { const float u = up[(size_t)tau * 512 + hh]; bur += br[hh] * u; bui += bi[hh] * u; }
                const float nr = ar * sr - ai * si + bur, ni = ar * si + ai * sr + bui; sr = nr; si = ni;
                st[(tau * 64 + p) * 2] = sr; st[(tau * 64 + p) * 2 + 1] = si;
            }
            LDS_WAIT();
            float y[4];
#pragma unroll
            for (int j = 0; j < 4; ++j) { const int tau = tq + 4 * j; float a = 0.f;
                for (int pp = 0; pp < 64; ++pp) a += cre[(g * 16 + h) * 64 + pp] * st[(tau * 64 + pp) * 2] - cim[(g * 16 + h) * 64 + pp] * st[(tau * 64 + pp) * 2 + 1];
                a += dd * up[(size_t)tau * 512 + h];
                const float ge = 0.5f * a * (1.0f + tanhf(0.7978845608028654f * (a + 0.044715f * a * a * a)));
                y[j] = ge; yg[tau * 16 + h] = ge; }
            LDS_WAIT();
#pragma unroll
            for (int j = 0; j < 4; ++j) { const int tau = tq + 4 * j; float z = gb;
#pragma unroll
                for (int hh = 0; hh < 16; ++hh) z += yg[tau * 16 + hh] * gluw[(g * 16 + hh) * 16 + h];
                MIX[(trow0 + sub * 16 + tau) * D + g * 16 + h] = (bf16)f2bf(y[j] * sigmoidf_(z)); }
            LDS_WAIT();
        }
    }
}


__device__ __forceinline__ void phase_s5mats(Frame& F, ArgsP AR) {
    const float* cre = FIN(16); const float* cim = FIN(17);
    bf16* MB = (bf16*)(F.ws + BG_S5MB); bf16* WE = (bf16*)(F.ws + BG_S5WE);
    LAS double* pw = (LAS double*)F.lds;
    LAS float* bbr = (LAS float*)(F.lds + 34816);
    LAS float* bbi = bbr + 1024;
    const int tid = F.tid;
#pragma unroll 1
    for (int unit = F.bid; unit < 256; unit += F.G) {
        const int g = unit >> 3, part = unit & 7;
        __syncthreads();
        const double dt = exp((double)FIN(13)[g]);
        for (int i = tid; i < 64 * 33; i += 512) { const int p = i / 33, dl = i % 33; const double lr = FIN(11)[g * 64 + p], li = FIN(12)[g * 64 + p];
            const double mag = exp(lr * dt * dl), ang = li * dt * dl; pw[2 * i] = mag * cos(ang); pw[2 * i + 1] = mag * sin(ang); }
        if (tid < 64) { const int p = tid; const double lr = FIN(11)[g * 64 + p], li = FIN(12)[g * 64 + p];
            const double mag = exp(lr * dt), ar = mag * cos(li * dt), ai = mag * sin(li * dt);
            const double nr = ar - 1.0, ni = ai, den = lr * lr + li * li; const double cr = (nr * lr + ni * li) / den, ci = (ni * lr - nr * li) / den;
            for (int h = 0; h < 16; ++h) { const double br = FIN(14)[(g * 64 + p) * 16 + h], bi = FIN(15)[(g * 64 + p) * 16 + h]; bbr[p * 16 + h] = (float)(cr * br - ci * bi); bbi[p * 16 + h] = (float)(cr * bi + ci * br); } }
        __syncthreads();
        if (part == 0 && tid < 64) { double* POW = (double*)(F.ws + BG_POW); const int gi = (g * 64 + tid) * 33 + 32; POW[2 * gi] = pw[2 * (tid * 33 + 32)]; POW[2 * gi + 1] = pw[2 * (tid * 33 + 32) + 1]; }
        for (int i = tid; i < 4 * 256; i += 512) {
            const int h2 = i & 15, h = (i >> 4) & 15, dl = 4 * part + (i >> 8);
            double acc = 0.0;
#pragma unroll 8
            for (int p = 0; p < 64; ++p) {
                const double pr = pw[2 * (p * 33 + dl)], pi = pw[2 * (p * 33 + dl) + 1];
                const double br = bbr[p * 16 + h2], bi = bbi[p * 16 + h2];
                acc += (double)cre[(g * 16 + h) * 64 + p] * (pr * br - pi * bi) - (double)cim[(g * 16 + h) * 64 + p] * (pr * bi + pi * br);
            }
            const bf16 kv = (bf16)f2bf((float)acc);
            bf16* Mg = MB + (size_t)g * 512 * 640;
            for (int t2 = 0; t2 + dl < 32; ++t2) {
                Mg[(size_t)((t2 + dl) * 16 + h) * 640 + t2 * 16 + h2] = kv;
                if (dl > 0) Mg[(size_t)(t2 * 16 + h) * 640 + (t2 + dl) * 16 + h2] = (bf16)0;
            }
        }
        for (int i = tid; i < 4 * 16 * 64; i += 512) {
            const int p = i & 63, h = (i >> 6) & 15, tau = 4 * part + (i >> 10);
            const double pr = pw[2 * (p * 33 + tau + 1)], pi = pw[2 * (p * 33 + tau + 1) + 1];
            const double cr = cre[(g * 16 + h) * 64 + p], ci = cim[(g * 16 + h) * 64 + p];
            bf16* row = MB + ((size_t)g * 512 + tau * 16 + h) * 640 + 512 + 2 * p;
            *(unsigned*)row = pk2((float)(cr * pr - ci * pi), (float)(-(cr * pi + ci * pr)));
        }
        for (int i = tid; i < 8 * 512; i += 512) {
            const int k = i & 511, p = 8 * part + (i >> 9);
            const int tau = k >> 4, h2 = k & 15;
            const double pr = pw[2 * (p * 33 + 31 - tau)], pi = pw[2 * (p * 33 + 31 - tau) + 1];
            const double br = bbr[p * 16 + h2], bi = bbi[p * 16 + h2];
            bf16* Wg = WE + (size_t)g * 256 * 512;
            Wg[(size_t)(2 * p) * 512 + k] = (bf16)f2bf((float)(pr * br - pi * bi));
            Wg[(size_t)(2 * p + 1) * 512 + k] = (bf16)f2bf((float)(pr * bi + pi * br));
            Wg[(size_t)(128 + 2 * p) * 512 + k] = (bf16)0; Wg[(size_t)(128 + 2 * p + 1) * 512 + k] = (bf16)0;
        }
    }
    __syncthreads();
}
struct S5AOrder {
    const unsigned char* ws; int c, G;
    __device__ __forceinline__ bool next(int i, pg8::Unit& u) const { const int L = i * G + c; if (L >= 64) return false; u.e = L >> 1; u.pm = L & 1; u.pn = 0; u.rows = 256; return true; }
    __device__ __forceinline__ const char* a_base(const pg8::Unit& u) const { return (const char*)(ws + BG_AUG) + ((size_t)u.e * 512 + u.pm * 256) * 1280; }
    __device__ __forceinline__ const char* b_base(const pg8::Unit& u) const { return (const char*)(ws + BG_S5WE) + (size_t)u.e * 256 * 1024; }
    __device__ __forceinline__ unsigned a_off(const pg8::Unit&, int) const { return 0u; }
};
struct EpiS5A { static constexpr bool PERM = false; float* SL;
    __device__ __forceinline__ void operator()(const pg8::f32x4 (&acc)[2][2][4][2], const pg8::Unit& u, int wr, int wc, int fr, int fq) const {
#pragma unroll
        for (int ai = 0; ai < 2; ++ai)
#pragma unroll
            for (int m = 0; m < 4; ++m) { float* rowp = SL + ((size_t)u.e * 512 + u.pm * 256 + ai * 128 + wr * 64 + m * 16 + fr) * 128 + wc * 32 + 4 * fq;
#pragma unroll
                for (int n = 0; n < 2; ++n) *(f32x4*)(rowp + n * 16) = acc[ai][0][m][n]; }
    }
};
struct S5BOrder {
    const unsigned char* ws; int c, G;
    __device__ __forceinline__ bool next(int i, pg8::Unit& u) const { const int L = i * G + c; if (L >= 128) return false; u.e = L >> 2; u.pm = (L >> 1) & 1; u.pn = L & 1; u.rows = 256; return true; }
    __device__ __forceinline__ const char* a_base(const pg8::Unit& u) const { return (const char*)(ws + BG_AUG) + ((size_t)u.e * 512 + u.pm * 256) * 1280; }
    __device__ __forceinline__ const char* b_base(const pg8::Unit& u) const { return (const char*)(ws + BG_S5MB) + ((size_t)u.e * 512 + u.pn * 256) * 1280; }
    __device__ __forceinline__ unsigned a_off(const pg8::Unit&, int) const { return 0u; }
};
struct EpiS5B { static constexpr bool PERM = false; const unsigned char* ws; const float* dsk; const float* gluw; const float* glub; bf16* MIX;
    __device__ __forceinline__ void operator()(const pg8::f32x4 (&acc)[2][2][4][2], const pg8::Unit& u, int wr, int wc, int fr, int fq) const {
        const int g = u.e; const bf16* AUG = (const bf16*)(ws + BG_AUG);
        const f32x4 d4 = *(const f32x4*)(dsk + g * 16 + 4 * fq), b4 = *(const f32x4*)(glub + g * 16 + 4 * fq);
#pragma unroll
        for (int ai = 0; ai < 2; ++ai)
#pragma unroll
            for (int m = 0; m < 4; ++m) { const int nidx = u.pm * 256 + ai * 128 + wr * 64 + m * 16 + fr;
#pragma unroll
                for (int bj = 0; bj < 2; ++bj)
#pragma unroll
                    for (int n = 0; n < 2; ++n) {
                        const int tau = 16 * u.pn + 8 * bj + 2 * wc + n;
                        const v2u uw = *(const v2u*)(AUG + ((size_t)g * 512 + nidx) * 640 + tau * 16 + 4 * fq);
                        const f32x4 a = acc[ai][bj][m][n];
                        float y[4] = {a.x + d4.x * bflo(uw.x), a.y + d4.y * bfhi(uw.x), a.z + d4.z * bflo(uw.y), a.w + d4.w * bfhi(uw.y)};
#pragma unroll
                        for (int k = 0; k < 4; ++k) { const float v = y[k]; y[k] = 0.5f * v * (1.0f + tanhf(0.7978845608028654f * (v + 0.044715f * v * v * v))); }
                        float z[4] = {b4.x, b4.y, b4.z, b4.w};
#pragma unroll
                        for (int x = 0; x < 4; ++x) {
                            float o[4];
#pragma unroll
                            for (int k = 0; k < 4; ++k) o[k] = (x == 0) ? y[k] : __shfl_xor(y[k], 16 * x);
                            const int hb = 4 * (fq ^ x);
#pragma unroll
                            for (int k = 0; k < 4; ++k) { const f32x4 wv = *(const f32x4*)(gluw + (g * 16 + hb + k) * 16 + 4 * fq);
                                z[0] += o[k] * wv.x; z[1] += o[k] * wv.y; z[2] += o[k] * wv.z; z[3] += o[k] * wv.w; }
                        }
                        const size_t t = (size_t)nidx * 32 + tau;
                        v2u ov; ov.x = pk2(y[0] * sigmoidf_(z[0]), y[1] * sigmoidf_(z[1])); ov.y = pk2(y[2] * sigmoidf_(z[2]), y[3] * sigmoidf_(z[3]));
                        *(v2u*)(MIX + t * D + g * 16 + 4 * fq) = ov;
                        asm volatile("" ::: "memory");
                    } }
    }
};
__device__ __forceinline__ void phase_s5carry(Frame& F) {
    const double* POW = (const double*)(F.ws + BG_POW); const float* SL = (const float*)(F.ws + BG_SL2); bf16* AUG = (bf16*)(F.ws + BG_AUG);
    const int gid = F.bid * 512 + F.tid;
    for (int i = gid; i < 4 * 32 * 64; i += F.G * 512) {
        const int p = i & 63, g = (i >> 6) & 31, b = i >> 11;
        const float ar = (float)POW[2 * ((g * 64 + p) * 33 + 32)], ai = (float)POW[2 * ((g * 64 + p) * 33 + 32) + 1];
        float sr = 0.f, si = 0.f;
#pragma unroll 8
        for (int c = 0; c < 128; ++c) {
            const size_t n = (size_t)g * 512 + b * 128 + c;
            *(unsigned*)(AUG + n * 640 + 512 + 2 * p) = pk2(sr, si);
            const float lr = SL[n * 128 + 2 * p], li = SL[n * 128 + 2 * p + 1];
            const float nr = ar * sr - ai * si + lr, ni = ar * si + ai * sr + li; sr = nr; si = ni;
        }
    }
}

__device__ __forceinline__ unsigned fkey(float f) { const unsigned u = __builtin_bit_cast(unsigned, f); return (u & 0x80000000u) ? ~u : (u | 0x80000000u); }
__device__ __forceinline__ void phase_dsa(Frame& F, ArgsP AR) {
    const bf16* Q = (const bf16*)(F.ws + BG_Q); const bf16* QI = (const bf16*)(F.ws + BG_QI); const bf16* Kb = (const bf16*)(F.ws + BG_K); const bf16* Vb = (const bf16*)(F.ws + BG_V);
    const bf16* KIb = (const bf16*)(F.ws + BG_KI); const float* WI = (const float*)(F.ws + BG_WI); bf16* MIX = (bf16*)(F.ws + BG_MIX);
    LAS unsigned char* wl = F.lds + F.wave * 19456;
    LAS float* sc = (LAS float*)wl;
    LAS float* qf = (LAS float*)(wl + 16384);
    LAS int* list = (LAS int*)(wl + 16384 + 2048);
    const int lane = F.lane;
#pragma unroll 1
    for (int it = F.bid; it < T / 8; it += F.G) {
        const int t = (T / 8 - 1 - it) * 8 + F.wave;
        const int b = t >> 12, tp = t & 4095, n = tp + 1;
        const size_t kb0 = (size_t)b * SEQ;
#pragma unroll
        for (int j = 0; j < 8; ++j) qf[j * 64 + lane] = bf2f(QI[(size_t)t * 512 + j * 64 + lane]);
        float wv[8];
#pragma unroll
        for (int h = 0; h < 8; ++h) wv[h] = WI[(size_t)t * 8 + h];
        LDS_WAIT();
#pragma unroll 1
        for (int s0 = 0; s0 < n; s0 += 64) {
            asm volatile("" ::: "memory");
            const int s = s0 + lane;
            float score = -INFINITY;
            if (s < n) {
                const v4u* kp = (const v4u*)(KIb + (kb0 + s) * 64);
                float dh[8];
#pragma unroll
                for (int h = 0; h < 8; ++h) dh[h] = 0.f;
#pragma unroll 1
                for (int half = 0; half < 2; ++half) {
                    asm volatile("" ::: "memory");
                    float kf[32];
#pragma unroll
                    for (int i = 0; i < 4; ++i) { const v4u w = kp[half * 4 + i]; kf[8 * i] = bflo(w.x); kf[8 * i + 1] = bfhi(w.x); kf[8 * i + 2] = bflo(w.y); kf[8 * i + 3] = bfhi(w.y); kf[8 * i + 4] = bflo(w.z); kf[8 * i + 5] = bfhi(w.z); kf[8 * i + 6] = bflo(w.w); kf[8 * i + 7] = bfhi(w.w); }
#pragma unroll
                    for (int h = 0; h < 8; ++h) { float d = 0.f;
#pragma unroll
                        for (int i = 0; i < 8; ++i) { const f32x4 qv = *(const LAS f32x4*)(qf + h * 64 + half * 32 + 4 * i); d += qv.x * kf[4 * i] + qv.y * kf[4 * i + 1] + qv.z * kf[4 * i + 2] + qv.w * kf[4 * i + 3]; }
                        dh[h] += d; __builtin_amdgcn_sched_barrier(0); }
                }
                float a = 0.f;
#pragma unroll
                for (int h = 0; h < 8; ++h) a += wv[h] * fmaxf(dh[h] * 0.125f, 0.f);
                score = a;
            }
            sc[s] = score;
        }
        LDS_WAIT();
        int nsel;
        if (n <= 256) { for (int i = lane; i < n; i += 64) list[i] = i; nsel = n; }
        else {
            const int nch = (n + 63) >> 6;
            unsigned thr = 0u;
#pragma unroll 1
            for (int bit = 31; bit >= 0; --bit) {
                const unsigned cand = thr | (1u << bit); int cnt = 0;
#pragma unroll 1
                for (int j = 0; j < nch; ++j) { const int s = j * 64 + lane; if (s < n) cnt += (fkey(sc[s]) >= cand) ? 1 : 0; }
                cnt = wave_sum_i(cnt);
                if (cnt >= 256) thr = cand;
            }
            int cgt = 0;
            for (int j = 0; j < nch; ++j) { const int s = j * 64 + lane; if (s < n) cgt += (fkey(sc[s]) > thr) ? 1 : 0; }
            cgt = wave_sum_i(cgt);
            const int need_eq = 256 - cgt;
            int run = 0, eqrun = 0;
            const unsigned long long lt = (lane == 0) ? 0ull : (~0ull >> (64 - lane));
            for (int j = 0; j < nch; ++j) {
                const int s = j * 64 + lane; const bool in = s < n; const unsigned k = in ? fkey(sc[s]) : 0u;
                const bool gt = in && k > thr, eq = in && k == thr;
                const unsigned long long beq = __ballot(eq);
                const int myeq = eqrun + __popcll(beq & lt);
                const bool sel = gt || (eq && myeq < need_eq);
                const unsigned long long bs = __ballot(sel);
                if (sel) list[run + __popcll(bs & lt)] = s;
                run += __popcll(bs); eqrun += __popcll(beq);
            }
            nsel = run;
        }
        LDS_WAIT();
#pragma unroll
        for (int j = 0; j < 8; ++j) qf[j * 64 + lane] = bf2f(Q[(size_t)t * 512 + j * 64 + lane]);
        LDS_WAIT();
        float mx[8];
#pragma unroll
        for (int h = 0; h < 8; ++h) mx[h] = -INFINITY;
#pragma unroll 1
        for (int i0 = 0; i0 < nsel; i0 += 64) {
            asm volatile("" ::: "memory");
            const int i = i0 + lane;
            if (i < nsel) {
                const int s = list[i];
                const v4u* kp = (const v4u*)(Kb + (kb0 + s) * 64);
                float dh[8];
#pragma unroll
                for (int h = 0; h < 8; ++h) dh[h] = 0.f;
#pragma unroll 1
                for (int half = 0; half < 2; ++half) {
                    asm volatile("" ::: "memory");
                    float kf[32];
#pragma unroll
                    for (int q = 0; q < 4; ++q) { const v4u w = kp[half * 4 + q]; kf[8 * q] = bflo(w.x); kf[8 * q + 1] = bfhi(w.x); kf[8 * q + 2] = bflo(w.y); kf[8 * q + 3] = bfhi(w.y); kf[8 * q + 4] = bflo(w.z); kf[8 * q + 5] = bfhi(w.z); kf[8 * q + 6] = bflo(w.w); kf[8 * q + 7] = bfhi(w.w); }
#pragma unroll
                    for (int h = 0; h < 8; ++h) { float d = 0.f;
#pragma unroll
                        for (int q = 0; q < 8; ++q) { const f32x4 qv = *(const LAS f32x4*)(qf + h * 64 + half * 32 + 4 * q); d += qv.x * kf[4 * q] + qv.y * kf[4 * q + 1] + qv.z * kf[4 * q + 2] + qv.w * kf[4 * q + 3]; }
                        dh[h] += d; __builtin_amdgcn_sched_barrier(0); }
                }
#pragma unroll
                for (int h = 0; h < 8; ++h) { const float d = dh[h] * 0.125f; sc[i * 8 + h] = d; mx[h] = fmaxf(mx[h], d); }
            }
        }
        float lsum[8];
#pragma unroll
        for (int h = 0; h < 8; ++h) { mx[h] = wave_max(mx[h]); lsum[h] = 0.f; }
        LDS_WAIT();
        for (int i0 = 0; i0 < nsel; i0 += 64) {
            const int i = i0 + lane;
            if (i < nsel) {
#pragma unroll
                for (int h = 0; h < 8; ++h) { const float pv = __expf(sc[i * 8 + h] - mx[h]); sc[i * 8 + h] = pv; lsum[h] += pv; }
            }
        }
#pragma unroll
        for (int h = 0; h < 8; ++h) lsum[h] = wave_sum(lsum[h]);
        LDS_WAIT();
        float o[8];
#pragma unroll
        for (int h = 0; h < 8; ++h) o[h] = 0.f;
#pragma unroll 2
        for (int i = 0; i < nsel; ++i) {
            const int s = list[i];
            const float v = bf2f(Vb[(kb0 + s) * 64 + lane]);
            const f32x4 p0 = *(const LAS f32x4*)(sc + i * 8), p1 = *(const LAS f32x4*)(sc + i * 8 + 4);
            o[0] += p0.x * v; o[1] += p0.y * v; o[2] += p0.z * v; o[3] += p0.w * v; o[4] += p1.x * v; o[5] += p1.y * v; o[6] += p1.z * v; o[7] += p1.w * v;
        }
#pragma unroll
        for (int h = 0; h < 8; ++h) MIX[(size_t)t * D + 512 + h * 64 + lane] = (bf16)f2bf(o[h] / lsum[h]);
        LDS_WAIT();
    }
}


typedef float f32x16 __attribute__((ext_vector_type(16)));
constexpr int DS_SC = 0;
constexpr int DS_BM = 131072;
constexpr int DS_WT = DS_BM + 8192;
constexpr int DS_MRG = 32768;
__device__ __forceinline__ void swap32(float v, float& lo, float& hi) { float a = v, b = v; asm volatile("s_nop 1\n\tv_permlane32_swap_b32 %0, %1\n\ts_nop 1" : "+v"(a), "+v"(b)); lo = a; hi = b; }
__device__ __forceinline__ float swap32_sum(float v) { float a, b; swap32(v, a, b); return a + b; }
__device__ __forceinline__ float swap32_max(float v) { float a, b; swap32(v, a, b); return fmaxf(a, b); }
__device__ __forceinline__ float dppf(float v, const int ctrl) { return v; }
#define DPP_F(v, ctrl) __builtin_bit_cast(float, __builtin_amdgcn_update_dpp(0, __builtin_bit_cast(int, (v)), (ctrl), 0xF, 0xF, false))
__device__ __forceinline__ float wave_max_dpp(float v) {
    v = fmaxf(v, DPP_F(v, 0xB1)); v = fmaxf(v, DPP_F(v, 0x4E)); v = fmaxf(v, DPP_F(v, 0x141)); v = fmaxf(v, DPP_F(v, 0x140));
    const float a = __builtin_bit_cast(float, __builtin_amdgcn_readlane(__builtin_bit_cast(int, v), 0)), b = __builtin_bit_cast(float, __builtin_amdgcn_readlane(__builtin_bit_cast(int, v), 16));
    const float c = __builtin_bit_cast(float, __builtin_amdgcn_readlane(__builtin_bit_cast(int, v), 32)), d = __builtin_bit_cast(float, __builtin_amdgcn_readlane(__builtin_bit_cast(int, v), 48));
    return fmaxf(fmaxf(a, b), fmaxf(c, d));
}
__device__ __forceinline__ float wave_sum_dppf(float v) {
    v += DPP_F(v, 0xB1); v += DPP_F(v, 0x4E); v += DPP_F(v, 0x141); v += DPP_F(v, 0x140);
    const float a = __builtin_bit_cast(float, __builtin_amdgcn_readlane(__builtin_bit_cast(int, v), 0)), b = __builtin_bit_cast(float, __builtin_amdgcn_readlane(__builtin_bit_cast(int, v), 16));
    const float c = __builtin_bit_cast(float, __builtin_amdgcn_readlane(__builtin_bit_cast(int, v), 32)), d = __builtin_bit_cast(float, __builtin_amdgcn_readlane(__builtin_bit_cast(int, v), 48));
    return (a + b) + (c + d);
}
__device__ __forceinline__ int wave_sum_dpp(int v) {
    v += __builtin_amdgcn_update_dpp(0, v, 0xB1, 0xF, 0xF, false);
    v += __builtin_amdgcn_update_dpp(0, v, 0x4E, 0xF, 0xF, false);
    v += __builtin_amdgcn_update_dpp(0, v, 0x141, 0xF, 0xF, false);
    v += __builtin_amdgcn_update_dpp(0, v, 0x140, 0xF, 0xF, false);
    return __builtin_amdgcn_readlane(v, 0) + __builtin_amdgcn_readlane(v, 16) + __builtin_amdgcn_readlane(v, 32) + __builtin_amdgcn_readlane(v, 48);
}
__device__ __forceinline__ void phase_dsa2(Frame& F, ArgsP AR, unsigned long long* probe_acc) {
    unsigned long long ps0_ = (PROBE_PHASE >= 300 && PROBE_PHASE < 400) ? __builtin_amdgcn_s_memrealtime() : 0ull;
#define PSECD(id) do { if (PROBE_PHASE >= 300 && PROBE_PHASE < 400) { const unsigned long long n_ = __builtin_amdgcn_s_memrealtime(); if (PROBE_PHASE == 300 + (id)) *probe_acc += n_ - ps0_; ps0_ = n_; } } while (0)
    const bf16* Q = (const bf16*)(F.ws + BG_Q); const bf16* QI = (const bf16*)(F.ws + BG_QI); const bf16* Kb = (const bf16*)(F.ws + BG_K); const bf16* VT = (const bf16*)(F.ws + BG_VT);
    const bf16* KIb = (const bf16*)(F.ws + BG_KI); const float* WI = (const float*)(F.ws + BG_WI); bf16* MIX = (bf16*)(F.ws + BG_MIX);
    LAS unsigned short* SC = (LAS unsigned short*)(F.lds + DS_SC);
    LAS unsigned char* BM = F.lds + DS_BM;
    LAS float* WT = (LAS float*)(F.lds + DS_WT);
    const int lane = F.lane, w = F.wave, tid = F.tid;
    const int r32 = lane & 31, h = lane >> 5;
    const int nunits = T / 16;
#pragma unroll 1
    for (int i = 0; ; ++i) {
        int j = i * F.G + ((i & 1) ? (F.G - 1 - F.bid) : F.bid);
        if (i * F.G >= nunits) break;
        if (j >= nunits) continue;
        const int b = j & 3, qt = j >> 2;
        const int tp0 = qt * 16, t0 = b * SEQ + tp0;
        const int n_keys = tp0 + 16;
        const int nkt = (n_keys + 31) >> 5, n_comp = nkt * 32, nst = (n_keys + 63) >> 6;
        const size_t kb0 = (size_t)b * SEQ;
        PSECD(3);
        if (tid < 128) WT[tid] = WI[(size_t)t0 * 8 + tid] * 0.125f;
        {
            const int ptl = ((r32 >> 2) & 1) * 2 + (r32 >> 4), phd = ((r32 >> 3) & 1) * 4 + (r32 & 3);
            bf16x8 af[4][4];
#pragma unroll
            for (int rb = 0; rb < 4; ++rb)
#pragma unroll
                for (int ks = 0; ks < 4; ++ks) af[rb][ks] = *(const bf16x8*)(QI + ((size_t)(t0 + 4 * rb + ptl) * 8 + phd) * 64 + ks * 16 + h * 8);
            __syncthreads();
            bf16x8 bfr[4], bnx[4];
            if (w < nkt) {
                const bf16* kp = KIb + (kb0 + w * 32 + r32) * 64 + h * 8;
#pragma unroll
                for (int ks = 0; ks < 4; ++ks) bfr[ks] = *(const bf16x8*)(kp + ks * 16);
            }
#pragma unroll 1
            for (int kt = w; kt < nkt; kt += 8) {
                {
                    const int ktn = (kt + 8 < nkt) ? kt + 8 : kt;
                    const bf16* kp = KIb + (kb0 + ktn * 32 + r32) * 64 + h * 8;
#pragma unroll
                    for (int ks = 0; ks < 4; ++ks) bnx[ks] = *(const bf16x8*)(kp + ks * 16);
                }
                const int s = kt * 32 + r32;
#pragma unroll
                for (int rb = 0; rb < 4; ++rb) {
                    f32x16 acc = {0.f, 0.f, 0.f, 0.f, 0.f, 0.f, 0.f, 0.f, 0.f, 0.f, 0.f, 0.f, 0.f, 0.f, 0.f, 0.f};
#pragma unroll
                    for (int ks = 0; ks < 4; ++ks) acc = __builtin_amdgcn_mfma_f32_32x32x16_bf16(af[rb][ks], bfr[ks], acc, 0, 0, 0);
#pragma unroll
                    for (int j = 0; j < 2; ++j) {
                        const int tk = 4 * rb + 2 * h + j;
                        const f32x4 w0 = *(const LAS f32x4*)(WT + tk * 8), w1 = *(const LAS f32x4*)(WT + tk * 8 + 4);
                        const float part = (w0.x * fmaxf(acc[8 * j], 0.f) + w0.y * fmaxf(acc[8 * j + 1], 0.f)) + (w0.z * fmaxf(acc[8 * j + 2], 0.f) + w0.w * fmaxf(acc[8 * j + 3], 0.f))
                                         + (w1.x * fmaxf(acc[8 * j + 4], 0.f) + w1.y * fmaxf(acc[8 * j + 5], 0.f)) + (w1.z * fmaxf(acc[8 * j + 6], 0.f) + w1.w * fmaxf(acc[8 * j + 7], 0.f));
                        const _Float16 hf = (_Float16)part; const unsigned hb = (unsigned)__builtin_bit_cast(unsigned short, hf);
                        const unsigned key = (hb & 0x8000u) ? (~hb & 0xffffu) : (hb | 0x8000u);
                        SC[tk * 4096 + s] = (unsigned short)((s <= tp0 + tk) ? key : 0u);
                    }
                }
#pragma unroll
                for (int ks = 0; ks < 4; ++ks) bfr[ks] = bnx[ks];
            }
        }
        __syncthreads(); PSECD(0);
        {
            typedef unsigned short u16x2 __attribute__((ext_vector_type(2)));
            const int nch = (n_comp + 511) >> 9;
            const int tkA = 2 * w, tkB = 2 * w + 1;
            const LAS v4u* rowA = (const LAS v4u*)(SC + tkA * 4096); const LAS v4u* rowB = (const LAS v4u*)(SC + tkB * 4096);
            const int total = nch * 512;
            auto count_lt = [&](unsigned candA, unsigned candB, int& cA, int& cB) {
                const u16x2 ca = {(unsigned short)candA, (unsigned short)candA}, cb = {(unsigned short)candB, (unsigned short)candB}; const u16x2 one = {1, 1};
                u16x2 accA = {0, 0}, accB = {0, 0};
#pragma unroll 2
                for (int ch = 0; ch < nch; ++ch) {
                    v4u xa = (v4u){0u, 0u, 0u, 0u}, xb = xa; if (ch * 512 + lane * 8 < n_comp) { xa = rowA[ch * 64 + lane]; xb = rowB[ch * 64 + lane]; }
                    const unsigned wa[4] = {xa.x, xa.y, xa.z, xa.w}, wb[4] = {xb.x, xb.y, xb.z, xb.w};
#pragma unroll
                    for (int d = 0; d < 4; ++d) {
                        accA += __builtin_elementwise_min(__builtin_elementwise_sub_sat(ca, __builtin_bit_cast(u16x2, wa[d])), one);
                        accB += __builtin_elementwise_min(__builtin_elementwise_sub_sat(cb, __builtin_bit_cast(u16x2, wb[d])), one);
                    }
                }
                cA = wave_sum_dpp((int)accA.x + (int)accA.y); cB = wave_sum_dpp((int)accB.x + (int)accB.y);
            };
            const int nA = tp0 + tkA + 1, nB = tp0 + tkB + 1;
            unsigned thrA = 0u, thrB = 0u; int geA = total, geB = total;
            if (nB > 256) {
#pragma unroll 1
                for (int bit = 15; bit >= 0; --bit) {
                    const unsigned cA_ = thrA | (1u << bit), cB_ = thrB | (1u << bit); int ltA, ltB;
                    count_lt(cA_, cB_, ltA, ltB);
                    if (total - ltA >= 256) { thrA = cA_; geA = total - ltA; }
                    if (total - ltB >= 256) { thrB = cB_; geB = total - ltB; }
                }
                if (nA <= 256) { thrA = 0u; geA = total; }
            }
            int gtA = 0, gtB = 0;
            { int ltA, ltB; count_lt(thrA + 1u, thrB + 1u, ltA, ltB); gtA = total - ltA; gtB = total - ltB; }
            const int needA = (thrA == 0u) ? 0 : 256 - gtA, needB = (thrB == 0u) ? 0 : 256 - gtB;
            const int eqA = geA - gtA, eqB = geB - gtB;
#pragma unroll 1
            for (int q = 0; q < 2; ++q) {
                const int tk = q ? tkB : tkA; const unsigned thr = q ? thrB : thrA; const int need = q ? needB : needA; const bool all_eq = q ? (eqB == needB) : (eqA == needA);
                const LAS v4u* row = q ? rowB : rowA;
                int run = 0;
#pragma unroll 1
                for (int ch = 0; ch < nch; ++ch) {
                    v4u x = (v4u){0u, 0u, 0u, 0u}; if (ch * 512 + lane * 8 < n_comp) x = row[ch * 64 + lane];
                    const unsigned e[8] = {x.x & 0xffffu, x.x >> 16, x.y & 0xffffu, x.y >> 16, x.z & 0xffffu, x.z >> 16, x.w & 0xffffu, x.w >> 16};
                    unsigned gtb = 0u, eqb = 0u;
#pragma unroll
                    for (int k = 0; k < 8; ++k) { gtb |= (e[k] > thr) ? (1u << k) : 0u; eqb |= (e[k] == thr) ? (1u << k) : 0u; }
                    unsigned selb = gtb;
                    if (need > 0) {
                        if (all_eq) selb |= eqb;
                        else {
                            const int c = __popc(eqb); int inc = c;
#pragma unroll
                            for (int o = 1; o < 64; o <<= 1) { const int up = __shfl_up(inc, o); if (lane >= o) inc += up; }
                            const int before = run + inc - c;
                            int take = need - before; take = take < 0 ? 0 : (take > c ? c : take);
                            unsigned eb = eqb, tb = 0u;
#pragma unroll
                            for (int k = 0; k < 8; ++k) { if (take > 0 && eb) { const unsigned lowb = eb & (0u - eb); tb |= lowb; eb ^= lowb; --take; } }
                            selb |= tb;
                            run += __shfl(inc, 63);
                        }
                    }
                    BM[tk * 512 + ch * 64 + lane] = (unsigned char)selb;
                }
            }
        }
        __syncthreads(); PSECD(1);
        {
            const int rb = w & 3, kh = w >> 2;
            const int tk = 4 * rb + (r32 >> 3);
            bf16x8 qf[4];
#pragma unroll
            for (int ks = 0; ks < 4; ++ks) qf[ks] = *(const bf16x8*)(Q + ((size_t)t0 * 8 + rb * 32 + r32) * 64 + ks * 16 + h * 8);
            f32x16 O0 = {0.f, 0.f, 0.f, 0.f, 0.f, 0.f, 0.f, 0.f, 0.f, 0.f, 0.f, 0.f, 0.f, 0.f, 0.f, 0.f}, O1 = O0;
            float m = -1e30f, l = 0.f;
            const int skey = tid >> 3, sch = tid & 7;
            const bf16* ksrc = Kb + (kb0 + skey) * 64 + sch * 8;
            const bf16* vsrc = VT + ((size_t)b * 64 + skey) * 4096 + sch * 8;
            const int kdst = skey * 128 + ((sch ^ ((skey >> 1) & 7)) << 4);
            const int vf = (skey >> 1) & 15;
            const int vdst0 = skey * 128 + (((2 * sch) ^ vf) << 3), vdst1 = skey * 128 + (((2 * sch + 1) ^ vf) << 3);
            v4u kreg = *(const v4u*)(ksrc), vreg = *(const v4u*)(vsrc);
            { LAS unsigned char* kb_ = F.lds; LAS unsigned char* vb_ = F.lds + 8192;
              *(LAS v4u*)(kb_ + kdst) = kreg; *(LAS v2u*)(vb_ + vdst0) = (v2u){vreg.x, vreg.y}; *(LAS v2u*)(vb_ + vdst1) = (v2u){vreg.z, vreg.w}; }
            __syncthreads();
            const int krow = kh * 32 + r32;
            const int kswz = (krow >> 1) & 7;
            const int vfl0 = ((r32) >> 1) & 15, vfl1 = ((32 + r32) >> 1) & 15;
            constexpr float C2 = 0.125f * 1.4426950408889634f;
#pragma unroll 1
            for (int st = 0; st < nst; ++st) {
                const int cur = (st & 1) * 16384;
                { const int stn = (st + 1 < nst) ? st + 1 : st; kreg = *(const v4u*)(ksrc + (size_t)stn * 64 * 64); vreg = *(const v4u*)(vsrc + stn * 64); }
                const LAS unsigned char* kt_ = F.lds + cur; const LAS unsigned char* vt_ = F.lds + cur + 8192;
                f32x16 sv = {0.f, 0.f, 0.f, 0.f, 0.f, 0.f, 0.f, 0.f, 0.f, 0.f, 0.f, 0.f, 0.f, 0.f, 0.f, 0.f};
#pragma unroll
                for (int ks = 0; ks < 4; ++ks) { const bf16x8 ka = *(const LAS bf16x8*)(kt_ + krow * 128 + (((2 * ks + h) ^ kswz) << 4)); sv = __builtin_amdgcn_mfma_f32_32x32x16_bf16(ka, qf[ks], sv, 0, 0, 0); }
                const unsigned mw = *(const LAS unsigned*)(BM + tk * 512 + (2 * st + kh) * 4) >> (4 * h);
                float mt = fmaxf(fmaxf(sv[0], sv[1]), fmaxf(sv[2], sv[3]));
#pragma unroll
                for (int r = 4; r < 16; r += 4) mt = fmaxf(mt, fmaxf(fmaxf(sv[r], sv[r + 1]), fmaxf(sv[r + 2], sv[r + 3])));
                mt = swap32_max(mt) * C2;
                if (__builtin_amdgcn_ballot_w64(mt > m) != 0ull) {
                    const float mn = fmaxf(m, mt); const float alpha = __builtin_amdgcn_exp2f(m - mn); m = mn;
                    l *= alpha;
#pragma unroll
                    for (int r = 0; r < 16; ++r) { O0[r] *= alpha; O1[r] *= alpha; }
                }
                const float nm = -m;
                float ls = 0.f;
#pragma unroll
                for (int r = 0; r < 16; ++r) { const int kl = (r & 3) + 8 * (r >> 2);
                    const float pe = __builtin_amdgcn_exp2f(__builtin_fmaf(sv[r], C2, nm));
                    const int keep = __builtin_amdgcn_sbfe((int)mw, kl, 1);
                    sv[r] = __builtin_bit_cast(float, __builtin_bit_cast(int, pe) & keep); ls += sv[r]; }
                l += ls;
                bf16x8 pb[2];
#pragma unroll
                for (int s2 = 0; s2 < 2; ++s2) { v4u pk; pk.x = pk2(sv[8 * s2], sv[8 * s2 + 1]); pk.y = pk2(sv[8 * s2 + 2], sv[8 * s2 + 3]); pk.z = pk2(sv[8 * s2 + 4], sv[8 * s2 + 5]); pk.w = pk2(sv[8 * s2 + 6], sv[8 * s2 + 7]); pb[s2] = __builtin_bit_cast(bf16x8, pk); }
#pragma unroll
                for (int s2 = 0; s2 < 2; ++s2) {
                    const int c8 = 8 * kh + 4 * s2 + h;
                    { const v2u a0 = *(const LAS v2u*)(vt_ + r32 * 128 + ((c8 ^ vfl0) << 3)), a1 = *(const LAS v2u*)(vt_ + r32 * 128 + (((c8 + 2) ^ vfl0) << 3));
                      const v4u av = (v4u){a0.x, a0.y, a1.x, a1.y}; O0 = __builtin_amdgcn_mfma_f32_32x32x16_bf16(__builtin_bit_cast(bf16x8, av), pb[s2], O0, 0, 0, 0); }
                    { const v2u a0 = *(const LAS v2u*)(vt_ + (32 + r32) * 128 + ((c8 ^ vfl1) << 3)), a1 = *(const LAS v2u*)(vt_ + (32 + r32) * 128 + (((c8 + 2) ^ vfl1) << 3));
                      const v4u av = (v4u){a0.x, a0.y, a1.x, a1.y}; O1 = __builtin_amdgcn_mfma_f32_32x32x16_bf16(__builtin_bit_cast(bf16x8, av), pb[s2], O1, 0, 0, 0); }
                }
                { LAS unsigned char* kb_ = F.lds + (cur ^ 16384); LAS unsigned char* vb_ = kb_ + 8192;
                    *(LAS v4u*)(kb_ + kdst) = kreg; *(LAS v2u*)(vb_ + vdst0) = (v2u){vreg.x, vreg.y}; *(LAS v2u*)(vb_ + vdst1) = (v2u){vreg.z, vreg.w}; }
                __syncthreads();
            }
            l = swap32_sum(l);
            LAS float* mg = (LAS float*)(F.lds + DS_MRG + rb * 8704);
            if (kh == 1) {
#pragma unroll
                for (int r = 0; r < 16; ++r) { mg[r * 64 + lane] = O0[r]; mg[(16 + r) * 64 + lane] = O1[r]; }
                if (h == 0) { mg[2048 + r32] = m; mg[2048 + 32 + r32] = l; }
            }
            __syncthreads();
            if (kh == 0) {
                const float m1 = mg[2048 + r32], l1 = mg[2048 + 32 + r32];
                const float mf = fmaxf(m, m1); const float a0 = __builtin_amdgcn_exp2f(m - mf), a1 = __builtin_amdgcn_exp2f(m1 - mf);
                const float inv = 1.0f / (l * a0 + l1 * a1);
                bf16* orow = MIX + (size_t)(t0 + tk) * D + 512 + (r32 & 7) * 64;
#pragma unroll
                for (int g4 = 0; g4 < 4; ++g4) {
                    float o0[4], o1[4];
#pragma unroll
                    for (int k = 0; k < 4; ++k) { const int r = 4 * g4 + k; o0[k] = (O0[r] * a0 + mg[r * 64 + lane] * a1) * inv; o1[k] = (O1[r] * a0 + mg[(16 + r) * 64 + lane] * a1) * inv; }
                    v2u s0; s0.x = pk2(o0[0], o0[1]); s0.y = pk2(o0[2], o0[3]); *(v2u*)(orow + 8 * g4 + 4 * h) = s0;
                    v2u s1; s1.x = pk2(o1[0], o1[1]); s1.y = pk2(o1[2], o1[3]); *(v2u*)(orow + 32 + 8 * g4 + 4 * h) = s1;
                }
            }
            __syncthreads(); PSECD(2);
        }
    }
}

constexpr int LDS_RT = 131072;
__device__ __forceinline__ void phase_router(Frame& F, ArgsP AR, int l, unsigned long long* probe_acc) {
    unsigned long long psr_ = 0ull;
#define PSECR(id) do { if (PROBE_PHASE >= 100 && PROBE_PHASE < 200) { const unsigned long long n_ = __builtin_amdgcn_s_memrealtime(); if (PROBE_PHASE == 100 + (id)) *probe_acc += n_ - psr_; psr_ = n_; } } while (0)
    const float* X = F.out; const float* gamma = FIN(6) + (size_t)l * D; const int m = 2 * l + 1;
    const float* MOD = (const float*)(F.ws + WS_MOD); const float* RW = FIN(25) + (size_t)l * D * 64; const float* RB = FIN(26) + (size_t)l * 64;
    bf16* Hout = (bf16*)(F.ws + WS_H); unsigned* ctl = (unsigned*)(F.ws + WS_CTL);
    int* EIDX = (int*)(F.ws + WS_EIDX); int* SLOT = (int*)(F.ws + WS_SLOT); int* ELT = (int*)(F.ws + WS_ELT); float* ELW = (float*)(F.ws + WS_ELW);
    constexpr int HS = 1028;
    LAS float* hbuf = (LAS float*)F.lds;
    LAS float* part = (LAS float*)(F.lds + 69632);
    LAS int* lcnt = (LAS int*)(F.lds + LDS_RT); LAS int* lbase = lcnt + 64;
    const int lane = F.lane, w = F.wave;
    const float rb = RB[lane];
    if (F.tid < 64) lcnt[F.tid] = 0;
    const int nround = (T / 16 + F.G - 1) / F.G;
#pragma unroll 1
    for (int rd = 0; rd < nround; ++rd) {
        const int blk = rd * F.G + F.bid;
        const bool live = blk < T / 16;
        const int base = blk * 16;
        __syncthreads();
        PSECR(5);
        if (live) {
            const int b = base >> 12;
            const float* shift = MOD + (size_t)(m * 4 + b) * 3072; const float* scale = shift + 1024;
#pragma unroll
            for (int q = 0; q < 2; ++q) {
                const int tl = 2 * w + q, row = base + tl;
                const f32x4* xr = (const f32x4*)(X + (size_t)row * D) + lane;
                f32x4 v[4]; float ss = 0.f;
#pragma unroll
                for (int j = 0; j < 4; ++j) { v[j] = xr[64 * j]; ss += v[j].x * v[j].x + v[j].y * v[j].y + v[j].z * v[j].z + v[j].w * v[j].w; }
                const float rstd = rsqrtf(wave_sum(ss) * (1.0f / D) + 1e-6f);
#pragma unroll
                for (int j = 0; j < 4; ++j) {
                    const int c0 = 4 * lane + 256 * j;
                    const f32x4 gg = *(const f32x4*)(gamma + c0), sc = *(const f32x4*)(scale + c0), sh = *(const f32x4*)(shift + c0);
                    f32x4 h; h.x = v[j].x * rstd * gg.x * (1.f + sc.x) + sh.x; h.y = v[j].y * rstd * gg.y * (1.f + sc.y) + sh.y;
                    h.z = v[j].z * rstd * gg.z * (1.f + sc.z) + sh.z; h.w = v[j].w * rstd * gg.w * (1.f + sc.w) + sh.w;
                    v2u o; o.x = pk2(h.x, h.y); o.y = pk2(h.z, h.w); *(v2u*)(Hout + (size_t)row * D + c0) = o;
                    *(LAS f32x4*)(hbuf + tl * HS + c0) = h;
                }
            }
        }
        __syncthreads(); PSECR(0);
        if (live) {
            f32x4 c4[4];
#pragma unroll
            for (int j = 0; j < 4; ++j) c4[j] = (f32x4){0.f, 0.f, 0.f, 0.f};
            const LAS float* ap = hbuf + (lane & 15) * HS + 128 * w + (lane >> 4);
            const float* rw = RW + (size_t)(128 * w + (lane >> 4)) * 64 + (lane & 15);
#pragma unroll 1
            for (int half = 0; half < 2; ++half) {
                float bw[16][4];
#pragma unroll
                for (int ks = 0; ks < 16; ++ks)
#pragma unroll
                    for (int j = 0; j < 4; ++j) bw[ks][j] = rw[(size_t)(16 * half + ks) * 256 + 16 * j];
#pragma unroll
                for (int ks = 0; ks < 16; ++ks) { const float a = ap[4 * (16 * half + ks)];
#pragma unroll
                    for (int j = 0; j < 4; ++j) c4[j] = __builtin_amdgcn_mfma_f32_16x16x4f32(a, bw[ks][j], c4[j], 0, 0, 0); }
            }
#pragma unroll
            for (int j = 0; j < 4; ++j)
#pragma unroll
                for (int r = 0; r < 4; ++r) part[(w * 16 + 4 * (lane >> 4) + r) * 64 + 16 * j + (lane & 15)] = c4[j][r];
        }
        __syncthreads(); PSECR(1);
        float gwt[2]; int rk[2], lp[2];
#pragma unroll
        for (int q = 0; q < 2; ++q) { gwt[q] = 0.f; rk[q] = -1; lp[q] = 0; }
        if (live) {
#pragma unroll
            for (int q = 0; q < 2; ++q) {
                const int tl = 2 * w + q;
                float lg = 0.f;
#pragma unroll
                for (int ww = 0; ww < 8; ++ww) lg += part[(ww * 16 + tl) * 64 + lane];
                const float score = sigmoidf_(lg);
                const float sel = score + rb;
                float m1 = sel; m1 = fmaxf(m1, DPP_F(m1, 0xB1)); m1 = fmaxf(m1, DPP_F(m1, 0x4E)); m1 = fmaxf(m1, DPP_F(m1, 0x141));
                const unsigned long long bm = __ballot(sel == m1);
                const int g = lane >> 3; const unsigned gm = (unsigned)((bm >> (8 * g)) & 0xffull); const int first = 8 * g + __builtin_ctz(gm);
                float m2 = (lane == first) ? -INFINITY : sel; m2 = fmaxf(m2, DPP_F(m2, 0xB1)); m2 = fmaxf(m2, DPP_F(m2, 0x4E)); m2 = fmaxf(m2, DPP_F(m2, 0x141));
                const float gs = m1 + m2;
                int grank = 0;
#pragma unroll
                for (int gg = 0; gg < 8; ++gg) { const float o = __builtin_bit_cast(float, __builtin_amdgcn_readlane(__builtin_bit_cast(int, gs), gg * 8)); grank += (o > gs || (o == gs && gg < g)) ? 1 : 0; }
                float masked = (grank < 4) ? sel : -INFINITY;
                int rank = -1; float ssum = 0.f;
#pragma unroll
                for (int it = 0; it < 8; ++it) {
                    const float mx = wave_max_dpp(masked);
                    const unsigned long long bb = __ballot(masked == mx);
                    const int win = (int)__builtin_ctzll(bb);
                    if (lane == win) { rank = it; masked = -INFINITY; }
                    ssum += __builtin_bit_cast(float, __builtin_amdgcn_readlane(__builtin_bit_cast(int, score), win));
                }
                const bool chosen = rank >= 0;
                gwt[q] = score / ssum * 2.5f; rk[q] = rank;
                if (chosen) lp[q] = __hip_atomic_fetch_add(&lcnt[lane], 1, __ATOMIC_RELAXED, __HIP_MEMORY_SCOPE_WORKGROUP);
            }
        }
        __syncthreads(); PSECR(2);
        if (F.tid < 64) { const int c = lcnt[F.tid]; int gb = 0; if (c > 0) gb = (int)atomicAdd(&ctl[CW_CNT + (l * 64 + F.tid) * 64], (unsigned)c); lbase[F.tid] = gb; lcnt[F.tid] = 0; }
        __syncthreads(); PSECR(3);
        if (live) {
            const int gb = lbase[lane];
#pragma unroll
            for (int q = 0; q < 2; ++q) if (rk[q] >= 0) {
                const int row = base + 2 * w + q, pos = gb + lp[q];
                ELT[(size_t)lane * ECAP + pos] = row; ELW[(size_t)lane * ECAP + pos] = gwt[q];
                EIDX[(size_t)row * 8 + rk[q]] = lane; SLOT[(size_t)row * 8 + rk[q]] = pos;
            }
        }
    }
    __syncthreads();
}
typedef float f32x2v __attribute__((ext_vector_type(2)));
__device__ __forceinline__ void acc_fp8x16(f32x4 (&a)[4], const v4u w) {
    const unsigned d[4] = {w.x, w.y, w.z, w.w};
#pragma unroll
    for (int j = 0; j < 4; ++j) { const f32x2v lo = __builtin_amdgcn_cvt_pk_f32_fp8((int)d[j], false), hi = __builtin_amdgcn_cvt_pk_f32_fp8((int)d[j], true); a[j].x += lo.x; a[j].y += lo.y; a[j].z += hi.x; a[j].w += hi.y; }
}
__device__ __forceinline__ void phase_combine(Frame& F, int l, const float* gamma, int mnext, float* Hf) {
    moe_tables(F, l);
    const LAS int* est = (const LAS int*)(F.lds + LDS_MOE);
    const int* EIDX = (const int*)(F.ws + WS_EIDX); const int* SLOT = (const int*)(F.ws + WS_SLOT);
    const unsigned char* Y = F.ws + BG_Y; const unsigned char* YSH = F.ws + BG_YSH;
    const float* MOD = (const float*)(F.ws + WS_MOD); const float* gate = MOD + (size_t)((2 * l + 1) * 4) * 3072 + 2048; float* X = F.out;
    const int lane = F.lane, c0 = 16 * lane;
#pragma unroll 1
    for (int row = F.gw; row < T; row += F.NGW) {
        const int b = row >> 12;
        const v4u e0 = *(const v4u*)(EIDX + (size_t)row * 8), e1 = *(const v4u*)(EIDX + (size_t)row * 8 + 4), p0 = *(const v4u*)(SLOT + (size_t)row * 8), p1 = *(const v4u*)(SLOT + (size_t)row * 8 + 4);
        size_t yr[8];
        yr[0] = (size_t)(est[e0.x] + (int)p0.x); yr[1] = (size_t)(est[e0.y] + (int)p0.y); yr[2] = (size_t)(est[e0.z] + (int)p0.z); yr[3] = (size_t)(est[e0.w] + (int)p0.w);
        yr[4] = (size_t)(est[e1.x] + (int)p1.x); yr[5] = (size_t)(est[e1.y] + (int)p1.y); yr[6] = (size_t)(est[e1.z] + (int)p1.z); yr[7] = (size_t)(est[e1.w] + (int)p1.w);
        v4u yw[9];
        yw[8] = *(const v4u*)(YSH + (size_t)row * D + c0);
#pragma unroll
        for (int k = 0; k < 8; ++k) yw[k] = *(const v4u*)(Y + yr[k] * D + c0);
        f32x4 a[4];
#pragma unroll
        for (int j = 0; j < 4; ++j) a[j] = (f32x4){0.f, 0.f, 0.f, 0.f};
#pragma unroll
        for (int k = 0; k < 9; ++k) acc_fp8x16(a, yw[k]);
        float ss = 0.f;
#pragma unroll
        for (int j = 0; j < 4; ++j) { const f32x4 g = *(const f32x4*)(gate + (size_t)b * 3072 + c0 + 4 * j);
            f32x4* xp = (f32x4*)(X + (size_t)row * D + c0 + 4 * j); a[j] = *xp + g * (a[j] * Y8_INV); *xp = a[j]; ss += a[j].x * a[j].x + a[j].y * a[j].y + a[j].z * a[j].z + a[j].w * a[j].w; }
        if (Hf) {
            const float* shift = MOD + (size_t)(mnext * 4 + b) * 3072; const float* scale = shift + 1024;
            const float rstd = rsqrtf(wave_sum(ss) * (1.0f / D) + 1e-6f);
#pragma unroll
            for (int j = 0; j < 4; ++j) { const int cc = c0 + 4 * j;
                const f32x4 gg = *(const f32x4*)(gamma + cc), sc = *(const f32x4*)(scale + cc), sh = *(const f32x4*)(shift + cc);
                f32x4 h; h.x = a[j].x * rstd * gg.x * (1.f + sc.x) + sh.x; h.y = a[j].y * rstd * gg.y * (1.f + sc.y) + sh.y; h.z = a[j].z * rstd * gg.z * (1.f + sc.z) + sh.z; h.w = a[j].w * rstd * gg.w * (1.f + sc.w) + sh.w;
                *(f32x4*)(Hf + (size_t)row * D + cc) = h; }
        }
    }
}
__device__ __forceinline__ void phase_pool(Frame& F) {
    const float* Hf = (const float*)(F.ws + BG_H2F); bf16* P = (bf16*)(F.ws + WS_H);
    for (int row = F.gw; row < T; row += F.NGW) {
        const int tp = row & 4095;
#pragma unroll
        for (int j = 0; j < 4; ++j) {
            const int win = 2 << j, c0 = 4 * F.lane + 256 * j;
            const int lo = (tp - win + 1) > 0 ? (tp - win + 1) : 0; const int cnt = tp - lo + 1;
            f32x4 s = (f32x4){0.f, 0.f, 0.f, 0.f};
            for (int q = 0; q < cnt; ++q) s = s + *(const f32x4*)(Hf + (size_t)(row - q) * D + c0);
            const f32x4 h = *(const f32x4*)(Hf + (size_t)row * D + c0);
            const float inv = 1.0f / (float)cnt;
            v2u o; o.x = pk2(s.x * inv - h.x, s.y * inv - h.y); o.y = pk2(s.z * inv - h.z, s.w * inv - h.w);
            *(v2u*)(P + (size_t)row * D + c0) = o;
        }
    }
}

constexpr int NPHASE = 29;
__global__ void __launch_bounds__(512, 2) mega(Args args_formal) {
    ArgsP const ap0 = (ArgsP)__builtin_amdgcn_kernarg_segment_ptr();
    extern __shared__ __attribute__((aligned(16))) unsigned char lds_raw[];
    Frame F;
    F.lds = (LAS unsigned char*)lds_raw;
    F.tid = threadIdx.x; F.lane = F.tid & 63; F.wave = __builtin_amdgcn_readfirstlane(F.tid >> 6);
    F.bid = blockIdx.x; F.G = gridDim.x; F.gw = F.bid * 8 + F.wave; F.NGW = F.G * 8;
    F.out = ap0->out; F.ws = ap0->ws;
    unsigned* ctl = (unsigned*)(F.ws + WS_CTL);
    const int lo = ap0->ph_lo, hi = ap0->ph_hi;
    volatile LAS unsigned* bst = (volatile LAS unsigned*)(F.lds + LDS_BYTES - 16);
    XcdBarrier bar; bar.bar = ctl + CW_BAR; bar.x = 0; bar.st = bst;
    const bool multi = (hi - lo) > 1;
    if (multi) { if (F.tid == 0) { bst[0] = 0u; bst[1] = 0u; } __syncthreads(); bar = xcd_barrier_post(ctl + CW_BAR, bst); }
    unsigned long long probe_t0 = 0ull, probe_dt = 0ull, probe_sec = 0ull;
#ifndef PROBE_EXTRA_BAR
#define PROBE_EXTRA_BAR 0
#endif
#ifndef PROBE_DUP
#define PROBE_DUP 0ull
#endif
#ifndef PHMASK
#define PHMASK 0xFFFFFFFFull
#endif
#define IN(k) ((((PHMASK) >> ((k) >= 20 ? (k) - 10 : (k))) & 1ull) && lo <= (k) && (k) < hi)
#define SEAM(k) do { if ((k) + 1 < hi) xcd_barrier(bar); } while (0)
#define PH_BEGIN(k) if ((k) == PROBE_PHASE) probe_t0 = __builtin_amdgcn_s_memrealtime(); if (IN(k)) { { int t_ = threadIdx.x; asm volatile("" : "+v"(t_)); F.tid = t_; F.lane = t_ & 63; F.wave = __builtin_amdgcn_readfirstlane(t_ >> 6); F.gw = F.bid * 8 + F.wave; } ArgsP args = launder_args(ap0); ArgsP AR = args; (void)AR; F.out = args->out; F.ws = args->ws; ctl = (unsigned*)(F.ws + WS_CTL); const float* MOD = (const float*)(F.ws + WS_MOD); (void)MOD; _Pragma("unroll 1") for (int rep_ = 0; rep_ < ((((PROBE_DUP) >> ((k) >= 20 ? (k) - 10 : (k))) & 1ull) ? 2 : 1); ++rep_) { if (rep_) __syncthreads();
#define PH_END(k) } } if (multi && lo <= (k) && (k) < hi && (k) + 1 < hi) { xcd_barrier(bar); if ((k) == 0) { for (int xb_ = 0; xb_ < PROBE_EXTRA_BAR; ++xb_) xcd_barrier(bar); } } if ((k) == PROBE_PHASE) probe_dt = __builtin_amdgcn_s_memrealtime() - probe_t0;
    PH_BEGIN(0) phase_mod(F, args); __syncthreads(); phase_s5mats(F, args); phase_convert_static(F, args); phase_tables(F, args); phase_convert_experts(F, args, 0); PH_END(0)
    PH_BEGIN(1) phase_norm_mod(F, FIN(0), FIN(3), 0, (bf16*)(F.ws + WS_H), nullptr); PH_END(1)
    PH_BEGIN(3) DenseOrder S; S.init(F.ws + WS_H, F.ws + WS_WIN, 2048u, 2048u, T, INP, F.G, F.bid); EpiBf16Store E{(bf16*)(F.ws + BG_PROJ), INP};
        pg8::gemm_phase<EpiBf16Store, DenseOrder, false>(F.lds, F.tid, 1024, 2048u, 2048u, S, E); PH_END(3)
    PH_BEGIN(4) phase_postproj(F, args); PH_END(4)
    PH_BEGIN(5) S5AOrder S{F.ws, F.bid, F.G}; EpiS5A E{(float*)(F.ws + BG_SL2)}; pg8::gemm_phase<EpiS5A, S5AOrder, false>(F.lds, F.tid, 512, 1280u, 1024u, S, E); PH_END(5)
    PH_BEGIN(6) phase_s5carry(F); phase_dsa2(F, args, &probe_sec); PH_END(6)
    PH_BEGIN(7) S5BOrder S{F.ws, F.bid, F.G}; EpiS5B E{F.ws, FIN(18), FIN(19), FIN(20), (bf16*)(F.ws + BG_MIX)}; pg8::gemm_phase<EpiS5B, S5BOrder, false>(F.lds, F.tid, 640, 1280u, 1280u, S, E); PH_END(7)
    PH_BEGIN(9) DenseOrder S; S.init(F.ws + BG_MIX, F.ws + WS_WOUT, 2048u, 2048u, T, D, F.G, F.bid); EpiResidual E{FIN(0), F.out, MOD + 2048, nullptr, 0};
        pg8::gemm_phase<EpiResidual, DenseOrder, false>(F.lds, F.tid, 1024, 2048u, 2048u, S, E); PH_END(9)
#define MOE_PHASES(pb, l) \
    PH_BEGIN(pb) phase_router(F, args, l, &probe_sec); PH_END(pb) \
    PH_BEGIN(pb + 1) moe_tables(F, l); typedef MoeOrder<2, true> O; O S; S.init(F.lds, F.ws, false, true, F.G, F.bid); EpiGateUp<O> E{&S, F.ws}; \
        pg8::gemm_phase<EpiGateUp<O>, O, true>(F.lds, F.tid, 1024, 2048u, 2048u, S, E); PH_END(pb + 1) \
    PH_BEGIN(pb + 2) moe_tables(F, l); typedef MoeOrder<4, false> O; O S; S.init(F.lds, F.ws, false, true, F.G, F.bid); EpiDown<O> E{&S, F.ws}; \
        pg8::gemm_phase<EpiDown<O>, O, false>(F.lds, F.tid, 256, 512u, 512u, S, E); PH_END(pb + 2)
    MOE_PHASES(10, 0)
    PH_BEGIN(17) phase_combine(F, 0, FIN(3) + D, 2, (float*)(F.ws + BG_H2F));     phase_convert_experts(F, args, 1); PH_END(17)
    PH_BEGIN(18) phase_pool(F); PH_END(18)
    PH_BEGIN(19) PoolOrder S; S.init(F.ws + WS_H, F.ws + WS_WPOOL, F.G, F.bid); EpiResidual E{F.out, F.out, MOD + (size_t)(2 * 4) * 3072 + 2048, FIN(24), 1};
        pg8::gemm_phase<EpiResidual, PoolOrder, false>(F.lds, F.tid, 256, 2048u, 512u, S, E); PH_END(19)
    MOE_PHASES(20, 1)
    PH_BEGIN(23) phase_combine(F, 1, nullptr, 0, nullptr); PH_END(23)
    if (PROBE_PHASE >= 0 && F.bid == 0 && F.wave == 0) { const unsigned long long te = __builtin_amdgcn_s_memrealtime() + (unsigned long long)PROBE_AMP * (PROBE_PHASE >= 100 ? probe_sec : probe_dt); while (__builtin_amdgcn_s_memrealtime() < te) __builtin_amdgcn_s_sleep(16); }
}

extern "C" void kernel_launch(void* const* d_in, const int* in_sizes, int n_in, void* d_out, int out_size, void* d_ws, size_t ws_size, hipStream_t stream) {
    static int grid = 0;
    if (grid == 0) {
        int dev = 0, cus = 0;
        if (n_in != 33 || ws_size < WS_END) { fprintf(stderr, "kernel_launch: unexpected n_in %d or ws_size %zu (need %zu)\n", n_in, ws_size, (size_t)WS_END); grid = -1; return; }
        if (hipGetDevice(&dev) != hipSuccess || hipDeviceGetAttribute(&cus, hipDeviceAttributeMultiprocessorCount, dev) != hipSuccess) { grid = -1; return; }
        if (hipFuncSetAttribute((const void*)mega, hipFuncAttributeMaxDynamicSharedMemorySize, LDS_BYTES) != hipSuccess) { fprintf(stderr, "kernel_launch: hipFuncSetAttribute failed\n"); grid = -1; return; }
        (void)hipGetLastError();
        grid = cus - (cus % 8); if (grid <= 0) grid = cus;
    }
    if (grid < 0) return;
    (void)hipMemsetAsync((char*)d_ws + WS_CTL, 0, CTL_ZERO_BYTES, stream);
    Args a{};
    for (int i = 0; i < 33; ++i) a.in[i] = (const float*)d_in[i];
    a.out = (float*)d_out; a.ws = (unsigned char*)d_ws;
    const int last = 24;
#if MK_LAUNCH_PER_PHASE
    for (int p = 0; p < last; ++p) { a.ph_lo = p; a.ph_hi = p + 1; hipLaunchKernelGGL(mega, dim3(grid), dim3(512), LDS_BYTES, stream, a); }
#else
    a.ph_lo = 0; a.ph_hi = last; hipLaunchKernelGGL(mega, dim3(grid), dim3(512), LDS_BYTES, stream, a);
#endif
}
```

```cpp
#include <hip/hip_runtime.h>
#include <cstdio>
#include <cstdint>

#ifndef PROBE_PHASE
#define PROBE_PHASE -1
#endif
#ifndef PROBE_AMP
#define PROBE_AMP 8
#endif
#ifndef MK_LAUNCH_PER_PHASE
#define MK_LAUNCH_PER_PHASE 0
#endif

#define GAS __attribute__((address_space(1)))
#define LAS __attribute__((address_space(3)))
typedef unsigned short bf16;
typedef unsigned v4u __attribute__((ext_vector_type(4)));
typedef unsigned v2u __attribute__((ext_vector_type(2)));
typedef float f32x4 __attribute__((ext_vector_type(4)));
typedef short bf16x8 __attribute__((ext_vector_type(8)));
#define LDS_WAIT() asm volatile("s_waitcnt lgkmcnt(0)" ::: "memory")
#define VM_WAIT() asm volatile("s_waitcnt vmcnt(0)" ::: "memory")

constexpr int NB = 4, SEQ = 4096, T = NB * SEQ, D = 1024;
constexpr int INW = 1736, INP = 1792;
constexpr int NEXP = 64, EDIM = 256;
constexpr int NASSIGN = T * 8;
constexpr int ECAP = T;

constexpr size_t MiB = 1u << 20;
constexpr size_t WS_CTL = 0;
constexpr size_t CTL_ZERO_BYTES = 1 * MiB;
constexpr size_t WS_MOD = 1 * MiB;
constexpr size_t WS_ROPE = WS_MOD + 256 * 1024;
constexpr size_t WS_S5T = WS_ROPE + 1 * MiB;
constexpr size_t WS_WIN = 4 * MiB;
constexpr size_t WS_WOUT = WS_WIN + (size_t)INP * D * 2;
constexpr size_t WS_WPOOL = WS_WOUT + (size_t)D * D * 2;
constexpr size_t WS_WGU = 10 * MiB;
constexpr size_t WS_WD = WS_WGU + (size_t)65 * 512 * 1024 * 2;
constexpr size_t WS_H = WS_WD + (size_t)65 * 1024 * 256 * 2;
constexpr size_t WS_EIDX = WS_H + (size_t)T * D * 2;
constexpr size_t WS_SLOT = WS_EIDX + (size_t)T * 8 * 4;
constexpr size_t WS_ELT = WS_SLOT + (size_t)T * 8 * 4;
constexpr size_t WS_ELW = WS_ELT + (size_t)NEXP * ECAP * 4;
constexpr size_t WS_BIG = WS_ELW + (size_t)NEXP * ECAP * 4;
constexpr size_t BG_PROJ = WS_BIG;
constexpr size_t BG_U = BG_PROJ + (size_t)T * INP * 4;
constexpr size_t BG_Q = BG_U + (size_t)T * 512 * 4;
constexpr size_t BG_QI = BG_Q + (size_t)T * 512 * 2;
constexpr size_t BG_K = BG_QI + (size_t)T * 512 * 2;
constexpr size_t BG_V = BG_K + (size_t)T * 64 * 2;
constexpr size_t BG_KI = BG_V + (size_t)T * 64 * 2;
constexpr size_t BG_WI = BG_KI + (size_t)T * 64 * 2;
constexpr size_t BG_SLOC = BG_WI + (size_t)T * 8 * 4;
constexpr size_t BG_SIN = BG_SLOC + (size_t)4 * 32 * 64 * 64 * 2 * 4;
constexpr size_t BG_MIX = BG_SIN + (size_t)4 * 32 * 64 * 64 * 2 * 4;
constexpr size_t BG_VT = BG_MIX + (size_t)T * D * 2;
constexpr size_t BG_POW = BG_VT + (size_t)T * 64 * 2;
constexpr size_t BG_S5MB = BG_POW + (size_t)32 * 64 * 33 * 16;
constexpr size_t BG_S5WE = BG_S5MB + (size_t)32 * 512 * 640 * 2;
constexpr size_t BG_AUG = BG_S5WE + (size_t)32 * 256 * 512 * 2;
constexpr size_t BG_SL2 = BG_AUG + (size_t)32 * 512 * 640 * 2;
constexpr size_t BG_MIXER_END = BG_SL2 + (size_t)32 * 512 * 128 * 4;
constexpr size_t BG_HB = WS_BIG;
constexpr size_t BG_HBSH = BG_HB + (size_t)(NASSIGN + 256) * 256 * 2;
constexpr size_t BG_Y = BG_HBSH + (size_t)T * 256 * 2;
constexpr size_t BG_YSH = BG_Y + (size_t)NASSIGN * D;
constexpr size_t BG_MOE_END = BG_YSH + (size_t)T * D;
constexpr size_t BG_H2F = WS_BIG;
constexpr size_t WS_END = (BG_MOE_END > BG_MIXER_END ? BG_MOE_END : BG_MIXER_END);
static_assert(BG_H2F + (size_t)T * D * 2 <= BG_HBSH, "H2F must stay inside the dead HB region");
static_assert(WS_END <= 539993216ull, "workspace map exceeds the guaranteed d_ws size");

constexpr int S5_ABAR = 0;
constexpr int S5_A64 = S5_ABAR + 32 * 64 * 2;
constexpr int S5_BBR = S5_A64 + 32 * 64 * 2;
constexpr int S5_BBI = S5_BBR + 32 * 64 * 16;

constexpr int CW_BAR = 4096;
constexpr int CW_CNT = 16384;
constexpr int CW_EST = 16384 + 256;
constexpr int CW_NT = 16384 + 512;
constexpr int CW_TE = 16384 + 1024;
constexpr int CW_TJ = 16384 + 4096;
constexpr int LDS_BYTES = 163840;

__device__ __forceinline__ unsigned f2bf(float f) { unsigned u = __builtin_bit_cast(unsigned, f); return (u + 0x7fffu + ((u >> 16) & 1u)) >> 16; }
typedef float f32x2_t __attribute__((ext_vector_type(2))); typedef __bf16 bf16x2_t __attribute__((ext_vector_type(2)));
__device__ __forceinline__ unsigned pk2(float lo, float hi) { const f32x2_t v = {lo, hi}; const bf16x2_t b = __builtin_convertvector(v, bf16x2_t); return __builtin_bit_cast(unsigned, b); }
__device__ __forceinline__ float bf2f(unsigned b) { return __builtin_bit_cast(float, b << 16); }
__device__ __forceinline__ float bflo(unsigned w) { return __builtin_bit_cast(float, w << 16); }
__device__ __forceinline__ float bfhi(unsigned w) { return __builtin_bit_cast(float, w & 0xffff0000u); }
__device__ __forceinline__ int wave_sum_i(int v) {
#pragma unroll
    for (int o = 1; o < 64; o <<= 1) v += __shfl_xor(v, o);
    return v;
}
#define DPP_F(v, ctrl) __builtin_bit_cast(float, __builtin_amdgcn_update_dpp(0, __builtin_bit_cast(int, (v)), (ctrl), 0xF, 0xF, false))
#define RDL_F(v, l) __builtin_bit_cast(float, __builtin_amdgcn_readlane(__builtin_bit_cast(int, (v)), (l)))
__device__ __forceinline__ float wave_sum(float v) {
    v += DPP_F(v, 0xB1); v += DPP_F(v, 0x4E); v += DPP_F(v, 0x141); v += DPP_F(v, 0x140);
    return (RDL_F(v, 0) + RDL_F(v, 16)) + (RDL_F(v, 32) + RDL_F(v, 48));
}
__device__ __forceinline__ float wave_max(float v) {
    v = fmaxf(v, DPP_F(v, 0xB1)); v = fmaxf(v, DPP_F(v, 0x4E)); v = fmaxf(v, DPP_F(v, 0x141)); v = fmaxf(v, DPP_F(v, 0x140));
    return fmaxf(fmaxf(RDL_F(v, 0), RDL_F(v, 16)), fmaxf(RDL_F(v, 32), RDL_F(v, 48)));
}
__device__ __forceinline__ float sigmoidf_(float x) { return 1.0f / (1.0f + __expf(-x)); }

namespace pg8 {
typedef float f32x4 __attribute__((ext_vector_type(4)));
constexpr int BM = 256, BK = 64, HALF = 128, HTB = HALF * BK * 2, STAGE_BYTES = 8 * HTB;
__host__ __device__ __forceinline__ int lds_byte(int r, int c) { const int st = (r >> 4) * 2 + (c >> 5), rr = r & 15, cc = c & 31, ob = rr * 64 + cc * 2; return st * 1024 + (ob ^ (((ob >> 9) & 1) << 5)); }
__host__ __device__ __forceinline__ int perm32(int rho) { const int n = rho >> 4, i = rho & 15; return 8 * (i >> 2) + 4 * n + (i & 3); }
__host__ __device__ __forceinline__ void stage_rc(int b, int& R, int& C) { const int st = b / 1024, sb = b % 1024, swz = sb ^ (((sb >> 9) & 1) << 5); R = (st >> 1) * 16 + swz / 64; C = (st & 1) * 32 + (swz % 64) / 2; }
struct Unit { int pm, pn, e, rows; };
template <class Epi, class Sched, bool GATHER>
__device__ __forceinline__ void gemm_phase(LAS unsigned char* lds, const int tid, const int K, const unsigned lda_b, const unsigned ldb_b, const Sched& S, const Epi& E) {
    const int wid = __builtin_amdgcn_readfirstlane(tid >> 6), lane = tid & 63, wr = wid >> 2, wc = wid & 3, fr = lane & 15, fq = lane >> 4;
    const int nt = K / BK;
    unsigned voffA[2], voffB[2]; int RA[2], CA[2];
#pragma unroll
    for (int i = 0; i < 2; ++i) { int R, C; stage_rc(tid * 16 + i * 8192, R, C); RA[i] = R; CA[i] = C; const int Rb = Epi::PERM ? ((R & ~31) + perm32(R & 31)) : R; voffA[i] = (unsigned)R * lda_b + (unsigned)C * 2u; voffB[i] = (unsigned)Rb * ldb_b + (unsigned)C * 2u; }
    const size_t kstep = (size_t)(BK * 2);
    const size_t hstepA = (size_t)HALF * lda_b, hstepB = (size_t)HALF * ldb_b;
    const unsigned ldsw = (unsigned)wid * 1024u;
    const int aoff = lds_byte(wr * 64 + fr, fq * 8), boff = lds_byte(wc * 32 + fr, fq * 8);
#define PG8_SA(b, h) (((b) * 2 + (h)) * HTB)
#define PG8_SB(b, h) ((4 + (b) * 2 + (h)) * HTB)
#define PG8_STAGE(bufoff, gbase, voff) do { _Pragma("unroll") for (int _i = 0; _i < 2; ++_i) \
        __builtin_amdgcn_global_load_lds((const unsigned*)((const char*)(gbase) + (voff)[_i]), (LAS unsigned*)(lds + (bufoff) + ldsw + _i * 8192), 16, 0, 0); } while (0)
#define PG8_STAGE_A(bufoff, gbase, h, OS) do { if constexpr (GATHER) { PG8_STAGE(bufoff, gbase, g##OS##h); } else { PG8_STAGE(bufoff, (gbase) + (h) * hstepA, voffA); } } while (0)
#define PG8_LDA(dst, b, h) do { _Pragma("unroll") for (int m = 0; m < 4; ++m) _Pragma("unroll") for (int k = 0; k < 2; ++k) dst[m][k] = *(const LAS bf16x8*)(lds + PG8_SA(b, h) + aoff + m * 2048 + k * 1024); } while (0)
#define PG8_LDB(dst, b, h) do { _Pragma("unroll") for (int n = 0; n < 2; ++n) _Pragma("unroll") for (int k = 0; k < 2; ++k) dst[n][k] = *(const LAS bf16x8*)(lds + PG8_SB(b, h) + boff + n * 2048 + k * 1024); } while (0)
#define PG8_MMA(ai, bj, At, Bt) do { __builtin_amdgcn_s_setprio(1); _Pragma("unroll") for (int m = 0; m < 4; ++m) _Pragma("unroll") for (int n = 0; n < 2; ++n) _Pragma("unroll") for (int k = 0; k < 2; ++k) \
        acc[ai][bj][m][n] = __builtin_amdgcn_mfma_f32_16x16x32_bf16(Bt[n][k], At[m][k], acc[ai][bj][m][n], 0, 0, 0); __builtin_amdgcn_s_setprio(0); } while (0)
#define PG8_WAIT_V(n) asm volatile("s_waitcnt vmcnt(" #n ")" ::: "memory")
#define PG8_WAIT_L(n) asm volatile("s_waitcnt lgkmcnt(" #n ")" ::: "memory")
#define PG8_BAR __builtin_amdgcn_s_barrier()
#define PG8_SCHED __builtin_amdgcn_sched_barrier(0)
    Unit cur, nxt; int ui = 0;
    if (!S.next(0, cur)) return;
    f32x4 acc[2][2][4][2];
#pragma unroll
    for (int a = 0; a < 2; ++a)
#pragma unroll
        for (int b = 0; b < 2; ++b)
#pragma unroll
            for (int m = 0; m < 4; ++m)
#pragma unroll
                for (int n = 0; n < 2; ++n) acc[a][b][m][n] = (f32x4){0.f, 0.f, 0.f, 0.f};
    bf16x8 At[4][2], B0[2][2], B1[2][2];
    unsigned gc0[2] = {0u, 0u}, gc1[2] = {0u, 0u}, gn0[2] = {0u, 0u}, gn1[2] = {0u, 0u};
    const char* cA = S.a_base(cur); const char* cB = S.b_base(cur);
    if constexpr (GATHER) {
#pragma unroll
        for (int i = 0; i < 2; ++i) { gc0[i] = S.a_off(cur, RA[i]) + (unsigned)CA[i] * 2u; gc1[i] = S.a_off(cur, HALF + RA[i]) + (unsigned)CA[i] * 2u; }
    }
    PG8_STAGE(PG8_SB(0, 0), cB, voffB); PG8_STAGE(PG8_SB(0, 1), cB + hstepB, voffB); PG8_STAGE_A(PG8_SA(0, 0), cA, 0, c); PG8_STAGE_A(PG8_SA(0, 1), cA, 1, c);
    if (wr == 1) PG8_BAR;
    PG8_WAIT_V(2); PG8_BAR;
    PG8_STAGE(PG8_SB(1, 0), cB + kstep, voffB); PG8_STAGE_A(PG8_SA(1, 0), cA + kstep, 0, c); PG8_STAGE(PG8_SB(1, 1), cB + hstepB + kstep, voffB);
    PG8_WAIT_V(6); PG8_BAR;
#pragma unroll 1
    for (;;) {
        const bool has_next = S.next(ui + 1, nxt);
        const char* nA = has_next ? S.a_base(nxt) : cA; const char* nB = has_next ? S.b_base(nxt) : cB;
        if constexpr (GATHER) {
            if (has_next) {
#pragma unroll
                for (int i = 0; i < 2; ++i) { gn0[i] = S.a_off(nxt, RA[i]) + (unsigned)CA[i] * 2u; gn1[i] = S.a_off(nxt, HALF + RA[i]) + (unsigned)CA[i] * 2u; }
            } else {
#pragma unroll
                for (int i = 0; i < 2; ++i) { gn0[i] = gc0[i]; gn1[i] = gc1[i]; }
            }
        }
#pragma unroll 1
        for (int t = 0; t < nt; t += 2) {
            const bool last = (t == nt - 2);
            const char* a1 = cA + (size_t)(t + 1) * kstep;
            const char* a2 = last ? nA : cA + (size_t)(t + 2) * kstep; const char* b2 = last ? nB : cB + (size_t)(t + 2) * kstep;
            const char* a3 = a2 + kstep; const char* b3 = b2 + kstep;
            unsigned gx0[2], gx1[2];
#pragma unroll
            for (int i = 0; i < 2; ++i) { gx0[i] = last ? gn0[i] : gc0[i]; gx1[i] = last ? gn1[i] : gc1[i]; }
            (void)gx0; (void)gx1;
            PG8_LDB(B0, 0, 0); PG8_LDB(B1, 0, 1); PG8_SCHED; PG8_LDA(At, 0, 0); PG8_STAGE_A(PG8_SA(1, 1), a1, 1, c);
            PG8_WAIT_V(8); PG8_WAIT_L(0); PG8_BAR; PG8_MMA(0, 0, At, B0); PG8_MMA(0, 1, At, B1); PG8_BAR; PG8_SCHED;
            PG8_LDA(At, 0, 1); PG8_STAGE(PG8_SB(0, 0), b2, voffB); PG8_STAGE(PG8_SB(0, 1), b2 + hstepB, voffB); PG8_STAGE_A(PG8_SA(0, 0), a2, 0, x);
            PG8_WAIT_V(8); PG8_WAIT_L(0); PG8_BAR; PG8_MMA(1, 0, At, B0); PG8_MMA(1, 1, At, B1); PG8_BAR; PG8_SCHED;
            PG8_LDB(B0, 1, 0); PG8_LDB(B1, 1, 1); PG8_SCHED; PG8_LDA(At, 1, 0); PG8_STAGE_A(PG8_SA(0, 1), a2, 1, x);
            PG8_WAIT_V(8); PG8_WAIT_L(0); PG8_BAR; PG8_MMA(0, 0, At, B0); PG8_MMA(0, 1, At, B1); PG8_BAR; PG8_SCHED;
            PG8_LDA(At, 1, 1); PG8_STAGE(PG8_SB(1, 0), b3, voffB); PG8_STAGE(PG8_SB(1, 1), b3 + hstepB, voffB); PG8_STAGE_A(PG8_SA(1, 0), a3, 0, x);
            PG8_WAIT_V(8); PG8_WAIT_L(0); PG8_BAR; PG8_MMA(1, 0, At, B0); PG8_MMA(1, 1, At, B1); PG8_BAR; PG8_SCHED;
        }
        if (wr == 0) PG8_BAR;
        E(acc, cur, wr, wc, fr, fq);
        if (!has_next) break;
#pragma unroll
        for (int a = 0; a < 2; ++a)
#pragma unroll
            for (int b = 0; b < 2; ++b)
#pragma unroll
                for (int m = 0; m < 4; ++m)
#pragma unroll
                    for (int n = 0; n < 2; ++n) acc[a][b][m][n] = (f32x4){0.f, 0.f, 0.f, 0.f};
        cur = nxt; cA = nA; cB = nB; ++ui;
        if constexpr (GATHER) {
#pragma unroll
            for (int i = 0; i < 2; ++i) { gc0[i] = gn0[i]; gc1[i] = gn1[i]; }
        }
        if (wr == 1) PG8_BAR;
    }
    PG8_WAIT_V(0);
    PG8_BAR;
#undef PG8_SA
#undef PG8_SB
#undef PG8_STAGE
#undef PG8_STAGE_A
#undef PG8_LDA
#undef PG8_LDB
#undef PG8_MMA
#undef PG8_WAIT_V
#undef PG8_WAIT_L
#undef PG8_BAR
#undef PG8_SCHED
}
}

#define XB_TMO      128
#define XB_XCNT(j)  (256  + 64 * (j))
#define XB_XSUB(j)  (1280 + 64 * (j))
#define XB_XGEN(j)  (2304 + 64 * (j))
#define XB_TOP      3328
#define XB_TOPGEN   3392
#define XCD_BAR_WORDS 3456
#define XB_SPIN_CAP (1u << 22)
__device__ __forceinline__ unsigned xb_ld(unsigned* p)              { return __hip_atomic_load(p, __ATOMIC_RELAXED, __HIP_MEMORY_SCOPE_AGENT); }
__device__ __forceinline__ unsigned xb_add(unsigned* p, unsigned v) { return __hip_atomic_fetch_add(p, v, __ATOMIC_RELAXED, __HIP_MEMORY_SCOPE_AGENT); }
__device__ __forceinline__ unsigned xb_xcc_id() { return (unsigned)__builtin_amdgcn_s_getreg((3 << 11) | 20) & 0xFu; }
#define XB_SPIN(cond, bar) do { unsigned _sp = 0; while (cond) { __builtin_amdgcn_s_sleep(1); \
    if ((++_sp & 255u) == 0u) { if (xb_ld(&(bar)[XB_TMO])) break; if (_sp > XB_SPIN_CAP) { atomicAdd(&(bar)[XB_TMO], 1u); break; } } } } while (0)
struct XcdBarrier { unsigned* bar; unsigned x; volatile LAS unsigned* st; };
__device__ __forceinline__ XcdBarrier xcd_barrier_post(unsigned* bar, volatile LAS unsigned* st) {
    XcdBarrier b; b.bar = bar; b.x = xb_xcc_id(); b.st = st;
    if (threadIdx.x == 0) (void)xb_add(&bar[XB_XCNT(b.x)], 1u);
    return b;
}
__device__ __forceinline__ void xcd_barrier_complete(unsigned* bar, unsigned x, unsigned& nloc, unsigned& nx) {
    const unsigned G = gridDim.x * gridDim.y * gridDim.z;
    unsigned sum, cnt, mine, sp = 0u;
    for (;;) {
        sum = 0u; cnt = 0u; mine = 0u;
#pragma unroll
        for (unsigned j = 0; j < 16; ++j) { const unsigned c = xb_ld(&bar[XB_XCNT(j)]); sum += c; cnt += (c > 0u) ? 1u : 0u; mine = (j == x) ? c : mine; }
        if (sum == G) break;
        __builtin_amdgcn_s_sleep(1);
        if ((++sp & 255u) == 0u) { if (xb_ld(&bar[XB_TMO])) break; if (sp > XB_SPIN_CAP) { atomicAdd(&bar[XB_TMO], 1u); break; } }
    }
    nloc = mine > 0u ? mine : 1u; nx = cnt > 0u ? cnt : 1u;
}
__device__ __forceinline__ void xcd_barrier(const XcdBarrier& b) {
    asm volatile("s_waitcnt vmcnt(0)" ::: "memory");
    __syncthreads();
    if (threadIdx.x == 0) {
        unsigned* bar = b.bar;
        __builtin_amdgcn_s_waitcnt(0);
        unsigned nloc = b.st[0], nx = b.st[1];
        if (nloc == 0u) { xcd_barrier_complete(bar, b.x, nloc, nx); b.st[0] = nloc; b.st[1] = nx; }
        const unsigned old = xb_add(&bar[XB_XSUB(b.x)], 1u);
        const unsigned gen = old / nloc;
        if (old + 1u == (gen + 1u) * nloc) {
            __builtin_amdgcn_fence(__ATOMIC_RELEASE, "agent");
            asm volatile("s_waitcnt vmcnt(0)" ::: "memory");
            const unsigned og = xb_add(&bar[XB_TOP], 1u);
            const unsigned tg = og / nx;
            if (og + 1u == (tg + 1u) * nx) xb_add(&bar[XB_TOPGEN], 1u);
            else XB_SPIN(xb_ld(&bar[XB_TOPGEN]) == tg, bar);
            __builtin_amdgcn_fence(__ATOMIC_ACQUIRE, "agent");
            xb_add(&bar[XB_XGEN(b.x)], 1u);
            asm volatile("s_waitcnt vmcnt(0)" ::: "memory");
        } else {
            XB_SPIN(xb_ld(&bar[XB_XGEN(b.x)]) == gen, bar);
            __builtin_amdgcn_fence(__ATOMIC_ACQUIRE, "agent");
            asm volatile("s_waitcnt vmcnt(0)" ::: "memory");
        }
    }
    __syncthreads();
}

struct Frame {
    LAS unsigned char* lds;
    int tid, lane, wave, bid, G, gw, NGW;
    float* out; unsigned char* ws;
};
struct Args { const float* in[33]; float* out; unsigned char* ws; int ph_lo, ph_hi; };
#define FIN(i) (AR->in[i])
#define CAS __attribute__((address_space(4)))
typedef const CAS Args* ArgsP;
__device__ __forceinline__ ArgsP launder_args(ArgsP p) { asm volatile("" : "+s"(p)); return p; }

__device__ __forceinline__ void phase_mod(Frame& F, ArgsP AR) {
    LAS float* cs = (LAS float*)F.lds;
    LAS float* red = cs + 4096;
    const float* c = FIN(1);
    for (int i = F.tid; i < 4096; i += 512) { const float v = c[i]; cs[i] = v / (1.0f + __expf(-v)); }
    __syncthreads();
    float* MOD = (float*)(F.ws + WS_MOD);
    for (int it = F.bid; it < 192; it += F.G) {
        const int m = it / 48, n0 = (it % 48) * 64, l = m >> 1;
        const float* W = ((m & 1) ? FIN(7) : FIN(4)) + (size_t)l * 1024 * 3072;
        const float* bias = ((m & 1) ? FIN(8) : FIN(5)) + (size_t)l * 3072;
        float a0 = 0.f, a1 = 0.f, a2 = 0.f, a3 = 0.f;
        const int k0 = F.wave * 128;
#pragma unroll 32
        for (int k = k0; k < k0 + 128; ++k) {
            const float w = W[(size_t)k * 3072 + n0 + F.lane];
            a0 += cs[k] * w; a1 += cs[1024 + k] * w; a2 += cs[2048 + k] * w; a3 += cs[3072 + k] * w;
        }
        red[(F.wave * 4 + 0) * 64 + F.lane] = a0; red[(F.wave * 4 + 1) * 64 + F.lane] = a1; red[(F.wave * 4 + 2) * 64 + F.lane] = a2; red[(F.wave * 4 + 3) * 64 + F.lane] = a3;
        __syncthreads();
        if (F.tid < 256) { const int b = F.tid >> 6, n = F.tid & 63; float s = 0.f;
#pragma unroll
            for (int w = 0; w < 8; ++w) s += red[(w * 4 + b) * 64 + n];
            MOD[(size_t)(m * 4 + b) * 3072 + n0 + n] = s + bias[n0 + n]; }
        __syncthreads();
    }
}

__device__ __forceinline__ void transpose_item(const float* W, int ldw, int nvalid, int K, bf16* WT, int mode, LAS float* scr, int kb, int nb, int lane) {
    const int k0 = 64 * kb, n0 = 32 * nb;
    const int nn = n0 + (lane & 31);
#pragma unroll
    for (int i = 0; i < 32; ++i) { const int kk = 2 * i + (lane >> 5); scr[kk * 33 + (lane & 31)] = (nn < nvalid) ? W[(size_t)(k0 + kk) * ldw + nn] : 0.f; }
    LDS_WAIT();
    const int c = lane & 7;
#pragma unroll
    for (int j = 0; j < 4; ++j) { const int nl = (lane >> 3) + 8 * j; const LAS float* s = scr + (8 * c) * 33 + nl;
        v4u o; o.x = pk2(s[0 * 33], s[1 * 33]); o.y = pk2(s[2 * 33], s[3 * 33]); o.z = pk2(s[4 * 33], s[5 * 33]); o.w = pk2(s[6 * 33], s[7 * 33]);
        const int n = n0 + nl; const int row = (mode == 0) ? n : (256 * (n >> 7) + (n & 127) + (mode == 2 ? 128 : 0));
        *(v4u*)(WT + (size_t)row * K + k0 + 8 * c) = o; }
    LDS_WAIT();
}
__device__ __forceinline__ void phase_convert_static(Frame& F, ArgsP AR) {
    LAS float* scr = (LAS float*)(F.lds + F.wave * 16384);
    constexpr int I_IN = 16 * 56, I_OUT = 16 * 32, I_POOL = 4 * 4 * 8;
    for (int it = F.gw; it < I_IN + I_OUT + I_POOL; it += F.NGW) {
        int r = it;
        if (r < I_IN) { transpose_item(FIN(9), INW, INW, 1024, (bf16*)(F.ws + WS_WIN), 0, scr, r / 56, r % 56, F.lane); continue; } r -= I_IN;
        if (r < I_OUT) { transpose_item(FIN(10), 1024, 1024, 1024, (bf16*)(F.ws + WS_WOUT), 0, scr, r / 32, r % 32, F.lane); continue; } r -= I_OUT;
        const int g = r / 32, rr = r % 32;
        transpose_item(FIN(23) + (size_t)g * 65536, 256, 256, 256, (bf16*)(F.ws + WS_WPOOL) + (size_t)g * 65536, 0, scr, rr / 8, rr % 8, F.lane);
    }
}
__device__ __forceinline__ void phase_convert_experts(Frame& F, ArgsP AR, int l) {
    LAS float* scr = (LAS float*)(F.lds + F.wave * 16384);
    for (int it = F.gw; it < 65 * 384; it += F.NGW) {
        const int e = it / 384, r = it % 384, type = r >> 7, sub = r & 127;
        if (type < 2) {
            const float* W = (e < 64) ? (FIN(type == 0 ? 27 : 28) + (size_t)(l * 64 + e) * 1024 * 256) : (FIN(type == 0 ? 30 : 31) + (size_t)l * 1024 * 256);
            transpose_item(W, 256, 256, 1024, (bf16*)(F.ws + WS_WGU) + (size_t)e * 512 * 1024, 1 + type, scr, sub >> 3, sub & 7, F.lane);
        } else {
            const float* W = (e < 64) ? (FIN(29) + (size_t)(l * 64 + e) * 256 * 1024) : (FIN(32) + (size_t)l * 256 * 1024);
            transpose_item(W, 1024, 1024, 256, (bf16*)(F.ws + WS_WD) + (size_t)e * 1024 * 256, 0, scr, sub >> 5, sub & 31, F.lane);
        }
    }
}

__device__ __forceinline__ void phase_tables(Frame& F, ArgsP AR) {
    const int gid = F.bid * 512 + F.tid, NT_ = F.G * 512;
    float* ROPE = (float*)(F.ws + WS_ROPE);
    const int* pos = (const int*)FIN(2);
    for (int i = gid; i < T * 8; i += NT_) {
        const int t = i >> 3, j = i & 7;
        const float inv = (j == 0) ? 1.0f : (j == 1) ? 0.1939227432f : (j == 2) ? 0.03760603070f : (j == 3) ? 0.007292664610f : (j == 4) ? 0.001414213562f : (j == 5) ? 0.0002742481884f : (j == 6) ? 5.318295734e-05f : 1.031338525e-05f;
        const float ang = (float)pos[t] * inv;
        float sn, cs; sincosf(ang, &sn, &cs);
        ROPE[2 * i] = cs; ROPE[2 * i + 1] = sn;
    }
}

__device__ __forceinline__ void phase_norm_mod(Frame& F, const float* X, const float* gamma, int m, bf16* Hout, float* Hf) {
    const float* MOD = (const float*)(F.ws + WS_MOD);
    for (int row = F.gw; row < T; row += F.NGW) {
        const int b = row >> 12;
        const float* shift = MOD + (size_t)(m * 4 + b) * 3072; const float* scale = shift + 1024;
        const f32x4* xr = (const f32x4*)(X + (size_t)row * D) + F.lane;
        f32x4 v[4]; float ss = 0.f;
#pragma unroll
        for (int j = 0; j < 4; ++j) { v[j] = xr[64 * j]; ss += v[j].x * v[j].x + v[j].y * v[j].y + v[j].z * v[j].z + v[j].w * v[j].w; }
        const float rstd = rsqrtf(wave_sum(ss) * (1.0f / D) + 1e-6f);
#pragma unroll
        for (int j = 0; j < 4; ++j) {
            const int c0 = 4 * F.lane + 256 * j;
            const f32x4 gg = *(const f32x4*)(gamma + c0), sc = *(const f32x4*)(scale + c0), sh = *(const f32x4*)(shift + c0);
            f32x4 h; h.x = v[j].x * rstd * gg.x * (1.f + sc.x) + sh.x; h.y = v[j].y * rstd * gg.y * (1.f + sc.y) + sh.y;
            h.z = v[j].z * rstd * gg.z * (1.f + sc.z) + sh.z; h.w = v[j].w * rstd * gg.w * (1.f + sc.w) + sh.w;
            if (Hout) { v2u o; o.x = pk2(h.x, h.y); o.y = pk2(h.z, h.w); *(v2u*)(Hout + (size_t)row * D + c0) = o; }
            if (Hf) *(f32x4*)(Hf + (size_t)row * D + c0) = h;
        }
    }
}

struct DenseOrder {
    const char* A; const char* Bt; unsigned lda_b, ldb_b; int nM, nN, nU, chunk, x, q0, qs;
    __device__ __forceinline__ void init(const void* A_, const void* Bt_, unsigned lda, unsigned ldb, int M, int N, int G, int c) {
        A = (const char*)A_; Bt = (const char*)Bt_; lda_b = lda; ldb_b = ldb; nM = M / 256; nN = N / 256; nU = nM * nN; chunk = (nU + 7) / 8; x = c & 7; q0 = c >> 3; qs = G >> 3; }
    __device__ __forceinline__ bool next(int i, pg8::Unit& u) const {
        const int q = i * qs + q0; if (q >= chunk) return false; const int L = x * chunk + q; if (L >= nU) return false;
        u.pm = L / nN; u.pn = L % nN; u.e = 0; u.rows = 256; return true; }
    __device__ __forceinline__ const char* a_base(const pg8::Unit& u) const { return A + (size_t)u.pm * 256 * lda_b; }
    __device__ __forceinline__ const char* b_base(const pg8::Unit& u) const { return Bt + (size_t)u.pn * 256 * ldb_b; }
    __device__ __forceinline__ unsigned a_off(const pg8::Unit&, int) const { return 0u; }
};
struct PoolOrder {
    const char* A; const char* Bt; int nU, chunk, x, q0, qs;
    __device__ __forceinline__ void init(const void* A_, const void* Bt_, int G, int c) { A = (const char*)A_; Bt = (const char*)Bt_; nU = 64 * 4; chunk = (nU + 7) / 8; x = c & 7; q0 = c >> 3; qs = G >> 3; }
    __device__ __forceinline__ bool next(int i, pg8::Unit& u) const {
        const int q = i * qs + q0; if (q >= chunk) return false; const int L = x * chunk + q; if (L >= nU) return false;
        u.pm = L >> 2; u.pn = L & 3; u.e = L & 3; u.rows = 256; return true; }
    __device__ __forceinline__ const char* a_base(const pg8::Unit& u) const { return A + (size_t)u.pm * 256 * 2048 + (size_t)u.e * 512; }
    __device__ __forceinline__ const char* b_base(const pg8::Unit& u) const { return Bt + (size_t)u.e * 256 * 512; }
    __device__ __forceinline__ unsigned a_off(const pg8::Unit&, int) const { return 0u; }
};
constexpr int LDS_MOE = 131072;
__device__ __forceinline__ void moe_tables(Frame& F, int l) {
    LAS int* est = (LAS int*)(F.lds + LDS_MOE); LAS int* tst = est + 128;
    if (F.wave == 0) {
        const unsigned* ctl = (const unsigned*)(F.ws + WS_CTL);
        const int c = (int)__hip_atomic_load(&ctl[CW_CNT + (l * 64 + F.lane) * 64], __ATOMIC_RELAXED, __HIP_MEMORY_SCOPE_AGENT);
        const int nt = (c + 255) >> 8;
        int ic = c, it = nt;
#pragma unroll
        for (int o = 1; o < 64; o <<= 1) { const int a = __shfl_up(ic, o), b2 = __shfl_up(it, o); if (F.lane >= o) { ic += a; it += b2; } }
        est[F.lane] = ic - c; tst[F.lane] = it - nt;
        if (F.lane == 63) { est[64] = ic; tst[64] = it; }
    }
    __syncthreads();
}
template <int NPN, bool GATE_UP>
struct MoeOrder {
    const LAS int* est; const LAS int* tst; const unsigned char* ws; int ntr, ntiles, nU, chunk, x, q0, qs;
    __device__ __forceinline__ void init(LAS unsigned char* lds, const unsigned char* ws_, bool shared_only, bool with_sh, int G, int c) {
        est = (const LAS int*)(lds + LDS_MOE); tst = est + 128; ws = ws_;
        ntr = shared_only ? 0 : __builtin_amdgcn_readfirstlane(tst[64]); ntiles = ntr + (with_sh ? 64 : 0); nU = ntiles * NPN; chunk = (nU + 7) / 8; x = c & 7; q0 = c >> 3; qs = G >> 3; }
    __device__ __forceinline__ bool next(int i, pg8::Unit& u) const {
        const int q = i * qs + q0; if (q >= chunk) return false; const int L = x * chunk + q; if (L >= nU) return false;
        const int tile = L / NPN; u.pn = L % NPN;
        if (tile < ntr) { int e = 0;
#pragma unroll
            for (int s_ = 32; s_ >= 1; s_ >>= 1) { if (tst[e + s_] <= tile) e += s_; }
            e = __builtin_amdgcn_readfirstlane(e); u.e = e; u.pm = __builtin_amdgcn_readfirstlane(tile - tst[e]); const int rem = __builtin_amdgcn_readfirstlane(est[e + 1] - est[e]) - 256 * u.pm; u.rows = rem < 256 ? rem : 256; }
        else { u.e = 64; u.pm = tile - ntr; u.rows = 256; }
        return true; }
    __device__ __forceinline__ int row0(const pg8::Unit& u) const { return (u.e < 64) ? __builtin_amdgcn_readfirstlane(est[u.e]) + 256 * u.pm : 256 * u.pm; }
    __device__ __forceinline__ const char* a_base(const pg8::Unit& u) const {
        if (GATE_UP) return (const char*)(ws + WS_H);
        return (u.e < 64) ? (const char*)(ws + BG_HB) + (size_t)row0(u) * 512 : (const char*)(ws + BG_HBSH) + (size_t)row0(u) * 512; }
    __device__ __forceinline__ const char* b_base(const pg8::Unit& u) const {
        if (GATE_UP) return (const char*)(ws + WS_WGU) + (size_t)u.e * 512 * 2048 + (size_t)u.pn * 256 * 2048;
        return (const char*)(ws + WS_WD) + (size_t)u.e * 1024 * 512 + (size_t)u.pn * 256 * 512; }
    __device__ __forceinline__ unsigned a_off(const pg8::Unit& u, int r) const {
        int tok;
        if (u.e < 64) { const int* elt = (const int*)(ws + WS_ELT) + (size_t)u.e * ECAP + 256 * u.pm; tok = (r < u.rows) ? elt[r] : 0; }
        else tok = 256 * u.pm + r;
        return (unsigned)tok * 2048u; }
};

struct EpiBf16Store { static constexpr bool PERM = true; bf16* C; int ldc;
    __device__ __forceinline__ void operator()(const pg8::f32x4 (&acc)[2][2][4][2], const pg8::Unit& u, int wr, int wc, int fr, int fq) const {
#pragma unroll
        for (int ai = 0; ai < 2; ++ai)
#pragma unroll
            for (int m = 0; m < 4; ++m) { bf16* rowp = C + (size_t)(u.pm * 256 + ai * 128 + wr * 64 + m * 16 + fr) * ldc + u.pn * 256 + wc * 32 + 8 * fq;
#pragma unroll
                for (int bj = 0; bj < 2; ++bj) { const f32x4 a0 = acc[ai][bj][m][0], a1 = acc[ai][bj][m][1];
                    v4u o; o.x = pk2(a0.x, a0.y); o.y = pk2(a0.z, a0.w); o.z = pk2(a1.x, a1.y); o.w = pk2(a1.z, a1.w); *(v4u*)(rowp + bj * 128) = o; } }
    }
};
struct EpiF32Store { static constexpr bool PERM = false; float* C; int ldc;
    __device__ __forceinline__ void operator()(const pg8::f32x4 (&acc)[2][2][4][2], const pg8::Unit& u, int wr, int wc, int fr, int fq) const {
#pragma unroll
        for (int ai = 0; ai < 2; ++ai)
#pragma unroll
            for (int m = 0; m < 4; ++m) { float* rowp = C + (size_t)(u.pm * 256 + ai * 128 + wr * 64 + m * 16 + fr) * ldc + u.pn * 256 + wc * 32 + 4 * fq;
#pragma unroll
                for (int bj = 0; bj < 2; ++bj)
#pragma unroll
                    for (int n = 0; n < 2; ++n) *(f32x4*)(rowp + bj * 128 + n * 16) = acc[ai][bj][m][n]; }
    }
};
struct EpiResidual { static constexpr bool PERM = false; const float* Xin; float* X; const float* gate; const float* colscale; int col_from_e;
    __device__ __forceinline__ void operator()(const pg8::f32x4 (&acc)[2][2][4][2], const pg8::Unit& u, int wr, int wc, int fr, int fq) const {
        const int cbase = (col_from_e ? u.e * 256 : u.pn * 256) + wc * 32 + 4 * fq;
#pragma unroll
        for (int ai = 0; ai < 2; ++ai)
#pragma unroll
            for (int m = 0; m < 4; ++m) { const int row = u.pm * 256 + ai * 128 + wr * 64 + m * 16 + fr; const int b = row >> 12;
#pragma unroll
                for (int bj = 0; bj < 2; ++bj)
#pragma unroll
                    for (int n = 0; n < 2; ++n) { const int col = cbase + bj * 128 + n * 16; const size_t o = (size_t)row * D + col;
                        f32x4 g = *(const f32x4*)(gate + (size_t)b * 3072 + col); if (colscale) { const f32x4 cs = *(const f32x4*)(colscale + col); g = g * cs; }
                        const f32x4 xi = *(const f32x4*)(Xin + o); *(f32x4*)(X + o) = xi + g * acc[ai][bj][m][n]; } }
    }
};
template <class Order> struct EpiGateUp { static constexpr bool PERM = true; const Order* S; unsigned char* ws;
    __device__ __forceinline__ void operator()(const pg8::f32x4 (&acc)[2][2][4][2], const pg8::Unit& u, int wr, int wc, int fr, int fq) const {
        const int r0 = S->row0(u); bf16* HB = (bf16*)(ws + (u.e < 64 ? BG_HB : BG_HBSH));
        const float* elw = (const float*)(ws + WS_ELW) + (size_t)(u.e < 64 ? u.e : 0) * ECAP + 256 * u.pm;
#pragma unroll
        for (int ai = 0; ai < 2; ++ai)
#pragma unroll
            for (int m = 0; m < 4; ++m) { const int r = ai * 128 + wr * 64 + m * 16 + fr;
                if (r < u.rows) { const float w = (u.e < 64) ? elw[r] : 1.0f; bf16* rowp = HB + (size_t)(r0 + r) * 256 + u.pn * 128 + wc * 32 + 8 * fq;
                    v4u o;
#pragma unroll
                    for (int n = 0; n < 2; ++n) { const f32x4 g = acc[ai][0][m][n], up = acc[ai][1][m][n]; f32x4 h;
                        h.x = g.x * sigmoidf_(g.x) * up.x * w; h.y = g.y * sigmoidf_(g.y) * up.y * w; h.z = g.z * sigmoidf_(g.z) * up.z * w; h.w = g.w * sigmoidf_(g.w) * up.w * w;
                        if (n == 0) { o.x = pk2(h.x, h.y); o.y = pk2(h.z, h.w); } else { o.z = pk2(h.x, h.y); o.w = pk2(h.z, h.w); } }
                    *(v4u*)rowp = o; } }
    }
};
constexpr float Y8_SCALE = 32.0f, Y8_INV = 1.0f / 32.0f;
template <class Order> struct EpiDown { static constexpr bool PERM = true; const Order* S; unsigned char* ws;
    __device__ __forceinline__ void operator()(const pg8::f32x4 (&acc)[2][2][4][2], const pg8::Unit& u, int wr, int wc, int fr, int fq) const {
        const int r0 = S->row0(u); unsigned char* Y = ws + (u.e < 64 ? BG_Y : BG_YSH);
#pragma unroll
        for (int ai = 0; ai < 2; ++ai)
#pragma unroll
            for (int m = 0; m < 4; ++m) { const int r = ai * 128 + wr * 64 + m * 16 + fr;
                if (r < u.rows) {
#pragma unroll
                    for (int bj = 0; bj < 2; ++bj) { const int col = u.pn * 256 + bj * 128 + wc * 32 + 8 * fq; const f32x4 a0 = acc[ai][bj][m][0] * Y8_SCALE, a1 = acc[ai][bj][m][1] * Y8_SCALE;
                        int w0 = 0, w1 = 0;
                        w0 = __builtin_amdgcn_cvt_pk_fp8_f32(a0.x, a0.y, w0, false); w0 = __builtin_amdgcn_cvt_pk_fp8_f32(a0.z, a0.w, w0, true);
                        w1 = __builtin_amdgcn_cvt_pk_fp8_f32(a1.x, a1.y, w1, false); w1 = __builtin_amdgcn_cvt_pk_fp8_f32(a1.z, a1.w, w1, true);
                        *(v2u*)(Y + (size_t)(r0 + r) * D + col) = (v2u){(unsigned)w0, (unsigned)w1}; } }
                asm volatile("" ::: "memory"); }
    }
};

__device__ __forceinline__ void unpack8(const v4u w, float (&x)[8]) { x[0] = bflo(w.x); x[1] = bfhi(w.x); x[2] = bflo(w.y); x[3] = bfhi(w.y); x[4] = bflo(w.z); x[5] = bfhi(w.z); x[6] = bflo(w.w); x[7] = bfhi(w.w); }
__device__ __forceinline__ v4u pack8(const float (&x)[8]) { v4u o; o.x = pk2(x[0], x[1]); o.y = pk2(x[2], x[3]); o.z = pk2(x[4], x[5]); o.w = pk2(x[6], x[7]); return o; }
__device__ __forceinline__ float sum8_dpp(float v) { v += DPP_F(v, 0xB1); v += DPP_F(v, 0x4E); v += DPP_F(v, 0x141); return v; }
__device__ __forceinline__ void rope8(float (&y)[8], const int c, const float (&cs)[8], const float (&sn)[8]) {
#pragma unroll
    for (int i = 0; i < 8; ++i) { const float p = DPP_F(y[i], 0xB1); const float r = (c == 0) ? (y[i] * cs[i] - p * sn[i]) : (p * sn[i] + y[i] * cs[i]); y[i] = (c < 2) ? r : y[i]; }
}
__device__ __forceinline__ void phase_postproj(Frame& F, ArgsP AR) {
    const bf16* PROJ = (const bf16*)(F.ws + BG_PROJ); const float* ROPE = (const float*)(F.ws + WS_ROPE);
    bf16* Q = (bf16*)(F.ws + BG_Q); bf16* QI = (bf16*)(F.ws + BG_QI); bf16* Kb = (bf16*)(F.ws + BG_K); bf16* Vb = (bf16*)(F.ws + BG_V); bf16* KIb = (bf16*)(F.ws + BG_KI); float* WI = (float*)(F.ws + BG_WI);
    bf16* AUG = (bf16*)(F.ws + BG_AUG); bf16* VT = (bf16*)(F.ws + BG_VT);
    LAS bf16* vsc = (LAS bf16*)(F.lds + F.wave * 1024);
    const int lane = F.lane, hs = lane >> 3, c = lane & 7;
    float qg[8], kg[8];
#pragma unroll
    for (int i = 0; i < 8; ++i) { qg[i] = FIN(21)[8 * c + i]; kg[i] = FIN(22)[8 * c + i]; }
#pragma unroll 1
    for (int grp = F.gw; grp < T / 8; grp += F.NGW) {
        const int base = grp * 8;
#pragma unroll 2
        for (int q = 0; q < 8; ++q) {
            const int t = base + q; const bf16* p = PROJ + (size_t)t * INP;
            const v4u wu = *(const v4u*)(p + 8 * lane), wq = *(const v4u*)(p + 512 + 8 * lane), wi_ = *(const v4u*)(p + 1152 + 8 * lane);
            float cs[8], sn[8];
            { const f32x4* rp = (const f32x4*)(ROPE + (size_t)t * 16);
#pragma unroll
              for (int i = 0; i < 4; ++i) { const f32x4 r = rp[i]; cs[2 * i] = r.x; sn[2 * i] = r.y; cs[2 * i + 1] = r.z; sn[2 * i + 1] = r.w; } }
            *(v4u*)(AUG + ((size_t)(lane >> 1) * 512 + (t >> 5)) * 640 + (t & 31) * 16 + 8 * (lane & 1)) = wu;
            float x[8]; unpack8(wq, x);
            float ss = 0.f;
#pragma unroll
            for (int i = 0; i < 8; ++i) ss += x[i] * x[i];
            const float rstd = rsqrtf(sum8_dpp(ss) * (1.0f / 64.0f) + 1e-6f);
#pragma unroll
            for (int i = 0; i < 8; ++i) x[i] = x[i] * rstd * qg[i];
            rope8(x, c, cs, sn);
            *(v4u*)(Q + (size_t)t * 512 + 8 * lane) = pack8(x);
            unpack8(wi_, x); rope8(x, c, cs, sn);
            *(v4u*)(QI + (size_t)t * 512 + 8 * lane) = pack8(x);
        }
        {
            const int t = base + hs; const bf16* p = PROJ + (size_t)t * INP;
            const v4u wk = *(const v4u*)(p + 1024 + 8 * c), wv = *(const v4u*)(p + 1088 + 8 * c), wki = *(const v4u*)(p + 1664 + 8 * c);
            const float wgt = bf2f(p[1728 + c]);
            float cs[8], sn[8];
            { const f32x4* rp = (const f32x4*)(ROPE + (size_t)t * 16);
#pragma unroll
              for (int i = 0; i < 4; ++i) { const f32x4 r = rp[i]; cs[2 * i] = r.x; sn[2 * i] = r.y; cs[2 * i + 1] = r.z; sn[2 * i + 1] = r.w; } }
            float x[8]; unpack8(wk, x);
            float ss = 0.f;
#pragma unroll
            for (int i = 0; i < 8; ++i) ss += x[i] * x[i];
            const float rstd = rsqrtf(sum8_dpp(ss) * (1.0f / 64.0f) + 1e-6f);
#pragma unroll
            for (int i = 0; i < 8; ++i) x[i] = x[i] * rstd * kg[i];
            rope8(x, c, cs, sn);
            *(v4u*)(Kb + (size_t)t * 64 + 8 * c) = pack8(x);
            unpack8(wki, x); rope8(x, c, cs, sn);
            *(v4u*)(KIb + (size_t)t * 64 + 8 * c) = pack8(x);
            *(v4u*)(Vb + (size_t)t * 64 + 8 * c) = wv;
            WI[(size_t)t * 8 + c] = wgt * 0.35355339059327373f;
            *(LAS v4u*)(vsc + hs * 64 + 8 * c) = wv;
            LDS_WAIT();
            unsigned short e[8];
#pragma unroll
            for (int i = 0; i < 8; ++i) e[i] = vsc[i * 64 + lane];
            v4u o; o.x = (unsigned)e[0] | ((unsigned)e[1] << 16); o.y = (unsigned)e[2] | ((unsigned)e[3] << 16); o.z = (unsigned)e[4] | ((unsigned)e[5] << 16); o.w = (unsigned)e[6] | ((unsigned)e[7] << 16);
            *(v4u*)(VT + ((size_t)(base >> 12) * 64 + lane) * 4096 + (base & 4095)) = o;
            LDS_WAIT();
        }
    }
}

__device__ __forceinline__ void phase_s5a(Frame& F, ArgsP AR) {
    const float* S5 = (const float*)(F.ws + WS_S5T); const float* U = (const float*)(F.ws + BG_U); float* SLOC = (float*)(F.ws + BG_SLOC);
    const int p = F.lane;
    for (int it = F.gw; it < 4 * 32 * 64; it += F.NGW) {
        const int c = it & 63, g = (it >> 6) & 31, b = it >> 11;
        const float ar = S5[S5_ABAR + 2 * (g * 64 + p)], ai = S5[S5_ABAR + 2 * (g * 64 + p) + 1];
        float br[16], bi[16];
#pragma unroll
        for (int h = 0; h < 16; ++h) { br[h] = S5[S5_BBR + (g * 64 + p) * 16 + h]; bi[h] = S5[S5_BBI + (g * 64 + p) * 16 + h]; }
        float sr = 0.f, si = 0.f;
        const float* up = U + ((size_t)b * SEQ + c * 64) * 512 + g * 16;
        for (int tau = 0; tau < 64; ++tau) {
            float bur = 0.f, bui = 0.f;
#pragma unroll
            for (int h = 0; h < 16; ++h) { const float u = up[(size_t)tau * 512 + h]; bur += br[h] * u; bui += bi[h] * u; }
            const float nr = ar * sr - ai * si + bur, ni = ar * si + ai * sr + bui; sr = nr; si = ni;
        }
        SLOC[((size_t)it * 64 + p) * 2] = sr; SLOC[((size_t)it * 64 + p) * 2 + 1] = si;
    }
}
__device__ __forceinline__ void phase_s5b(Frame& F, ArgsP AR) {
    const float* S5 = (const float*)(F.ws + WS_S5T); const float* SLOC = (const float*)(F.ws + BG_SLOC); float* SIN = (float*)(F.ws + BG_SIN);
    const int gid = F.bid * 512 + F.tid;
    for (int i = gid; i < 4 * 32 * 64; i += F.G * 512) {
        const int p = i & 63, g = (i >> 6) & 31, b = i >> 11;
        const float ar = S5[S5_A64 + 2 * (g * 64 + p)], ai = S5[S5_A64 + 2 * (g * 64 + p) + 1];
        float sr = 0.f, si = 0.f;
        for (int c = 0; c < 64; ++c) {
            const size_t o = ((((size_t)b * 32 + g) * 64 + c) * 64 + p) * 2;
            SIN[o] = sr; SIN[o + 1] = si;
            const float lr = SLOC[o], li = SLOC[o + 1];
            const float nr = ar * sr - ai * si + lr, ni = ar * si + ai * sr + li; sr = nr; si = ni;
        }
    }
}
__device__ __forceinline__ void phase_s5c(Frame& F, ArgsP AR) {
    const float* S5 = (const float*)(F.ws + WS_S5T); const float* U = (const float*)(F.ws + BG_U); const float* SIN = (const float*)(F.ws + BG_SIN); bf16* MIX = (bf16*)(F.ws + BG_MIX);
    const float* cre = FIN(16); const float* cim = FIN(17); const float* dsk = FIN(18); const float* gluw = FIN(19); const float* glub = FIN(20);
    LAS float* st = (LAS float*)(F.lds + F.wave * 10240);
    LAS float* yg = st + 2048;
    const int p = F.lane, h = F.lane & 15, tq = F.lane >> 4;
    for (int it = F.gw; it < 4 * 32 * 64; it += F.NGW) {
        const int c = it & 63, g = (it >> 6) & 31, b = it >> 11;
        const float ar = S5[S5_ABAR + 2 * (g * 64 + p)], ai = S5[S5_ABAR + 2 * (g * 64 + p) + 1];
        float br[16], bi[16];
#pragma unroll
        for (int hh = 0; hh < 16; ++hh) { br[hh] = S5[S5_BBR + (g * 64 + p) * 16 + hh]; bi[hh] = S5[S5_BBI + (g * 64 + p) * 16 + hh]; }
        float sr = SIN[((size_t)it * 64 + p) * 2], si = SIN[((size_t)it * 64 + p) * 2 + 1];
        const size_t trow0 = (size_t)b * SEQ + c * 64;
        const float dd = dsk[g * 16 + h], gb = glub[g * 16 + h];
        for (int sub = 0; sub < 4; ++sub) {
            const float* up = U + (trow0 + sub * 16) * 512 + g * 16;
            for (int tau = 0; tau < 16; ++tau) {
                float bur = 0.f, bui = 0.f;
#pragma unroll
                for (int hh = 0; hh < 16; ++hh) { const float u = up[(size_t)tau * 512 + hh]; bur += br[hh] * u; bui += bi[hh] * u; }
                const float nr = ar * sr - ai * si + bur, ni = ar * si + ai * sr + bui; sr = nr; si = ni;
                st[(tau * 64 + p) * 2] = sr; st[(tau * 64 + p) * 2 + 1] = si;
            }
            LDS_WAIT();
            float y[4];
#pragma unroll
            for (int j = 0; j < 4; ++j) { const int tau = tq + 4 * j; float a = 0.f;
                for (int pp = 0; pp < 64; ++pp) a += cre[(g * 16 + h) * 64 + pp] * st[(tau * 64 + pp) * 2] - cim[(g * 16 + h) * 64 + pp] * st[(tau * 64 + pp) * 2 + 1];
                a += dd * up[(size_t)tau * 512 + h];
                const float ge = 0.5f * a * (1.0f + tanhf(0.7978845608028654f * (a + 0.044715f * a * a * a)));
                y[j] = ge; yg[tau * 16 + h] = ge; }
            LDS_WAIT();
#pragma unroll
            for (int j = 0; j < 4; ++j) { const int tau = tq + 4 * j; float z = gb;
#pragma unroll
                for (int hh = 0; hh < 16; ++hh) z += yg[tau * 16 + hh] * gluw[(g * 16 + hh) * 16 + h];
                MIX[(trow0 + sub * 16 + tau) * D + g * 16 + h] = (bf16)f2bf(y[j] * sigmoidf_(z)); }
            LDS_WAIT();
        }
    }
}


__device__ __forceinline__ void phase_s5mats(Frame& F, ArgsP AR) {
    const float* cre = FIN(16); const float* cim = FIN(17);
    bf16* MB = (bf16*)(F.ws + BG_S5MB); bf16* WE = (bf16*)(F.ws + BG_S5WE);
    LAS double* pw = (LAS double*)F.lds;
    LAS float* bbr = (LAS float*)(F.lds + 34816);
    LAS float* bbi = bbr + 1024;
    const int tid = F.tid;
#pragma unroll 1
    for (int unit = F.bid; unit < 256; unit += F.G) {
        const int g = unit >> 3, part = unit & 7;
        __syncthreads();
        const double dt = exp((double)FIN(13)[g]);
        for (int i = tid; i < 64 * 33; i += 512) { const int p = i / 33, dl = i % 33; const double lr = FIN(11)[g * 64 + p], li = FIN(12)[g * 64 + p];
            const double mag = exp(lr * dt * dl), ang = li * dt * dl; pw[2 * i] = mag * cos(ang); pw[2 * i + 1] = mag * sin(ang); }
        if (tid < 64) { const int p = tid; const double lr = FIN(11)[g * 64 + p], li = FIN(12)[g * 64 + p];
            const double mag = exp(lr * dt), ar = mag * cos(li * dt), ai = mag * sin(li * dt);
            const double nr = ar - 1.0, ni = ai, den = lr * lr + li * li; const double cr = (nr * lr + ni * li) / den, ci = (ni * lr - nr * li) / den;
            for (int h = 0; h < 16; ++h) { const double br = FIN(14)[(g * 64 + p) * 16 + h], bi = FIN(15)[(g * 64 + p) * 16 + h]; bbr[p * 16 + h] = (float)(cr * br - ci * bi); bbi[p * 16 + h] = (float)(cr * bi + ci * br); } }
        __syncthreads();
        if (part == 0 && tid < 64) { double* POW = (double*)(F.ws + BG_POW); const int gi = (g * 64 + tid) * 33 + 32; POW[2 * gi] = pw[2 * (tid * 33 + 32)]; POW[2 * gi + 1] = pw[2 * (tid * 33 + 32) + 1]; }
        for (int i = tid; i < 4 * 256; i += 512) {
            const int h2 = i & 15, h = (i >> 4) & 15, dl = 4 * part + (i >> 8);
            double acc = 0.0;
#pragma unroll 8
            for (int p = 0; p < 64; ++p) {
                const double pr = pw[2 * (p * 33 + dl)], pi = pw[2 * (p * 33 + dl) + 1];
                const double br = bbr[p * 16 + h2], bi = bbi[p * 16 + h2];
                acc += (double)cre[(g * 16 + h) * 64 + p] * (pr * br - pi * bi) - (double)cim[(g * 16 + h) * 64 + p] * (pr * bi + pi * br);
            }
            const bf16 kv = (bf16)f2bf((float)acc);
            bf16* Mg = MB + (size_t)g * 512 * 640;
            for (int t2 = 0; t2 + dl < 32; ++t2) {
                Mg[(size_t)((t2 + dl) * 16 + h) * 640 + t2 * 16 + h2] = kv;
                if (dl > 0) Mg[(size_t)(t2 * 16 + h) * 640 + (t2 + dl) * 16 + h2] = (bf16)0;
            }
        }
        for (int i = tid; i < 4 * 16 * 64; i += 512) {
            const int p = i & 63, h = (i >> 6) & 15, tau = 4 * part + (i >> 10);
            const double pr = pw[2 * (p * 33 + tau + 1)], pi = pw[2 * (p * 33 + tau + 1) + 1];
            const double cr = cre[(g * 16 + h) * 64 + p], ci = cim[(g * 16 + h) * 64 + p];
            bf16* row = MB + ((size_t)g * 512 + tau * 16 + h) * 640 + 512 + 2 * p;
            *(unsigned*)row = pk2((float)(cr * pr - ci * pi), (float)(-(cr * pi + ci * pr)));
        }
        for (int i = tid; i < 8 * 512; i += 512) {
            const int k = i & 511, p = 8 * part + (i >> 9);
            const int tau = k >> 4, h2 = k & 15;
            const double pr = pw[2 * (p * 33 + 31 - tau)], pi = pw[2 * (p * 33 + 31 - tau) + 1];
            const double br = bbr[p * 16 + h2], bi = bbi[p * 16 + h2];
            bf16* Wg = WE + (size_t)g * 256 * 512;
            Wg[(size_t)(2 * p) * 512 + k] = (bf16)f2bf((float)(pr * br - pi * bi));
            Wg[(size_t)(2 * p + 1) * 512 + k] = (bf16)f2bf((float)(pr * bi + pi * br));
            Wg[(size_t)(128 + 2 * p) * 512 + k] = (bf16)0; Wg[(size_t)(128 + 2 * p + 1) * 512 + k] = (bf16)0;
        }
    }
    __syncthreads();
}
struct S5AOrder {
    const unsigned char* ws; int c, G;
    __device__ __forceinline__ bool next(int i, pg8::Unit& u) const { const int L = i * G + c; if (L >= 64) return false; u.e = L >> 1; u.pm = L & 1; u.pn = 0; u.rows = 256; return true; }
    __device__ __forceinline__ const char* a_base(const pg8::Unit& u) const { return (const char*)(ws + BG_AUG) + ((size_t)u.e * 512 + u.pm * 256) * 1280; }
    __device__ __forceinline__ const char* b_base(const pg8::Unit& u) const { return (const char*)(ws + BG_S5WE) + (size_t)u.e * 256 * 1024; }
    __device__ __forceinline__ unsigned a_off(const pg8::Unit&, int) const { return 0u; }
};
struct EpiS5A { static constexpr bool PERM = false; float* SL;
    __device__ __forceinline__ void operator()(const pg8::f32x4 (&acc)[2][2][4][2], const pg8::Unit& u, int wr, int wc, int fr, int fq) const {
#pragma unroll
        for (int ai = 0; ai < 2; ++ai)
#pragma unroll
            for (int m = 0; m < 4; ++m) { float* rowp = SL + ((size_t)u.e * 512 + u.pm * 256 + ai * 128 + wr * 64 + m * 16 + fr) * 128 + wc * 32 + 4 * fq;
#pragma unroll
                for (int n = 0; n < 2; ++n) *(f32x4*)(rowp + n * 16) = acc[ai][0][m][n]; }
    }
};
struct S5BOrder {
    const unsigned char* ws; int c, G;
    __device__ __forceinline__ bool next(int i, pg8::Unit& u) const { const int L = i * G + c; if (L >= 128) return false; u.e = L >> 2; u.pm = (L >> 1) & 1; u.pn = L & 1; u.rows = 256; return true; }
    __device__ __forceinline__ const char* a_base(const pg8::Unit& u) const { return (const char*)(ws + BG_AUG) + ((size_t)u.e * 512 + u.pm * 256) * 1280; }
    __device__ __forceinline__ const char* b_base(const pg8::Unit& u) const { return (const char*)(ws + BG_S5MB) + ((size_t)u.e * 512 + u.pn * 256) * 1280; }
    __device__ __forceinline__ unsigned a_off(const pg8::Unit&, int) const { return 0u; }
};
typedef short bf16x4s __attribute__((ext_vector_type(4)));
__device__ __forceinline__ float fast_tanh(float x) { const float e = __expf(2.0f * x); return 1.0f - 2.0f / (e + 1.0f); }
struct EpiS5B { static constexpr bool PERM = false; const unsigned char* ws; const float* dsk; const float* gluw; const float* glub; bf16* MIX;
    __device__ __forceinline__ void operator()(const pg8::f32x4 (&acc)[2][2][4][2], const pg8::Unit& u, int wr, int wc, int fr, int fq) const {
        const int g = u.e; const bf16* AUG = (const bf16*)(ws + BG_AUG);
        const f32x4 d4 = *(const f32x4*)(dsk + g * 16 + 4 * fq), b4 = *(const f32x4*)(glub + g * 16 + 4 * fq);
        bf16x4s wa; { const float* wp = gluw + (g * 16 + 4 * fq) * 16 + fr; const v2u t2 = (v2u){pk2(wp[0], wp[16]), pk2(wp[32], wp[48])}; wa = __builtin_bit_cast(bf16x4s, t2); }
#pragma unroll
        for (int ai = 0; ai < 2; ++ai)
#pragma unroll
            for (int m = 0; m < 4; ++m) { const int nidx = u.pm * 256 + ai * 128 + wr * 64 + m * 16 + fr;
                v2u uw[2][2];
#pragma unroll
                for (int bj = 0; bj < 2; ++bj)
#pragma unroll
                    for (int n = 0; n < 2; ++n) { const int tau = 16 * u.pn + 8 * bj + 2 * wc + n; uw[bj][n] = *(const v2u*)(AUG + ((size_t)g * 512 + nidx) * 640 + tau * 16 + 4 * fq); }
#pragma unroll
                for (int bj = 0; bj < 2; ++bj)
#pragma unroll
                    for (int n = 0; n < 2; ++n) {
                        const int tau = 16 * u.pn + 8 * bj + 2 * wc + n;
                        const f32x4 a = acc[ai][bj][m][n];
                        float y[4] = {a.x + d4.x * bflo(uw[bj][n].x), a.y + d4.y * bfhi(uw[bj][n].x), a.z + d4.z * bflo(uw[bj][n].y), a.w + d4.w * bfhi(uw[bj][n].y)};
#pragma unroll
                        for (int k = 0; k < 4; ++k) { const float v = y[k]; y[k] = 0.5f * v * (1.0f + fast_tanh(0.7978845608028654f * (v + 0.044715f * v * v * v))); }
                        const v2u yb2 = (v2u){pk2(y[0], y[1]), pk2(y[2], y[3])};
                        const f32x4 z = __builtin_amdgcn_mfma_f32_16x16x16bf16_1k(wa, __builtin_bit_cast(bf16x4s, yb2), b4, 0, 0, 0);
                        const size_t t = (size_t)nidx * 32 + tau;
                        v2u ov; ov.x = pk2(y[0] * sigmoidf_(z.x), y[1] * sigmoidf_(z.y)); ov.y = pk2(y[2] * sigmoidf_(z.z), y[3] * sigmoidf_(z.w));
                        *(v2u*)(MIX + t * D + g * 16 + 4 * fq) = ov;
                    }
                asm volatile("" ::: "memory"); }
    }
};
__device__ __forceinline__ void phase_s5carry(Frame& F) {
    const double* POW = (const double*)(F.ws + BG_POW); const float* SL = (const float*)(F.ws + BG_SL2); bf16* AUG = (bf16*)(F.ws + BG_AUG);
    const int gid = F.bid * 512 + F.tid;
    for (int i = gid; i < 4 * 32 * 64; i += F.G * 512) {
        const int p = i & 63, g = (i >> 6) & 31, b = i >> 11;
        const float ar = (float)POW[2 * ((g * 64 + p) * 33 + 32)], ai = (float)POW[2 * ((g * 64 + p) * 33 + 32) + 1];
        float sr = 0.f, si = 0.f;
#pragma unroll 8
        for (int c = 0; c < 128; ++c) {
            const size_t n = (size_t)g * 512 + b * 128 + c;
            *(unsigned*)(AUG + n * 640 + 512 + 2 * p) = pk2(sr, si);
            const float lr = SL[n * 128 + 2 * p], li = SL[n * 128 + 2 * p + 1];
            const float nr = ar * sr - ai * si + lr, ni = ar * si + ai * sr + li; sr = nr; si = ni;
        }
    }
}

__device__ __forceinline__ unsigned fkey(float f) { const unsigned u = __builtin_bit_cast(unsigned, f); return (u & 0x80000000u) ? ~u : (u | 0x80000000u); }
__device__ __forceinline__ void phase_dsa(Frame& F, ArgsP AR) {
    const bf16* Q = (const bf16*)(F.ws + BG_Q); const bf16* QI = (const bf16*)(F.ws + BG_QI); const bf16* Kb = (const bf16*)(F.ws + BG_K); const bf16* Vb = (const bf16*)(F.ws + BG_V);
    const bf16* KIb = (const bf16*)(F.ws + BG_KI); const float* WI = (const float*)(F.ws + BG_WI); bf16* MIX = (bf16*)(F.ws + BG_MIX);
    LAS unsigned char* wl = F.lds + F.wave * 19456;
    LAS float* sc = (LAS float*)wl;
    LAS float* qf = (LAS float*)(wl + 16384);
    LAS int* list = (LAS int*)(wl + 16384 + 2048);
    const int lane = F.lane;
#pragma unroll 1
    for (int it = F.bid; it < T / 8; it += F.G) {
        const int t = (T / 8 - 1 - it) * 8 + F.wave;
        const int b = t >> 12, tp = t & 4095, n = tp + 1;
        const size_t kb0 = (size_t)b * SEQ;
#pragma unroll
        for (int j = 0; j < 8; ++j) qf[j * 64 + lane] = bf2f(QI[(size_t)t * 512 + j * 64 + lane]);
        float wv[8];
#pragma unroll
        for (int h = 0; h < 8; ++h) wv[h] = WI[(size_t)t * 8 + h];
        LDS_WAIT();
#pragma unroll 1
        for (int s0 = 0; s0 < n; s0 += 64) {
            asm volatile("" ::: "memory");
            const int s = s0 + lane;
            float score = -INFINITY;
            if (s < n) {
                const v4u* kp = (const v4u*)(KIb + (kb0 + s) * 64);
                float dh[8];
#pragma unroll
                for (int h = 0; h < 8; ++h) dh[h] = 0.f;
#pragma unroll 1
                for (int half = 0; half < 2; ++half) {
                    asm volatile("" ::: "memory");
                    float kf[32];
#pragma unroll
                    for (int i = 0; i < 4; ++i) { const v4u w = kp[half * 4 + i]; kf[8 * i] = bflo(w.x); kf[8 * i + 1] = bfhi(w.x); kf[8 * i + 2] = bflo(w.y); kf[8 * i + 3] = bfhi(w.y); kf[8 * i + 4] = bflo(w.z); kf[8 * i + 5] = bfhi(w.z); kf[8 * i + 6] = bflo(w.w); kf[8 * i + 7] = bfhi(w.w); }
#pragma unroll
                    for (int h = 0; h < 8; ++h) { float d = 0.f;
#pragma unroll
                        for (int i = 0; i < 8; ++i) { const f32x4 qv = *(const LAS f32x4*)(qf + h * 64 + half * 32 + 4 * i); d += qv.x * kf[4 * i] + qv.y * kf[4 * i + 1] + qv.z * kf[4 * i + 2] + qv.w * kf[4 * i + 3]; }
                        dh[h] += d; __builtin_amdgcn_sched_barrier(0); }
                }
                float a = 0.f;
#pragma unroll
                for (int h = 0; h < 8; ++h) a += wv[h] * fmaxf(dh[h] * 0.125f, 0.f);
                score = a;
            }
            sc[s] = score;
        }
        LDS_WAIT();
        int nsel;
        if (n <= 256) { for (int i = lane; i < n; i += 64) list[i] = i; nsel = n; }
        else {
            const int nch = (n + 63) >> 6;
            unsigned thr = 0u;
#pragma unroll 1
            for (int bit = 31; bit >= 0; --bit) {
                const unsigned cand = thr | (1u << bit); int cnt = 0;
#pragma unroll 1
                for (int j = 0; j < nch; ++j) { const int s = j * 64 + lane; if (s < n) cnt += (fkey(sc[s]) >= cand) ? 1 : 0; }
                cnt = wave_sum_i(cnt);
                if (cnt >= 256) thr = cand;
            }
            int cgt = 0;
            for (int j = 0; j < nch; ++j) { const int s = j * 64 + lane; if (s < n) cgt += (fkey(sc[s]) > thr) ? 1 : 0; }
            cgt = wave_sum_i(cgt);
            const int need_eq = 256 - cgt;
            int run = 0, eqrun = 0;
            const unsigned long long lt = (lane == 0) ? 0ull : (~0ull >> (64 - lane));
            for (int j = 0; j < nch; ++j) {
                const int s = j * 64 + lane; const bool in = s < n; const unsigned k = in ? fkey(sc[s]) : 0u;
                const bool gt = in && k > thr, eq = in && k == thr;
                const unsigned long long beq = __ballot(eq);
                const int myeq = eqrun + __popcll(beq & lt);
                const bool sel = gt || (eq && myeq < need_eq);
                const unsigned long long bs = __ballot(sel);
                if (sel) list[run + __popcll(bs & lt)] = s;
                run += __popcll(bs); eqrun += __popcll(beq);
            }
            nsel = run;
        }
        LDS_WAIT();
#pragma unroll
        for (int j = 0; j < 8; ++j) qf[j * 64 + lane] = bf2f(Q[(size_t)t * 512 + j * 64 + lane]);
        LDS_WAIT();
        float mx[8];
#pragma unroll
        for (int h = 0; h < 8; ++h) mx[h] = -INFINITY;
#pragma unroll 1
        for (int i0 = 0; i0 < nsel; i0 += 64) {
            asm volatile("" ::: "memory");
            const int i = i0 + lane;
            if (i < nsel) {
                const int s = list[i];
                const v4u* kp = (const v4u*)(Kb + (kb0 + s) * 64);
                float dh[8];
#pragma unroll
                for (int h = 0; h < 8; ++h) dh[h] = 0.f;
#pragma unroll 1
                for (int half = 0; half < 2; ++half) {
                    asm volatile("" ::: "memory");
                    float kf[32];
#pragma unroll
                    for (int q = 0; q < 4; ++q) { const v4u w = kp[half * 4 + q]; kf[8 * q] = bflo(w.x); kf[8 * q + 1] = bfhi(w.x); kf[8 * q + 2] = bflo(w.y); kf[8 * q + 3] = bfhi(w.y); kf[8 * q + 4] = bflo(w.z); kf[8 * q + 5] = bfhi(w.z); kf[8 * q + 6] = bflo(w.w); kf[8 * q + 7] = bfhi(w.w); }
#pragma unroll
                    for (int h = 0; h < 8; ++h) { float d = 0.f;
#pragma unroll
                        for (int q = 0; q < 8; ++q) { const f32x4 qv = *(const LAS f32x4*)(qf + h * 64 + half * 32 + 4 * q); d += qv.x * kf[4 * q] + qv.y * kf[4 * q + 1] + qv.z * kf[4 * q + 2] + qv.w * kf[4 * q + 3]; }
                        dh[h] += d; __builtin_amdgcn_sched_barrier(0); }
                }
#pragma unroll
                for (int h = 0; h < 8; ++h) { const float d = dh[h] * 0.125f; sc[i * 8 + h] = d; mx[h] = fmaxf(mx[h], d); }
            }
        }
        float lsum[8];
#pragma unroll
        for (int h = 0; h < 8; ++h) { mx[h] = wave_max(mx[h]); lsum[h] = 0.f; }
        LDS_WAIT();
        for (int i0 = 0; i0 < nsel; i0 += 64) {
            const int i = i0 + lane;
            if (i < nsel) {
#pragma unroll
                for (int h = 0; h < 8; ++h) { const float pv = __expf(sc[i * 8 + h] - mx[h]); sc[i * 8 + h] = pv; lsum[h] += pv; }
            }
        }
#pragma unroll
        for (int h = 0; h < 8; ++h) lsum[h] = wave_sum(lsum[h]);
        LDS_WAIT();
        float o[8];
#pragma unroll
        for (int h = 0; h < 8; ++h) o[h] = 0.f;
#pragma unroll 2
        for (int i = 0; i < nsel; ++i) {
            const int s = list[i];
            const float v = bf2f(Vb[(kb0 + s) * 64 + lane]);
            const f32x4 p0 = *(const LAS f32x4*)(sc + i * 8), p1 = *(const LAS f32x4*)(sc + i * 8 + 4);
            o[0] += p0.x * v; o[1] += p0.y * v; o[2] += p0.z * v; o[3] += p0.w * v; o[4] += p1.x * v; o[5] += p1.y * v; o[6] += p1.z * v; o[7] += p1.w * v;
        }
#pragma unroll
        for (int h = 0; h < 8; ++h) MIX[(size_t)t * D + 512 + h * 64 + lane] = (bf16)f2bf(o[h] / lsum[h]);
        LDS_WAIT();
    }
}


typedef float f32x16 __attribute__((ext_vector_type(16)));
constexpr int DS_SC = 0;
constexpr int DS_BM = 131072;
constexpr int DS_WT = DS_BM + 8192;
constexpr int DS_MRG = 32768;
__device__ __forceinline__ void swap32(float v, float& lo, float& hi) { float a = v, b = v; asm volatile("s_nop 1\n\tv_permlane32_swap_b32 %0, %1\n\ts_nop 1" : "+v"(a), "+v"(b)); lo = a; hi = b; }
__device__ __forceinline__ float swap32_sum(float v) { float a, b; swap32(v, a, b); return a + b; }
__device__ __forceinline__ float swap32_max(float v) { float a, b; swap32(v, a, b); return fmaxf(a, b); }
__device__ __forceinline__ float dppf(float v, const int ctrl) { return v; }
__device__ __forceinline__ float wave_max_dpp(float v) {
    v = fmaxf(v, DPP_F(v, 0xB1)); v = fmaxf(v, DPP_F(v, 0x4E)); v = fmaxf(v, DPP_F(v, 0x141)); v = fmaxf(v, DPP_F(v, 0x140));
    const float a = __builtin_bit_cast(float, __builtin_amdgcn_readlane(__builtin_bit_cast(int, v), 0)), b = __builtin_bit_cast(float, __builtin_amdgcn_readlane(__builtin_bit_cast(int, v), 16));
    const float c = __builtin_bit_cast(float, __builtin_amdgcn_readlane(__builtin_bit_cast(int, v), 32)), d = __builtin_bit_cast(float, __builtin_amdgcn_readlane(__builtin_bit_cast(int, v), 48));
    return fmaxf(fmaxf(a, b), fmaxf(c, d));
}
__device__ __forceinline__ float wave_sum_dppf(float v) {
    v += DPP_F(v, 0xB1); v += DPP_F(v, 0x4E); v += DPP_F(v, 0x141); v += DPP_F(v, 0x140);
    const float a = __builtin_bit_cast(float, __builtin_amdgcn_readlane(__builtin_bit_cast(int, v), 0)), b = __builtin_bit_cast(float, __builtin_amdgcn_readlane(__builtin_bit_cast(int, v), 16));
    const float c = __builtin_bit_cast(float, __builtin_amdgcn_readlane(__builtin_bit_cast(int, v), 32)), d = __builtin_bit_cast(float, __builtin_amdgcn_readlane(__builtin_bit_cast(int, v), 48));
    return (a + b) + (c + d);
}
__device__ __forceinline__ int wave_sum_dpp(int v) {
    v += __builtin_amdgcn_update_dpp(0, v, 0xB1, 0xF, 0xF, false);
    v += __builtin_amdgcn_update_dpp(0, v, 0x4E, 0xF, 0xF, false);
    v += __builtin_amdgcn_update_dpp(0, v, 0x141, 0xF, 0xF, false);
    v += __builtin_amdgcn_update_dpp(0, v, 0x140, 0xF, 0xF, false);
    return __builtin_amdgcn_readlane(v, 0) + __builtin_amdgcn_readlane(v, 16) + __builtin_amdgcn_readlane(v, 32) + __builtin_amdgcn_readlane(v, 48);
}
__device__ __forceinline__ void phase_dsa2(Frame& F, ArgsP AR, unsigned long long* probe_acc) {
    unsigned long long ps0_ = (PROBE_PHASE >= 300 && PROBE_PHASE < 400) ? __builtin_amdgcn_s_memrealtime() : 0ull;
#define PSECD(id) do { if (PROBE_PHASE >= 300 && PROBE_PHASE < 400) { const unsigned long long n_ = __builtin_amdgcn_s_memrealtime(); if (PROBE_PHASE == 300 + (id)) *probe_acc += n_ - ps0_; ps0_ = n_; } } while (0)
    const bf16* Q = (const bf16*)(F.ws + BG_Q); const bf16* QI = (const bf16*)(F.ws + BG_QI); const bf16* Kb = (const bf16*)(F.ws + BG_K); const bf16* VT = (const bf16*)(F.ws + BG_VT);
    const bf16* KIb = (const bf16*)(F.ws + BG_KI); const float* WI = (const float*)(F.ws + BG_WI); bf16* MIX = (bf16*)(F.ws + BG_MIX);
    LAS unsigned short* SC = (LAS unsigned short*)(F.lds + DS_SC);
    LAS unsigned char* BM = F.lds + DS_BM;
    LAS float* WT = (LAS float*)(F.lds + DS_WT);
    const int lane = F.lane, w = F.wave, tid = F.tid;
    const int r32 = lane & 31, h = lane >> 5;
    const int nunits = T / 16;
#pragma unroll 1
    for (int i = 0; ; ++i) {
        int j = i * F.G + ((i & 1) ? (F.G - 1 - F.bid) : F.bid);
        if (i * F.G >= nunits) break;
        if (j >= nunits) continue;
        const int b = j & 3, qt = j >> 2;
        const int tp0 = qt * 16, t0 = b * SEQ + tp0;
        const int n_keys = tp0 + 16;
        const int nkt = (n_keys + 31) >> 5, n_comp = nkt * 32, nst = (n_keys + 63) >> 6;
        const size_t kb0 = (size_t)b * SEQ;
        PSECD(3);
        if (tid < 128) WT[tid] = WI[(size_t)t0 * 8 + tid] * 0.125f;
        {
            const int ptl = ((r32 >> 2) & 1) * 2 + (r32 >> 4), phd = ((r32 >> 3) & 1) * 4 + (r32 & 3);
            bf16x8 af[4][4];
#pragma unroll
            for (int rb = 0; rb < 4; ++rb)
#pragma unroll
                for (int ks = 0; ks < 4; ++ks) af[rb][ks] = *(const bf16x8*)(QI + ((size_t)(t0 + 4 * rb + ptl) * 8 + phd) * 64 + ks * 16 + h * 8);
            __syncthreads();
            bf16x8 bfr[4], bnx[4];
            if (w < nkt) {
                const bf16* kp = KIb + (kb0 + w * 32 + r32) * 64 + h * 8;
#pragma unroll
                for (int ks = 0; ks < 4; ++ks) bfr[ks] = *(const bf16x8*)(kp + ks * 16);
            }
#pragma unroll 1
            for (int kt = w; kt < nkt; kt += 8) {
                {
                    const int ktn = (kt + 8 < nkt) ? kt + 8 : kt;
                    const bf16* kp = KIb + (kb0 + ktn * 32 + r32) * 64 + h * 8;
#pragma unroll
                    for (int ks = 0; ks < 4; ++ks) bnx[ks] = *(const bf16x8*)(kp + ks * 16);
                }
                const int s = kt * 32 + r32;
#pragma unroll
                for (int rb = 0; rb < 4; ++rb) {
                    f32x16 acc = {0.f, 0.f, 0.f, 0.f, 0.f, 0.f, 0.f, 0.f, 0.f, 0.f, 0.f, 0.f, 0.f, 0.f, 0.f, 0.f};
#pragma unroll
                    for (int ks = 0; ks < 4; ++ks) acc = __builtin_amdgcn_mfma_f32_32x32x16_bf16(af[rb][ks], bfr[ks], acc, 0, 0, 0);
#pragma unroll
                    for (int j = 0; j < 2; ++j) {
                        const int tk = 4 * rb + 2 * h + j;
                        const f32x4 w0 = *(const LAS f32x4*)(WT + tk * 8), w1 = *(const LAS f32x4*)(WT + tk * 8 + 4);
                        const float part = (w0.x * fmaxf(acc[8 * j], 0.f) + w0.y * fmaxf(acc[8 * j + 1], 0.f)) + (w0.z * fmaxf(acc[8 * j + 2], 0.f) + w0.w * fmaxf(acc[8 * j + 3], 0.f))
                                         + (w1.x * fmaxf(acc[8 * j + 4], 0.f) + w1.y * fmaxf(acc[8 * j + 5], 0.f)) + (w1.z * fmaxf(acc[8 * j + 6], 0.f) + w1.w * fmaxf(acc[8 * j + 7], 0.f));
                        const _Float16 hf = (_Float16)part; const unsigned hb = (unsigned)__builtin_bit_cast(unsigned short, hf);
                        const unsigned key = (hb & 0x8000u) ? (~hb & 0xffffu) : (hb | 0x8000u);
                        SC[tk * 4096 + s] = (unsigned short)((s <= tp0 + tk) ? key : 0u);
                    }
                }
#pragma unroll
                for (int ks = 0; ks < 4; ++ks) bfr[ks] = bnx[ks];
            }
        }
        __syncthreads(); PSECD(0);
        {
            typedef unsigned short u16x2 __attribute__((ext_vector_type(2)));
            const int nch = (n_comp + 511) >> 9;
            const int tkA = 2 * w, tkB = 2 * w + 1;
            const LAS v4u* rowA = (const LAS v4u*)(SC + tkA * 4096); const LAS v4u* rowB = (const LAS v4u*)(SC + tkB * 4096);
            const int total = nch * 512;
            auto count_lt = [&](unsigned candA, unsigned candB, int& cA, int& cB) {
                const u16x2 ca = {(unsigned short)candA, (unsigned short)candA}, cb = {(unsigned short)candB, (unsigned short)candB}; const u16x2 one = {1, 1};
                u16x2 accA = {0, 0}, accB = {0, 0};
#pragma unroll 2
                for (int ch = 0; ch < nch; ++ch) {
                    v4u xa = (v4u){0u, 0u, 0u, 0u}, xb = xa; if (ch * 512 + lane * 8 < n_comp) { xa = rowA[ch * 64 + lane]; xb = rowB[ch * 64 + lane]; }
                    const unsigned wa[4] = {xa.x, xa.y, xa.z, xa.w}, wb[4] = {xb.x, xb.y, xb.z, xb.w};
#pragma unroll
                    for (int d = 0; d < 4; ++d) {
                        accA += __builtin_elementwise_min(__builtin_elementwise_sub_sat(ca, __builtin_bit_cast(u16x2, wa[d])), one);
                        accB += __builtin_elementwise_min(__builtin_elementwise_sub_sat(cb, __builtin_bit_cast(u16x2, wb[d])), one);
                    }
                }
                cA = wave_sum_dpp((int)accA.x + (int)accA.y); cB = wave_sum_dpp((int)accB.x + (int)accB.y);
            };
            const int nA = tp0 + tkA + 1, nB = tp0 + tkB + 1;
            unsigned thrA = 0u, thrB = 0u; int geA = total, geB = total;
            if (nB > 256) {
#pragma unroll 1
                for (int bit = 15; bit >= 0; --bit) {
                    const unsigned cA_ = thrA | (1u << bit), cB_ = thrB | (1u << bit); int ltA, ltB;
                    count_lt(cA_, cB_, ltA, ltB);
                    if (total - ltA >= 256) { thrA = cA_; geA = total - ltA; }
                    if (total - ltB >= 256) { thrB = cB_; geB = total - ltB; }
                }
                if (nA <= 256) { thrA = 0u; geA = total; }
            }
            int gtA = 0, gtB = 0;
            { int ltA, ltB; count_lt(thrA + 1u, thrB + 1u, ltA, ltB); gtA = total - ltA; gtB = total - ltB; }
            const int needA = (thrA == 0u) ? 0 : 256 - gtA, needB = (thrB == 0u) ? 0 : 256 - gtB;
            const int eqA = geA - gtA, eqB = geB - gtB;
#pragma unroll 1
            for (int q = 0; q < 2; ++q) {
                const int tk = q ? tkB : tkA; const unsigned thr = q ? thrB : thrA; const int need = q ? needB : needA; const bool all_eq = q ? (eqB == needB) : (eqA == needA);
                const LAS v4u* row = q ? rowB : rowA;
                int run = 0;
#pragma unroll 1
                for (int ch = 0; ch < nch; ++ch) {
                    v4u x = (v4u){0u, 0u, 0u, 0u}; if (ch * 512 + lane * 8 < n_comp) x = row[ch * 64 + lane];
                    const unsigned e[8] = {x.x & 0xffffu, x.x >> 16, x.y & 0xffffu, x.y >> 16, x.z & 0xffffu, x.z >> 16, x.w & 0xffffu, x.w >> 16};
                    unsigned gtb = 0u, eqb = 0u;
#pragma unroll
                    for (int k = 0; k < 8; ++k) { gtb |= (e[k] > thr) ? (1u << k) : 0u; eqb |= (e[k] == thr) ? (1u << k) : 0u; }
                    unsigned selb = gtb;
                    if (need > 0) {
                        if (all_eq) selb |= eqb;
                        else {
                            const int c = __popc(eqb); int inc = c;
#pragma unroll
                            for (int o = 1; o < 64; o <<= 1) { const int up = __shfl_up(inc, o); if (lane >= o) inc += up; }
                            const int before = run + inc - c;
                            int take = need - before; take = take < 0 ? 0 : (take > c ? c : take);
                            unsigned eb = eqb, tb = 0u;
#pragma unroll
                            for (int k = 0; k < 8; ++k) { if (take > 0 && eb) { const unsigned lowb = eb & (0u - eb); tb |= lowb; eb ^= lowb; --take; } }
                            selb |= tb;
                            run += __shfl(inc, 63);
                        }
                    }
                    BM[tk * 512 + ch * 64 + lane] = (unsigned char)selb;
                }
            }
        }
        __syncthreads(); PSECD(1);
        {
            const int rb = w & 3, kh = w >> 2;
            const int tk = 4 * rb + (r32 >> 3);
            bf16x8 qf[4];
#pragma unroll
            for (int ks = 0; ks < 4; ++ks) qf[ks] = *(const bf16x8*)(Q + ((size_t)t0 * 8 + rb * 32 + r32) * 64 + ks * 16 + h * 8);
            f32x16 O0 = {0.f, 0.f, 0.f, 0.f, 0.f, 0.f, 0.f, 0.f, 0.f, 0.f, 0.f, 0.f, 0.f, 0.f, 0.f, 0.f}, O1 = O0;
            float m = -1e30f, l = 0.f;
            const int skey = tid >> 3, sch = tid & 7;
            const bf16* ksrc = Kb + (kb0 + skey) * 64 + sch * 8;
            const bf16* vsrc = VT + ((size_t)b * 64 + skey) * 4096 + sch * 8;
            const int kdst = skey * 128 + ((sch ^ ((skey >> 1) & 7)) << 4);
            const int vf = (skey >> 1) & 15;
            const int vdst0 = skey * 128 + (((2 * sch) ^ vf) << 3), vdst1 = skey * 128 + (((2 * sch + 1) ^ vf) << 3);
            v4u kreg = *(const v4u*)(ksrc), vreg = *(const v4u*)(vsrc);
            { LAS unsigned char* kb_ = F.lds; LAS unsigned char* vb_ = F.lds + 8192;
              *(LAS v4u*)(kb_ + kdst) = kreg; *(LAS v2u*)(vb_ + vdst0) = (v2u){vreg.x, vreg.y}; *(LAS v2u*)(vb_ + vdst1) = (v2u){vreg.z, vreg.w}; }
            __syncthreads();
            const int krow = kh * 32 + r32;
            const int kswz = (krow >> 1) & 7;
            const int vfl0 = ((r32) >> 1) & 15, vfl1 = ((32 + r32) >> 1) & 15;
            constexpr float C2 = 0.125f * 1.4426950408889634f;
#pragma unroll 1
            for (int st = 0; st < nst; ++st) {
                const int cur = (st & 1) * 16384;
                { const int stn = (st + 1 < nst) ? st + 1 : st; kreg = *(const v4u*)(ksrc + (size_t)stn * 64 * 64); vreg = *(const v4u*)(vsrc + stn * 64); }
                const LAS unsigned char* kt_ = F.lds + cur; const LAS unsigned char* vt_ = F.lds + cur + 8192;
                f32x16 sv = {0.f, 0.f, 0.f, 0.f, 0.f, 0.f, 0.f, 0.f, 0.f, 0.f, 0.f, 0.f, 0.f, 0.f, 0.f, 0.f};
#pragma unroll
                for (int ks = 0; ks < 4; ++ks) { const bf16x8 ka = *(const LAS bf16x8*)(kt_ + krow * 128 + (((2 * ks + h) ^ kswz) << 4)); sv = __builtin_amdgcn_mfma_f32_32x32x16_bf16(ka, qf[ks], sv, 0, 0, 0); }
                const unsigned mw = *(const LAS unsigned*)(BM + tk * 512 + (2 * st + kh) * 4) >> (4 * h);
                float mt = fmaxf(fmaxf(sv[0], sv[1]), fmaxf(sv[2], sv[3]));
#pragma unroll
                for (int r = 4; r < 16; r += 4) mt = fmaxf(mt, fmaxf(fmaxf(sv[r], sv[r + 1]), fmaxf(sv[r + 2], sv[r + 3])));
                mt = swap32_max(mt) * C2;
                if (__builtin_amdgcn_ballot_w64(mt > m) != 0ull) {
                    const float mn = fmaxf(m, mt); const float alpha = __builtin_amdgcn_exp2f(m - mn); m = mn;
                    l *= alpha;
#pragma unroll
                    for (int r = 0; r < 16; ++r) { O0[r] *= alpha; O1[r] *= alpha; }
                }
                const float nm = -m;
                float ls = 0.f;
#pragma unroll
                for (int r = 0; r < 16; ++r) { const int kl = (r & 3) + 8 * (r >> 2);
                    const float pe = __builtin_amdgcn_exp2f(__builtin_fmaf(sv[r], C2, nm));
                    const int keep = __builtin_amdgcn_sbfe((int)mw, kl, 1);
                    sv[r] = __builtin_bit_cast(float, __builtin_bit_cast(int, pe) & keep); ls += sv[r]; }
                l += ls;
                bf16x8 pb[2];
#pragma unroll
                for (int s2 = 0; s2 < 2; ++s2) { v4u pk; pk.x = pk2(sv[8 * s2], sv[8 * s2 + 1]); pk.y = pk2(sv[8 * s2 + 2], sv[8 * s2 + 3]); pk.z = pk2(sv[8 * s2 + 4], sv[8 * s2 + 5]); pk.w = pk2(sv[8 * s2 + 6], sv[8 * s2 + 7]); pb[s2] = __builtin_bit_cast(bf16x8, pk); }
#pragma unroll
                for (int s2 = 0; s2 < 2; ++s2) {
                    const int c8 = 8 * kh + 4 * s2 + h;
                    { const v2u a0 = *(const LAS v2u*)(vt_ + r32 * 128 + ((c8 ^ vfl0) << 3)), a1 = *(const LAS v2u*)(vt_ + r32 * 128 + (((c8 + 2) ^ vfl0) << 3));
                      const v4u av = (v4u){a0.x, a0.y, a1.x, a1.y}; O0 = __builtin_amdgcn_mfma_f32_32x32x16_bf16(__builtin_bit_cast(bf16x8, av), pb[s2], O0, 0, 0, 0); }
                    { const v2u a0 = *(const LAS v2u*)(vt_ + (32 + r32) * 128 + ((c8 ^ vfl1) << 3)), a1 = *(const LAS v2u*)(vt_ + (32 + r32) * 128 + (((c8 + 2) ^ vfl1) << 3));
                      const v4u av = (v4u){a0.x, a0.y, a1.x, a1.y}; O1 = __builtin_amdgcn_mfma_f32_32x32x16_bf16(__builtin_bit_cast(bf16x8, av), pb[s2], O1, 0, 0, 0); }
                }
                { LAS unsigned char* kb_ = F.lds + (cur ^ 16384); LAS unsigned char* vb_ = kb_ + 8192;
                    *(LAS v4u*)(kb_ + kdst) = kreg; *(LAS v2u*)(vb_ + vdst0) = (v2u){vreg.x, vreg.y}; *(LAS v2u*)(vb_ + vdst1) = (v2u){vreg.z, vreg.w}; }
                __syncthreads();
            }
            l = swap32_sum(l);
            LAS float* mg = (LAS float*)(F.lds + DS_MRG + rb * 8704);
            if (kh == 1) {
#pragma unroll
                for (int r = 0; r < 16; ++r) { mg[r * 64 + lane] = O0[r]; mg[(16 + r) * 64 + lane] = O1[r]; }
                if (h == 0) { mg[2048 + r32] = m; mg[2048 + 32 + r32] = l; }
            }
            __syncthreads();
            if (kh == 0) {
                const float m1 = mg[2048 + r32], l1 = mg[2048 + 32 + r32];
                const float mf = fmaxf(m, m1); const float a0 = __builtin_amdgcn_exp2f(m - mf), a1 = __builtin_amdgcn_exp2f(m1 - mf);
                const float inv = 1.0f / (l * a0 + l1 * a1);
                bf16* orow = MIX + (size_t)(t0 + tk) * D + 512 + (r32 & 7) * 64;
#pragma unroll
                for (int g4 = 0; g4 < 4; ++g4) {
                    float o0[4], o1[4];
#pragma unroll
                    for (int k = 0; k < 4; ++k) { const int r = 4 * g4 + k; o0[k] = (O0[r] * a0 + mg[r * 64 + lane] * a1) * inv; o1[k] = (O1[r] * a0 + mg[(16 + r) * 64 + lane] * a1) * inv; }
                    v2u s0; s0.x = pk2(o0[0], o0[1]); s0.y = pk2(o0[2], o0[3]); *(v2u*)(orow + 8 * g4 + 4 * h) = s0;
                    v2u s1; s1.x = pk2(o1[0], o1[1]); s1.y = pk2(o1[2], o1[3]); *(v2u*)(orow + 32 + 8 * g4 + 4 * h) = s1;
                }
            }
            __syncthreads(); PSECD(2);
        }
    }
}

constexpr int LDS_RT = 131072;
__device__ __forceinline__ void phase_router(Frame& F, ArgsP AR, int l, unsigned long long* probe_acc) {
    unsigned long long psr_ = 0ull;
#define PSECR(id) do { if (PROBE_PHASE >= 100 && PROBE_PHASE < 200) { const unsigned long long n_ = __builtin_amdgcn_s_memrealtime(); if (PROBE_PHASE == 100 + (id)) *probe_acc += n_ - psr_; psr_ = n_; } } while (0)
    const float* X = F.out; const float* gamma = FIN(6) + (size_t)l * D; const int m = 2 * l + 1;
    const float* MOD = (const float*)(F.ws + WS_MOD); const float* RW = FIN(25) + (size_t)l * D * 64; const float* RB = FIN(26) + (size_t)l * 64;
    bf16* Hout = (bf16*)(F.ws + WS_H); unsigned* ctl = (unsigned*)(F.ws + WS_CTL);
    int* EIDX = (int*)(F.ws + WS_EIDX); int* SLOT = (int*)(F.ws + WS_SLOT); int* ELT = (int*)(F.ws + WS_ELT); float* ELW = (float*)(F.ws + WS_ELW);
    constexpr int HS = 1028;
    LAS float* hbuf = (LAS float*)F.lds;
    LAS float* part = (LAS float*)(F.lds + 69632);
    LAS int* lcnt = (LAS int*)(F.lds + LDS_RT); LAS int* lbase = lcnt + 64;
    const int lane = F.lane, w = F.wave;
    const float rb = RB[lane];
    if (F.tid < 64) lcnt[F.tid] = 0;
    const int nround = (T / 16 + F.G - 1) / F.G;
#pragma unroll 1
    for (int rd = 0; rd < nround; ++rd) {
        const int blk = rd * F.G + F.bid;
        const bool live = blk < T / 16;
        const int base = blk * 16;
        __syncthreads();
        PSECR(5);
        if (live) {
            const int b = base >> 12;
            const float* shift = MOD + (size_t)(m * 4 + b) * 3072; const float* scale = shift + 1024;
#pragma unroll
            for (int q = 0; q < 2; ++q) {
                const int tl = 2 * w + q, row = base + tl;
                const f32x4* xr = (const f32x4*)(X + (size_t)row * D) + lane;
                f32x4 v[4]; float ss = 0.f;
#pragma unroll
                for (int j = 0; j < 4; ++j) { v[j] = xr[64 * j]; ss += v[j].x * v[j].x + v[j].y * v[j].y + v[j].z * v[j].z + v[j].w * v[j].w; }
                const float rstd = rsqrtf(wave_sum(ss) * (1.0f / D) + 1e-6f);
#pragma unroll
                for (int j = 0; j < 4; ++j) {
                    const int c0 = 4 * lane + 256 * j;
                    const f32x4 gg = *(const f32x4*)(gamma + c0), sc = *(const f32x4*)(scale + c0), sh = *(const f32x4*)(shift + c0);
                    f32x4 h; h.x = v[j].x * rstd * gg.x * (1.f + sc.x) + sh.x; h.y = v[j].y * rstd * gg.y * (1.f + sc.y) + sh.y;
                    h.z = v[j].z * rstd * gg.z * (1.f + sc.z) + sh.z; h.w = v[j].w * rstd * gg.w * (1.f + sc.w) + sh.w;
                    v2u o; o.x = pk2(h.x, h.y); o.y = pk2(h.z, h.w); *(v2u*)(Hout + (size_t)row * D + c0) = o;
                    *(LAS f32x4*)(hbuf + tl * HS + c0) = h;
                }
            }
        }
        __syncthreads(); PSECR(0);
        if (live) {
            f32x4 c4[4];
#pragma unroll
            for (int j = 0; j < 4; ++j) c4[j] = (f32x4){0.f, 0.f, 0.f, 0.f};
            const LAS float* ap = hbuf + (lane & 15) * HS + 128 * w + (lane >> 4);
            const float* rw = RW + (size_t)(128 * w + (lane >> 4)) * 64 + (lane & 15);
#pragma unroll 1
            for (int half = 0; half < 2; ++half) {
                float bw[16][4];
#pragma unroll
                for (int ks = 0; ks < 16; ++ks)
#pragma unroll
                    for (int j = 0; j < 4; ++j) bw[ks][j] = rw[(size_t)(16 * half + ks) * 256 + 16 * j];
#pragma unroll
                for (int ks = 0; ks < 16; ++ks) { const float a = ap[4 * (16 * half + ks)];
#pragma unroll
                    for (int j = 0; j < 4; ++j) c4[j] = __builtin_amdgcn_mfma_f32_16x16x4f32(a, bw[ks][j], c4[j], 0, 0, 0); }
            }
#pragma unroll
            for (int j = 0; j < 4; ++j)
#pragma unroll
                for (int r = 0; r < 4; ++r) part[(w * 16 + 4 * (lane >> 4) + r) * 64 + 16 * j + (lane & 15)] = c4[j][r];
        }
        __syncthreads(); PSECR(1);
        float gwt[2]; int rk[2], lp[2];
#pragma unroll
        for (int q = 0; q < 2; ++q) { gwt[q] = 0.f; rk[q] = -1; lp[q] = 0; }
        if (live) {
#pragma unroll
            for (int q = 0; q < 2; ++q) {
                const int tl = 2 * w + q;
                float lg = 0.f;
#pragma unroll
                for (int ww = 0; ww < 8; ++ww) lg += part[(ww * 16 + tl) * 64 + lane];
                const float score = sigmoidf_(lg);
                const float sel = score + rb;
                float m1 = sel; m1 = fmaxf(m1, DPP_F(m1, 0xB1)); m1 = fmaxf(m1, DPP_F(m1, 0x4E)); m1 = fmaxf(m1, DPP_F(m1, 0x141));
                const unsigned long long bm = __ballot(sel == m1);
                const int g = lane >> 3; const unsigned gm = (unsigned)((bm >> (8 * g)) & 0xffull); const int first = 8 * g + __builtin_ctz(gm);
                float m2 = (lane == first) ? -INFINITY : sel; m2 = fmaxf(m2, DPP_F(m2, 0xB1)); m2 = fmaxf(m2, DPP_F(m2, 0x4E)); m2 = fmaxf(m2, DPP_F(m2, 0x141));
                const float gs = m1 + m2;
                int grank = 0;
#pragma unroll
                for (int gg = 0; gg < 8; ++gg) { const float o = __builtin_bit_cast(float, __builtin_amdgcn_readlane(__builtin_bit_cast(int, gs), gg * 8)); grank += (o > gs || (o == gs && gg < g)) ? 1 : 0; }
                float masked = (grank < 4) ? sel : -INFINITY;
                int rank = -1; float ssum = 0.f;
#pragma unroll
                for (int it = 0; it < 8; ++it) {
                    const float mx = wave_max_dpp(masked);
                    const unsigned long long bb = __ballot(masked == mx);
                    const int win = (int)__builtin_ctzll(bb);
                    if (lane == win) { rank = it; masked = -INFINITY; }
                    ssum += __builtin_bit_cast(float, __builtin_amdgcn_readlane(__builtin_bit_cast(int, score), win));
                }
                const bool chosen = rank >= 0;
                gwt[q] = score / ssum * 2.5f; rk[q] = rank;
                if (chosen) lp[q] = __hip_atomic_fetch_add(&lcnt[lane], 1, __ATOMIC_RELAXED, __HIP_MEMORY_SCOPE_WORKGROUP);
            }
        }
        __syncthreads(); PSECR(2);
        if (F.tid < 64) { const int c = lcnt[F.tid]; int gb = 0; if (c > 0) gb = (int)atomicAdd(&ctl[CW_CNT + (l * 64 + F.tid) * 64], (unsigned)c); lbase[F.tid] = gb; lcnt[F.tid] = 0; }
        __syncthreads(); PSECR(3);
        if (live) {
            const int gb = lbase[lane];
#pragma unroll
            for (int q = 0; q < 2; ++q) if (rk[q] >= 0) {
                const int row = base + 2 * w + q, pos = gb + lp[q];
                ELT[(size_t)lane * ECAP + pos] = row; ELW[(size_t)lane * ECAP + pos] = gwt[q];
                EIDX[(size_t)row * 8 + rk[q]] = lane; SLOT[(size_t)row * 8 + rk[q]] = pos;
            }
        }
    }
    __syncthreads();
}
typedef float f32x2v __attribute__((ext_vector_type(2)));
__device__ __forceinline__ void acc_fp8x16(f32x4 (&a)[4], const v4u w) {
    const unsigned d[4] = {w.x, w.y, w.z, w.w};
#pragma unroll
    for (int j = 0; j < 4; ++j) { const f32x2v lo = __builtin_amdgcn_cvt_pk_f32_fp8((int)d[j], false), hi = __builtin_amdgcn_cvt_pk_f32_fp8((int)d[j], true); a[j].x += lo.x; a[j].y += lo.y; a[j].z += hi.x; a[j].w += hi.y; }
}
__device__ __forceinline__ void phase_combine(Frame& F, int l, const float* gamma, int mnext, bf16* Hf) {
    moe_tables(F, l);
    const LAS int* est = (const LAS int*)(F.lds + LDS_MOE);
    const int* EIDX = (const int*)(F.ws + WS_EIDX); const int* SLOT = (const int*)(F.ws + WS_SLOT);
    const unsigned char* Y = F.ws + BG_Y; const unsigned char* YSH = F.ws + BG_YSH;
    const float* MOD = (const float*)(F.ws + WS_MOD); const float* gate = MOD + (size_t)((2 * l + 1) * 4) * 3072 + 2048; float* X = F.out;
    const int lane = F.lane, c0 = 16 * lane;
#pragma unroll 1
    for (int row = F.gw; row < T; row += F.NGW) {
        const int b = row >> 12;
        const v4u e0 = *(const v4u*)(EIDX + (size_t)row * 8), e1 = *(const v4u*)(EIDX + (size_t)row * 8 + 4), p0 = *(const v4u*)(SLOT + (size_t)row * 8), p1 = *(const v4u*)(SLOT + (size_t)row * 8 + 4);
        size_t yr[8];
        yr[0] = (size_t)(est[e0.x] + (int)p0.x); yr[1] = (size_t)(est[e0.y] + (int)p0.y); yr[2] = (size_t)(est[e0.z] + (int)p0.z); yr[3] = (size_t)(est[e0.w] + (int)p0.w);
        yr[4] = (size_t)(est[e1.x] + (int)p1.x); yr[5] = (size_t)(est[e1.y] + (int)p1.y); yr[6] = (size_t)(est[e1.z] + (int)p1.z); yr[7] = (size_t)(est[e1.w] + (int)p1.w);
        v4u yw[9];
        yw[8] = *(const v4u*)(YSH + (size_t)row * D + c0);
#pragma unroll
        for (int k = 0; k < 8; ++k) yw[k] = *(const v4u*)(Y + yr[k] * D + c0);
        f32x4 a[4];
#pragma unroll
        for (int j = 0; j < 4; ++j) a[j] = (f32x4){0.f, 0.f, 0.f, 0.f};
#pragma unroll
        for (int k = 0; k < 9; ++k) acc_fp8x16(a, yw[k]);
        float ss = 0.f;
#pragma unroll
        for (int j = 0; j < 4; ++j) { const f32x4 g = *(const f32x4*)(gate + (size_t)b * 3072 + c0 + 4 * j);
            f32x4* xp = (f32x4*)(X + (size_t)row * D + c0 + 4 * j); a[j] = *xp + g * (a[j] * Y8_INV); *xp = a[j]; ss += a[j].x * a[j].x + a[j].y * a[j].y + a[j].z * a[j].z + a[j].w * a[j].w; }
        if (Hf) {
            const float* shift = MOD + (size_t)(mnext * 4 + b) * 3072; const float* scale = shift + 1024;
            const float rstd = rsqrtf(wave_sum(ss) * (1.0f / D) + 1e-6f);
#pragma unroll
            for (int j = 0; j < 4; ++j) { const int cc = c0 + 4 * j;
                const f32x4 gg = *(const f32x4*)(gamma + cc), sc = *(const f32x4*)(scale + cc), sh = *(const f32x4*)(shift + cc);
                f32x4 h; h.x = a[j].x * rstd * gg.x * (1.f + sc.x) + sh.x; h.y = a[j].y * rstd * gg.y * (1.f + sc.y) + sh.y; h.z = a[j].z * rstd * gg.z * (1.f + sc.z) + sh.z; h.w = a[j].w * rstd * gg.w * (1.f + sc.w) + sh.w;
                v2u o; o.x = pk2(h.x, h.y); o.y = pk2(h.z, h.w); *(v2u*)(Hf + (size_t)row * D + cc) = o; }
        }
    }
}
__device__ __forceinline__ f32x4 ld_h4(const bf16* p) { const v2u w = *(const v2u*)p; return (f32x4){bflo(w.x), bfhi(w.x), bflo(w.y), bfhi(w.y)}; }
__device__ __forceinline__ void phase_pool(Frame& F) {
    const bf16* Hb = (const bf16*)(F.ws + BG_H2F); bf16* P = (bf16*)(F.ws + WS_H);
#pragma unroll 1
    for (int it = F.gw; it < (T / 32) * 4; it += F.NGW) {
        const int g = it & 3, r0 = (it >> 2) * 32, tp0 = r0 & 4095;
        const int win = 2 << g, c0 = 256 * g + 4 * F.lane;
        f32x4 s = (f32x4){0.f, 0.f, 0.f, 0.f};
        for (int q = 1; q < win; ++q) if (tp0 - q >= 0) s = s + ld_h4(Hb + (size_t)(r0 - q) * D + c0);
#pragma unroll 4
        for (int i = 0; i < 32; ++i) {
            const int row = r0 + i, tp = tp0 + i;
            const f32x4 h = ld_h4(Hb + (size_t)row * D + c0);
            s = s + h;
            const int cnt = (tp + 1 < win) ? tp + 1 : win;
            const float inv = 1.0f / (float)cnt;
            v2u o; o.x = pk2(s.x * inv - h.x, s.y * inv - h.y); o.y = pk2(s.z * inv - h.z, s.w * inv - h.w);
            *(v2u*)(P + (size_t)row * D + c0) = o;
            if (tp - win + 1 >= 0) s = s - ld_h4(Hb + (size_t)(row - win + 1) * D + c0);
        }
    }
}

constexpr int NPHASE = 29;
__global__ void __launch_bounds__(512, 2) mega(Args args_formal) {
    ArgsP const ap0 = (ArgsP)__builtin_amdgcn_kernarg_segment_ptr();
    extern __shared__ __attribute__((aligned(16))) unsigned char lds_raw[];
    Frame F;
    F.lds = (LAS unsigned char*)lds_raw;
    F.tid = threadIdx.x; F.lane = F.tid & 63; F.wave = __builtin_amdgcn_readfirstlane(F.tid >> 6);
    F.bid = blockIdx.x; F.G = gridDim.x; F.gw = F.bid * 8 + F.wave; F.NGW = F.G * 8;
    F.out = ap0->out; F.ws = ap0->ws;
    unsigned* ctl = (unsigned*)(F.ws + WS_CTL);
    const int lo = ap0->ph_lo, hi = ap0->ph_hi;
    volatile LAS unsigned* bst = (volatile LAS unsigned*)(F.lds + LDS_BYTES - 16);
    XcdBarrier bar; bar.bar = ctl + CW_BAR; bar.x = 0; bar.st = bst;
    const bool multi = (hi - lo) > 1;
    if (multi) { if (F.tid == 0) { bst[0] = 0u; bst[1] = 0u; } __syncthreads(); bar = xcd_barrier_post(ctl + CW_BAR, bst); }
    unsigned long long probe_t0 = 0ull, probe_dt = 0ull, probe_sec = 0ull;
#ifndef PROBE_EXTRA_BAR
#define PROBE_EXTRA_BAR 0
#endif
#ifndef PROBE_DUP
#define PROBE_DUP 0ull
#endif
#ifndef PHMASK
#define PHMASK 0xFFFFFFFFull
#endif
#define IN(k) ((((PHMASK) >> ((k) >= 20 ? (k) - 10 : (k))) & 1ull) && lo <= (k) && (k) < hi)
#define SEAM(k) do { if ((k) + 1 < hi) xcd_barrier(bar); } while (0)
#define PH_BEGIN(k) if ((k) == PROBE_PHASE) probe_t0 = __builtin_amdgcn_s_memrealtime(); if (IN(k)) { { int t_ = threadIdx.x; asm volatile("" : "+v"(t_)); F.tid = t_; F.lane = t_ & 63; F.wave = __builtin_amdgcn_readfirstlane(t_ >> 6); F.gw = F.bid * 8 + F.wave; } ArgsP args = launder_args(ap0); ArgsP AR = args; (void)AR; F.out = args->out; F.ws = args->ws; ctl = (unsigned*)(F.ws + WS_CTL); const float* MOD = (const float*)(F.ws + WS_MOD); (void)MOD; _Pragma("unroll 1") for (int rep_ = 0; rep_ < ((((PROBE_DUP) >> ((k) >= 20 ? (k) - 10 : (k))) & 1ull) ? 2 : 1); ++rep_) { if (rep_) __syncthreads();
#define PH_END(k) } } if (multi && lo <= (k) && (k) < hi && (k) + 1 < hi) { xcd_barrier(bar); if ((k) == 0) { for (int xb_ = 0; xb_ < PROBE_EXTRA_BAR; ++xb_) xcd_barrier(bar); } } if ((k) == PROBE_PHASE) probe_dt = __builtin_amdgcn_s_memrealtime() - probe_t0;
    PH_BEGIN(0) phase_mod(F, args); __syncthreads(); phase_s5mats(F, args); phase_convert_static(F, args); phase_tables(F, args); phase_convert_experts(F, args, 0); PH_END(0)
    PH_BEGIN(1) phase_norm_mod(F, FIN(0), FIN(3), 0, (bf16*)(F.ws + WS_H), nullptr); PH_END(1)
    PH_BEGIN(3) DenseOrder S; S.init(F.ws + WS_H, F.ws + WS_WIN, 2048u, 2048u, T, INP, F.G, F.bid); EpiBf16Store E{(bf16*)(F.ws + BG_PROJ), INP};
        pg8::gemm_phase<EpiBf16Store, DenseOrder, false>(F.lds, F.tid, 1024, 2048u, 2048u, S, E); PH_END(3)
    PH_BEGIN(4) phase_postproj(F, args); PH_END(4)
    PH_BEGIN(5) S5AOrder S{F.ws, F.bid, F.G}; EpiS5A E{(float*)(F.ws + BG_SL2)}; pg8::gemm_phase<EpiS5A, S5AOrder, false>(F.lds, F.tid, 512, 1280u, 1024u, S, E); PH_END(5)
    PH_BEGIN(6) phase_s5carry(F); phase_dsa2(F, args, &probe_sec); PH_END(6)
    PH_BEGIN(7) S5BOrder S{F.ws, F.bid, F.G}; EpiS5B E{F.ws, FIN(18), FIN(19), FIN(20), (bf16*)(F.ws + BG_MIX)}; pg8::gemm_phase<EpiS5B, S5BOrder, false>(F.lds, F.tid, 640, 1280u, 1280u, S, E); PH_END(7)
    PH_BEGIN(9) DenseOrder S; S.init(F.ws + BG_MIX, F.ws + WS_WOUT, 2048u, 2048u, T, D, F.G, F.bid); EpiResidual E{FIN(0), F.out, MOD + 2048, nullptr, 0};
        pg8::gemm_phase<EpiResidual, DenseOrder, false>(F.lds, F.tid, 1024, 2048u, 2048u, S, E); PH_END(9)
#define MOE_PHASES(pb, l) \
    PH_BEGIN(pb) phase_router(F, args, l, &probe_sec); PH_END(pb) \
    PH_BEGIN(pb + 1) moe_tables(F, l); typedef MoeOrder<2, true> O; O S; S.init(F.lds, F.ws, false, true, F.G, F.bid); EpiGateUp<O> E{&S, F.ws}; \
        pg8::gemm_phase<EpiGateUp<O>, O, true>(F.lds, F.tid, 1024, 2048u, 2048u, S, E); PH_END(pb + 1) \
    PH_BEGIN(pb + 2) moe_tables(F, l); typedef MoeOrder<4, false> O; O S; S.init(F.lds, F.ws, false, true, F.G, F.bid); EpiDown<O> E{&S, F.ws}; \
        pg8::gemm_phase<EpiDown<O>, O, false>(F.lds, F.tid, 256, 512u, 512u, S, E); PH_END(pb + 2)
    MOE_PHASES(10, 0)
    PH_BEGIN(17) phase_combine(F, 0, FIN(3) + D, 2, (bf16*)(F.ws + BG_H2F));     phase_convert_experts(F, args, 1); PH_END(17)
    PH_BEGIN(18) phase_pool(F); PH_END(18)
    PH_BEGIN(19) PoolOrder S; S.init(F.ws + WS_H, F.ws + WS_WPOOL, F.G, F.bid); EpiResidual E{F.out, F.out, MOD + (size_t)(2 * 4) * 3072 + 2048, FIN(24), 1};
        pg8::gemm_phase<EpiResidual, PoolOrder, false>(F.lds, F.tid, 256, 2048u, 512u, S, E); PH_END(19)
    MOE_PHASES(20, 1)
    PH_BEGIN(23) phase_combine(F, 1, nullptr, 0, nullptr); PH_END(23)
    if (PROBE_PHASE >= 0 && F.bid == 0 && F.wave == 0) { const unsigned long long te = __builtin_amdgcn_s_memrealtime() + (unsigned long long)PROBE_AMP * (PROBE_PHASE >= 100 ? probe_sec : probe_dt); while (__builtin_amdgcn_s_memrealtime() < te) __builtin_amdgcn_s_sleep(16); }
}

extern "C" void kernel_launch(void* const* d_in, const int* in_sizes, int n_in, void* d_out, int out_size, void* d_ws, size_t ws_size, hipStream_t stream) {
    static int grid = 0;
    if (grid == 0) {
        int dev = 0, cus = 0;
        if (n_in != 33 || ws_size < WS_END) { fprintf(stderr, "kernel_launch: unexpected n_in %d or ws_size %zu (need %zu)\n", n_in, ws_size, (size_t)WS_END); grid = -1; return; }
        if (hipGetDevice(&dev) != hipSuccess || hipDeviceGetAttribute(&cus, hipDeviceAttributeMultiprocessorCount, dev) != hipSuccess) { grid = -1; return; }
        if (hipFuncSetAttribute((const void*)mega, hipFuncAttributeMaxDynamicSharedMemorySize, LDS_BYTES) != hipSuccess) { fprintf(stderr, "kernel_launch: hipFuncSetAttribute failed\n"); grid = -1; return; }
        (void)hipGetLastError();
        grid = cus - (cus % 8); if (grid <= 0) grid = cus;
    }
    if (grid < 0) return;
    (void)hipMemsetAsync((char*)d_ws + WS_CTL, 0, CTL_ZERO_BYTES, stream);
    Args a{};
    for (int i = 0; i < 33; ++i) a.in[i] = (const float*)d_in[i];
    a.out = (float*)d_out; a.ws = (unsigned char*)d_ws;
    const int last = 24;
#if MK_LAUNCH_PER_PHASE
    for (int p = 0; p < last; ++p) { a.ph_lo = p; a.ph_hi = p + 1; hipLaunchKernelGGL(mega, dim3(grid), dim3(512), LDS_BYTES, stream, a); }
#else
    a.ph_lo = 0; a.ph_hi = last; hipLaunchKernelGGL(mega, dim3(grid), dim3(512), LDS_BYTES, stream, a);
#endif
}
```
